# Optimizing an MI355X kernel written in HIP

```python
import math
import jax, jax.numpy as jnp
from jax import lax
import numpy as np

D_MODEL = 1024
BATCH = 4
SEQ = 8192
DEPTH = 2

N_MIXERS = 2
N_A_LAYERS = (DEPTH + 1) // 2
N_B_LAYERS = DEPTH // 2
DA_HEADS = 8
DA_HEAD_DIM = 64
DA_V_DIM = 2 * DA_HEAD_DIM
Q_BLOCK = 128
REL_BUCKETS = 32
REL_MAX_EXACT = REL_BUCKETS // 2
REL_MAX_DIST = 128
SGU_CHUNK = 128
SGU_WIDTH = D_MODEL
SGU_GROUPS = 8
SGU_GROUP_DIM = SGU_WIDTH // SGU_GROUPS
D_FF = 2816
N_MOD = 9
EPS = 1e-6
NEG_INF = -1e30

kernel_name = 'hybrid_diffattn_sgu_macaron'


def rms_norm(x, g):
    x32 = x.astype(jnp.float32)
    y = x32 * lax.rsqrt(jnp.mean(x32 * x32, axis=-1, keepdims=True) + EPS)
    return (y * g.astype(jnp.float32)).astype(x.dtype)


def layer_norm(x, g, b):
    x32 = x.astype(jnp.float32)
    mu = jnp.mean(x32, axis=-1, keepdims=True)
    xc = x32 - mu
    y = xc * lax.rsqrt(jnp.mean(xc * xc, axis=-1, keepdims=True) + EPS)
    return (y * g.astype(jnp.float32) + b.astype(jnp.float32)).astype(x.dtype)


def modulate(h, shift, scale):
    return h * (1.0 + scale[:, None, :]) + shift[:, None, :]


def swiglu(h, wg, wu, wd):
    return (jax.nn.silu(h @ wg) * (h @ wu)) @ wd


def t5_bucket(rel):
    n = jnp.maximum(rel, 0)
    nf = jnp.maximum(n, 1).astype(jnp.float32)
    large = REL_MAX_EXACT + (jnp.log(nf / REL_MAX_EXACT) / math.log(REL_MAX_DIST / REL_MAX_EXACT)
                             * (REL_BUCKETS - REL_MAX_EXACT)).astype(jnp.int32)
    large = jnp.minimum(large, REL_BUCKETS - 1)
    return jnp.where(n < REL_MAX_EXACT, n, large)


def diff_attention(h, w_qkv, q_g, k_g, lq1, lk1, lq2, lk2, subln_g, w_o, rel_bias, lambda_init):
    B, S, _ = h.shape
    q, k, v = jnp.split(h @ w_qkv, 3, axis=-1)
    q = rms_norm(q.reshape(B, S, DA_HEADS, 2, DA_HEAD_DIM), q_g)
    k = rms_norm(k.reshape(B, S, DA_HEADS, 2, DA_HEAD_DIM), k_g)
    v32 = v.reshape(B, S, DA_HEADS, DA_V_DIM).astype(jnp.float32)
    k32 = k.astype(jnp.float32)
    f32 = jnp.float32
    lam = (jnp.exp(jnp.sum(lq1.astype(f32) * lk1.astype(f32)))
           - jnp.exp(jnp.sum(lq2.astype(f32) * lk2.astype(f32))) + lambda_init)
    scale = 1.0 / math.sqrt(DA_HEAD_DIM)
    nb = S // Q_BLOCK
    qb = q.reshape(B, nb, Q_BLOCK, DA_HEADS, 2, DA_HEAD_DIM).transpose(1, 0, 2, 3, 4, 5)
    k_pos = jnp.arange(S, dtype=jnp.int32)
    table = rel_bias.astype(f32)

    def block(args):
        q_blk, bi = args
        q_pos = bi * Q_BLOCK + jnp.arange(Q_BLOCK, dtype=jnp.int32)
        rel = q_pos[:, None] - k_pos[None, :]
        bias = jnp.where((rel >= 0)[..., None], table[t5_bucket(rel)], NEG_INF)
        bias = bias.transpose(2, 0, 1)
        logits = jnp.einsum('bqhcd,bkhcd->bhcqk', q_blk.astype(f32), k32) * scale + bias[None, :, None]
        p = jax.nn.softmax(logits, axis=-1)
        attn = p[:, :, 0] - lam * p[:, :, 1]
        o = jnp.einsum('bhqk,bkhe->bqhe', attn, v32)
        o = rms_norm(o, subln_g) * (1.0 - lambda_init)
        return o.reshape(B, Q_BLOCK, DA_HEADS * DA_V_DIM).astype(h.dtype)

    out = lax.map(block, (qb, jnp.arange(nb, dtype=jnp.int32)))
    out = out.transpose(1, 0, 2, 3).reshape(B, S, DA_HEADS * DA_V_DIM)
    return out @ w_o


def spatial_gating(h, w_in, ln_g, ln_b, w_s, b_s, w_out):
    B, S, _ = h.shape
    z = jax.nn.gelu(h @ w_in, approximate=False)
    u, v = jnp.split(z, 2, axis=-1)
    v = layer_norm(v, ln_g, ln_b)
    nc = S // SGU_CHUNK
    v = v.reshape(B, nc, SGU_CHUNK, SGU_GROUPS, SGU_GROUP_DIM)
    causal = jnp.tril(jnp.ones((SGU_CHUNK, SGU_CHUNK), dtype=w_s.dtype))
    mixed = jnp.einsum('gts,bnsgc->bntgc', w_s * causal, v) + b_s.T[:, :, None]
    gated = u * mixed.reshape(B, S, SGU_WIDTH)
    return gated @ w_out


def _normal(k, shape, std):
    return jax.random.normal(k, shape, jnp.float32) * std


def setup_inputs(seed: int = 0) -> dict:
    key = jax.random.key(seed)
    ks = jax.random.split(key, 32)
    D, F = D_MODEL, D_FF
    gain = lambda k, shape: 1.0 + _normal(k, shape, 0.1)
    return {
        'x': _normal(ks[0], (BATCH, SEQ, D), 1.0),
        'c': _normal(ks[1], (BATCH, D), 1.0),
        'rel_bias': _normal(ks[2], (REL_BUCKETS, DA_HEADS), 0.5),
        'ada_w': _normal(ks[3], (DEPTH, D, N_MOD * D), 0.5 * D ** -0.5),
        'ada_b': _normal(ks[4], (DEPTH, N_MOD * D), 0.02),
        'ln_ffn1': gain(ks[5], (DEPTH, D)),
        'ffn1_wg': _normal(ks[6], (DEPTH, D, F), D ** -0.5),
        'ffn1_wu': _normal(ks[7], (DEPTH, D, F), D ** -0.5),
        'ffn1_wd': _normal(ks[8], (DEPTH, F, D), F ** -0.5),
        'ln_mix': gain(ks[9], (DEPTH, D)),
        'ln_ffn2': gain(ks[10], (DEPTH, D)),
        'ffn2_wg': _normal(ks[11], (DEPTH, D, F), D ** -0.5),
        'ffn2_wu': _normal(ks[12], (DEPTH, D, F), D ** -0.5),
        'ffn2_wd': _normal(ks[13], (DEPTH, F, D), F ** -0.5),
        'ln_out': gain(ks[14], (DEPTH, D)),
        'attn_w_qkv': _normal(ks[15], (N_A_LAYERS, D, 3 * D), D ** -0.5),
        'attn_q_norm': gain(ks[16], (N_A_LAYERS, DA_HEAD_DIM)),
        'attn_k_norm': gain(ks[17], (N_A_LAYERS, DA_HEAD_DIM)),
        'attn_lq1': _normal(ks[18], (N_A_LAYERS, DA_HEAD_DIM), 0.1),
        'attn_lk1': _normal(ks[19], (N_A_LAYERS, DA_HEAD_DIM), 0.1),
        'attn_lq2': _normal(ks[20], (N_A_LAYERS, DA_HEAD_DIM), 0.1),
        'attn_lk2': _normal(ks[21], (N_A_LAYERS, DA_HEAD_DIM), 0.1),
        'attn_subln': gain(ks[22], (N_A_LAYERS, DA_V_DIM)),
        'attn_w_o': _normal(ks[23], (N_A_LAYERS, D, D), D ** -0.5),
        'sgu_w_in': _normal(ks[24], (N_B_LAYERS, D, 2 * SGU_WIDTH), D ** -0.5),
        'sgu_ln_g': gain(ks[25], (N_B_LAYERS, SGU_WIDTH)),
        'sgu_ln_b': _normal(ks[26], (N_B_LAYERS, SGU_WIDTH), 0.02),
        'sgu_w_s': _normal(ks[27], (N_B_LAYERS, SGU_GROUPS, SGU_CHUNK, SGU_CHUNK), SGU_CHUNK ** -0.5),
        'sgu_b_s': gain(ks[28], (N_B_LAYERS, SGU_GROUPS, SGU_CHUNK)),
        'sgu_w_out': _normal(ks[29], (N_B_LAYERS, SGU_WIDTH, D), SGU_WIDTH ** -0.5),
    }


def reference(x, c, rel_bias, ada_w, ada_b, ln_ffn1, ffn1_wg, ffn1_wu, ffn1_wd, ln_mix,
              ln_ffn2, ffn2_wg, ffn2_wu, ffn2_wd, ln_out, attn_w_qkv, attn_q_norm, attn_k_norm,
              attn_lq1, attn_lk1, attn_lq2, attn_lk2, attn_subln, attn_w_o, sgu_w_in, sgu_ln_g,
              sgu_ln_b, sgu_w_s, sgu_b_s, sgu_w_out):
    c_act = jax.nn.silu(c)
    for i in range(DEPTH):
        mod = c_act @ ada_w[i] + ada_b[i]
        sh1, sc1, g1, sh2, sc2, g2, sh3, sc3, g3 = jnp.split(mod, N_MOD, axis=-1)
        h = modulate(rms_norm(x, ln_ffn1[i]), sh1, sc1)
        x = x + 0.5 * g1[:, None, :] * swiglu(h, ffn1_wg[i], ffn1_wu[i], ffn1_wd[i])
        h = modulate(rms_norm(x, ln_mix[i]), sh2, sc2)
        j = i // N_MIXERS
        if i % N_MIXERS == 0:
            lambda_init = 0.8 - 0.6 * math.exp(-0.3 * i)
            mix = diff_attention(h, attn_w_qkv[j], attn_q_norm[j], attn_k_norm[j], attn_lq1[j],
                                 attn_lk1[j], attn_lq2[j], attn_lk2[j], attn_subln[j], attn_w_o[j],
                                 rel_bias, lambda_init)
        else:
            mix = spatial_gating(h, sgu_w_in[j], sgu_ln_g[j], sgu_ln_b[j], sgu_w_s[j], sgu_b_s[j],
                                 sgu_w_out[j])
        x = x + g2[:, None, :] * mix
        h = modulate(rms_norm(x, ln_ffn2[i]), sh3, sc3)
        x = x + 0.5 * g3[:, None, :] * swiglu(h, ffn2_wg[i], ffn2_wu[i], ffn2_wd[i])
        x = rms_norm(x, ln_out[i])
    return x
```

```cpp
#include <hip/hip_runtime.h>
#include <hip/hip_cooperative_groups.h>
#include <cstdio>
#include <cstdint>
#include <cmath>
namespace cg = cooperative_groups;
__device__ __forceinline__ int opaque_tid() { int t = threadIdx.x; asm volatile("" : "+v"(t)); return t; }
namespace pg8 {
#define PG8_LAS __attribute__((address_space(3)))
typedef unsigned short bf16_t;
typedef short bf16x8 __attribute__((ext_vector_type(8)));
typedef float f32x4 __attribute__((ext_vector_type(4)));
typedef unsigned u32x4 __attribute__((ext_vector_type(4)));
constexpr int BM = 256, BK = 64, HALF = 128, HTB = HALF * BK * 2  , STAGE_BYTES = 8 * HTB, NXCD = 8, WGM = 8;

__host__ __device__ __forceinline__ int lds_byte(int r, int c) { const int st = (r >> 4) * 2 + (c >> 5), rr = r & 15, cc = c & 31, ob = rr * 64 + cc * 2; return st * 1024 + (ob ^ (((ob >> 9) & 1) << 5)); }
__host__ __device__ __forceinline__ void stage_rc(int b, int& R, int& C) { const int st = b / 1024, sb = b % 1024, swz = sb ^ (((sb >> 9) & 1) << 5); R = (st >> 1) * 16 + swz / 64; C = (st & 1) * 32 + (swz % 64) / 2; }
__host__ __device__ __forceinline__ int perm32(int rho) { const int n = rho >> 4, i = rho & 15; return 8 * (i >> 2) + 4 * n + (i & 3); }

struct Unit { int pm, pn; };
struct Gemm { const bf16_t* A; const bf16_t* Bt; int M, N, K; };

struct StaticOrder {
    int nM, nN, nwg, G, c;
    __host__ __device__ void init(int M, int N, int G_, int c_) { nM = M / BM; nN = N / BM; nwg = nM * nN; G = G_; c = c_; }
    __host__ __device__ bool next(int i, Unit& u) const {
        const long L = (long)i * G + c; if (L >= nwg) return false;
        int wgid = (int)L; { const int q = nwg / NXCD, r = nwg % NXCD, xcd = wgid % NXCD, off = wgid / NXCD; wgid = (xcd < r ? xcd * (q + 1) : r * (q + 1) + (xcd - r) * q) + off; }
        const int nig = WGM * nN, gid = wgid / nig, fm = gid * WGM, gsz = (nM - fm) < WGM ? (nM - fm) : WGM;
        u.pm = fm + ((wgid % nig) % gsz); u.pn = (wgid % nig) / gsz; return true;
    }
    __device__ __forceinline__ void a_ready(const Unit&) const {}
    __device__ __forceinline__ void done(const Unit&) const {}
};

__device__ __forceinline__ unsigned cvt_pk_bf16(float lo, float hi) { unsigned r; asm volatile("v_cvt_pk_bf16_f32 %0, %1, %2" : "=v"(r) : "v"(lo), "v"(hi)); return r; }
typedef float f32x2 __attribute__((ext_vector_type(2)));
__device__ __forceinline__ f32x2 gelu_pk(f32x2 v) {
    const f32x2 av = __builtin_elementwise_abs(v), d = av * 0.2316418882f + 1.0f;
    f32x2 t; t.x = __builtin_amdgcn_rcpf(d.x); t.y = __builtin_amdgcn_rcpf(d.y);
    f32x2 q = t * 0.5307027145f + (-0.7265760135f); q = q * t + 0.7107068705f; q = q * t + (-0.142248368f); q = q * t + 0.127414796f; q = q * t;
    const f32x2 s = (v * v) * (-0.72134752044f);
    f32x2 e; e.x = __builtin_amdgcn_exp2f(s.x); e.y = __builtin_amdgcn_exp2f(s.y);
    const f32x2 m = v * (q * e), r = v - m;
    f32x2 o; o.x = v.x < 0.f ? m.x : r.x; o.y = v.y < 0.f ? m.y : r.y; return o;
}
typedef unsigned u32x2 __attribute__((ext_vector_type(2)));
__device__ __forceinline__ float silu_f(float g) { return g * __builtin_amdgcn_rcpf(1.0f + __builtin_amdgcn_exp2f(-1.4426950408889634f * g)); }

struct EpiSwiglu {
    static constexpr bool PERM = true, AFTER_DRAIN = false;
    bf16_t* H; int ldh;
    __device__ __forceinline__ void operator()(const f32x4 (&acc)[2][2][4][2], const Unit& u, int wr, int wc, int fr, int fq) const {
        const int row0 = u.pm * BM + wr * 64 + fr; const int col0 = u.pn * 128 + wc * 32 + 8 * fq;
#pragma unroll
        for (int ai = 0; ai < 2; ++ai)
#pragma unroll
            for (int m = 0; m < 4; ++m) {
                bf16_t* p = H + (size_t)(row0 + ai * HALF + m * 16) * ldh + col0;
                const f32x4 g0 = acc[ai][0][m][0], g1 = acc[ai][0][m][1], u0 = acc[ai][1][m][0], u1 = acc[ai][1][m][1];
                u32x4 w;
                w.x = cvt_pk_bf16(silu_f(g0[0]) * u0[0], silu_f(g0[1]) * u0[1]);
                w.y = cvt_pk_bf16(silu_f(g0[2]) * u0[2], silu_f(g0[3]) * u0[3]);
                w.z = cvt_pk_bf16(silu_f(g1[0]) * u1[0], silu_f(g1[1]) * u1[1]);
                w.w = cvt_pk_bf16(silu_f(g1[2]) * u1[2], silu_f(g1[3]) * u1[3]);
                *(u32x4*)p = w;
                asm volatile("" ::: "memory");
            }
    }
};

struct EpiGelu {
    static constexpr bool PERM = true, AFTER_DRAIN = false;
    bf16_t* O; int ldc;
    __device__ __forceinline__ void operator()(const f32x4 (&acc)[2][2][4][2], const Unit& u, int wr, int wc, int fr, int fq) const {
        const int row0 = u.pm * BM + wr * 64 + fr; const int col0 = u.pn * BM + wc * 32 + 8 * fq;
#pragma unroll
        for (int ai = 0; ai < 2; ++ai)
#pragma unroll
            for (int m = 0; m < 4; ++m) { bf16_t* rowp = O + (size_t)(row0 + ai * HALF + m * 16) * ldc + col0;
#pragma unroll
                for (int bj = 0; bj < 2; ++bj) { const f32x4 v0 = acc[ai][bj][m][0], v1 = acc[ai][bj][m][1];
                    const f32x2 a = gelu_pk((f32x2){v0[0], v0[1]}), b = gelu_pk((f32x2){v0[2], v0[3]}), c = gelu_pk((f32x2){v1[0], v1[1]}), d = gelu_pk((f32x2){v1[2], v1[3]});
                    u32x4 w; w.x = cvt_pk_bf16(a.x, a.y); w.y = cvt_pk_bf16(b.x, b.y); w.z = cvt_pk_bf16(c.x, c.y); w.w = cvt_pk_bf16(d.x, d.y);
                    *(u32x4*)(rowp + bj * HALF) = w; }
                asm volatile("" ::: "memory"); }
    }
};

struct EpiQKV {
    static constexpr bool PERM = true, AFTER_DRAIN = false;
    bf16_t *Q, *K, *V; const float* qg; const float* kg; float qscale;
    __device__ __forceinline__ void operator()(const f32x4 (&acc)[2][2][4][2], const Unit& u, int wr, int wc, int fr, int fq) const {
        const int sect = u.pn >> 2; const int row0 = u.pm * BM + wr * 64 + fr; const int colb = (u.pn & 3) * 256 + 64 * wc + 8 * fq;
        bf16_t* base = sect == 0 ? Q : (sect == 1 ? K : V);
        const float* gp = sect == 0 ? qg : kg; const float sc = sect == 0 ? qscale : 1.0f;
        f32x4 gv[2][2];
#pragma unroll
        for (int bj = 0; bj < 2; ++bj)
#pragma unroll
            for (int n = 0; n < 2; ++n) gv[bj][n] = sect < 2 ? *(const f32x4*)(gp + 32 * bj + 8 * fq + 4 * n) * sc : (f32x4){1.f, 1.f, 1.f, 1.f};
#pragma unroll
        for (int ai = 0; ai < 2; ++ai)
#pragma unroll
            for (int m = 0; m < 4; ++m) {
                float ss = 0.f;
#pragma unroll
                for (int bj = 0; bj < 2; ++bj)
#pragma unroll
                    for (int n = 0; n < 2; ++n) { const f32x4 x = acc[ai][bj][m][n]; ss += (x[0] * x[0] + x[1] * x[1]) + (x[2] * x[2] + x[3] * x[3]); }
                ss += __shfl_xor(ss, 16); ss += __shfl_xor(ss, 32);
                const float rs = sect < 2 ? __builtin_amdgcn_rsqf(ss * (1.0f / 64.0f) + 1e-6f) : 1.0f;
                bf16_t* rowp = base + (size_t)(row0 + ai * HALF + m * 16) * 1024 + colb;
#pragma unroll
                for (int bj = 0; bj < 2; ++bj) { const f32x4 v0 = acc[ai][bj][m][0] * rs * gv[bj][0], v1 = acc[ai][bj][m][1] * rs * gv[bj][1];
                    u32x4 w; w.x = cvt_pk_bf16(v0[0], v0[1]); w.y = cvt_pk_bf16(v0[2], v0[3]); w.z = cvt_pk_bf16(v1[0], v1[1]); w.w = cvt_pk_bf16(v1[2], v1[3]);
                    *(u32x4*)(rowp + 32 * bj) = w; }
                asm volatile("" ::: "memory");
            }
    }
};

struct EpiResid {
    static constexpr bool PERM = true, AFTER_DRAIN = false;
    const float* xin; float* xout; const float* gate; float gs;
    __device__ __forceinline__ void operator()(const f32x4 (&acc)[2][2][4][2], const Unit& u, int wr, int wc, int fr, int fq) const {
        const int b = (u.pm * BM) >> 13; const int row0 = u.pm * BM + wr * 64 + fr; const int col0 = u.pn * BM + wc * 32 + 8 * fq;
        f32x4 gv[2][2];
#pragma unroll
        for (int bj = 0; bj < 2; ++bj)
#pragma unroll
            for (int n = 0; n < 2; ++n) gv[bj][n] = *(const f32x4*)(gate + (size_t)b * 9216 + col0 + bj * HALF + 4 * n) * gs;
#pragma unroll
        for (int ai = 0; ai < 2; ++ai)
#pragma unroll
            for (int m = 0; m < 4; ++m) { const size_t off = (size_t)(row0 + ai * HALF + m * 16) * 1024 + col0;
#pragma unroll
                for (int bj = 0; bj < 2; ++bj)
#pragma unroll
                    for (int n = 0; n < 2; ++n) { const f32x4 xi = *(const f32x4*)(xin + off + bj * HALF + 4 * n); *(f32x4*)(xout + off + bj * HALF + 4 * n) = xi + gv[bj][n] * acc[ai][bj][m][n]; }
                asm volatile("" ::: "memory"); }
    }
};
struct EpiMulti {
    static constexpr bool PERM = true, AFTER_DRAIN = false;
    int kind; void* p0; void* p1; void* p2; const float* g0; const float* g1; float f0; int i0;
    __device__ __forceinline__ void operator()(const f32x4 (&acc)[2][2][4][2], const Unit& u, int wr, int wc, int fr, int fq) const {
        if (kind == 0) { EpiSwiglu e{(bf16_t*)p0, i0}; e(acc, u, wr, wc, fr, fq); }
        else if (kind == 1) { EpiResid e{g0, (float*)p0, g1, f0}; e(acc, u, wr, wc, fr, fq); }
        else if (kind == 2) { EpiQKV e{(bf16_t*)p0, (bf16_t*)p1, (bf16_t*)p2, g0, g1, f0}; e(acc, u, wr, wc, fr, fq); }
        else { EpiGelu e{(bf16_t*)p0, i0}; e(acc, u, wr, wc, fr, fq); }
    }
};

template <class Epi, class Sched, bool ALIGN_EPI = false, bool SP2 = false>
__device__ __forceinline__ void gemm_phase(PG8_LAS unsigned char* lds, const Gemm g, const Sched& S, const Epi& E) {
    const int tid = opaque_tid(), wid = __builtin_amdgcn_readfirstlane(tid >> 6), lane = tid & 63, wr = wid >> 2, wc = wid & 3, fr = lane & 15, fq = lane >> 4;
    const int K = g.K, nt = K / BK;
    unsigned voffA[2], voffB[2];
#pragma unroll
    for (int i = 0; i < 2; ++i) { int R, C; stage_rc(tid * 16 + i * 8192, R, C); const int Rb = Epi::PERM ? ((R & ~31) + perm32(R & 31)) : R;
        voffA[i] = (unsigned)(R * K + C) * 2u; voffB[i] = (unsigned)(Rb * K + C) * 2u; }
    const size_t kstep = (size_t)(BK * 2);
    const size_t hstep = (size_t)HALF * K * 2;
    const size_t tstep = 2 * hstep;
    const unsigned ldsw = (unsigned)wid * 1024u;
    const int aoff = lds_byte(wr * 64 + fr, fq * 8), boff = lds_byte(wc * 32 + fr, fq * 8);
#define PG8_SA(b, h) (((b) * 2 + (h)) * HTB)
#define PG8_SB(b, h) ((4 + (b) * 2 + (h)) * HTB)
#define PG8_STAGE(bufoff, gbase, voff) do { _Pragma("unroll") for (int _i = 0; _i < 2; ++_i) \
        __builtin_amdgcn_global_load_lds((const unsigned*)((const char*)(gbase) + (voff)[_i]), (PG8_LAS unsigned*)(lds + (bufoff) + ldsw + _i * 8192), 16, 0, 0); } while (0)
#define PG8_LDA(dst, b, h) do { _Pragma("unroll") for (int m = 0; m < 4; ++m) _Pragma("unroll") for (int k = 0; k < 2; ++k) dst[m][k] = *(const PG8_LAS bf16x8*)(lds + PG8_SA(b, h) + aoff + m * 2048 + k * 1024); } while (0)
#define PG8_LDB(dst, b, h) do { _Pragma("unroll") for (int n = 0; n < 2; ++n) _Pragma("unroll") for (int k = 0; k < 2; ++k) dst[n][k] = *(const PG8_LAS bf16x8*)(lds + PG8_SB(b, h) + boff + n * 2048 + k * 1024); } while (0)
#define PG8_MMA(ai, bj, At, Bt) do { __builtin_amdgcn_s_setprio(1); _Pragma("unroll") for (int m = 0; m < 4; ++m) _Pragma("unroll") for (int n = 0; n < 2; ++n) _Pragma("unroll") for (int k = 0; k < 2; ++k) \
        acc[ai][bj][m][n] = __builtin_amdgcn_mfma_f32_16x16x32_bf16(Bt[n][k], At[m][k], acc[ai][bj][m][n], 0, 0, 0); __builtin_amdgcn_s_setprio(0); } while (0)
#define PG8_WAIT_V(n) asm volatile("s_waitcnt vmcnt(" #n ")" ::: "memory")
#define PG8_WAIT_L(n) asm volatile("s_waitcnt lgkmcnt(" #n ")" ::: "memory")
#define PG8_BAR __builtin_amdgcn_s_barrier()
#define PG8_SCHED __builtin_amdgcn_sched_barrier(0)
    Unit cur, nxt; int ui = 0;
    if (!S.next(0, cur)) return;
    f32x4 acc[2][2][4][2];
#pragma unroll
    for (int a = 0; a < 2; ++a)
#pragma unroll
        for (int b = 0; b < 2; ++b)
#pragma unroll
            for (int m = 0; m < 4; ++m)
#pragma unroll
                for (int n = 0; n < 2; ++n) acc[a][b][m][n] = (f32x4){0.f, 0.f, 0.f, 0.f};
    bf16x8 At[4][2], B0[2][2], B1[2][2];
    const char* cA = (const char*)g.A + (size_t)cur.pm * tstep; const char* cB = (const char*)g.Bt + (size_t)cur.pn * tstep;
    S.a_ready(cur);
    if constexpr (SP2) {
        PG8_STAGE(PG8_SB(0, 0), cB, voffB); PG8_STAGE(PG8_SB(0, 1), cB + hstep, voffB); PG8_STAGE(PG8_SA(0, 0), cA, voffA); PG8_STAGE(PG8_SA(0, 1), cA + hstep, voffA);
        if (wr == 1) PG8_BAR;
        PG8_WAIT_V(2); PG8_BAR;
        PG8_STAGE(PG8_SB(1, 0), cB + kstep, voffB); PG8_STAGE(PG8_SA(1, 0), cA + kstep, voffA); PG8_STAGE(PG8_SB(1, 1), cB + hstep + kstep, voffB);
        PG8_WAIT_V(6); PG8_BAR;
    } else {
        PG8_STAGE(PG8_SB(0, 0), cB, voffB); PG8_STAGE(PG8_SA(0, 0), cA, voffA); PG8_STAGE(PG8_SB(0, 1), cB + hstep, voffB); PG8_STAGE(PG8_SA(0, 1), cA + hstep, voffA);
        if (wr == 1) PG8_BAR;
        PG8_WAIT_V(4); PG8_BAR;
        PG8_STAGE(PG8_SB(1, 0), cB + kstep, voffB); PG8_STAGE(PG8_SA(1, 0), cA + kstep, voffA); PG8_STAGE(PG8_SB(1, 1), cB + hstep + kstep, voffB);
        PG8_WAIT_V(6); PG8_BAR;
    }
    for (;;) {
        const bool has_next = S.next(ui + 1, nxt);
        const char* nA = has_next ? (const char*)g.A + (size_t)nxt.pm * tstep : cA; const char* nB = has_next ? (const char*)g.Bt + (size_t)nxt.pn * tstep : cB;
        for (int t = 0; t < nt; t += 2) {
            const bool last = (t == nt - 2);
            const char* a1 = cA + (size_t)(t + 1) * kstep;
            const char* a2 = last ? nA : cA + (size_t)(t + 2) * kstep; const char* b2 = last ? nB : cB + (size_t)(t + 2) * kstep;
            const char* a3 = a2 + kstep; const char* b3 = b2 + kstep;
            if (last && has_next) S.a_ready(nxt);
            if constexpr (SP2) {
            PG8_LDB(B0, 0, 0); PG8_LDB(B1, 0, 1); PG8_SCHED; PG8_LDA(At, 0, 0); PG8_STAGE(PG8_SA(1, 1), a1 + hstep, voffA);
            PG8_WAIT_V(8); PG8_WAIT_L(0); PG8_BAR; PG8_MMA(0, 0, At, B0); PG8_MMA(0, 1, At, B1); PG8_BAR; PG8_SCHED;
            PG8_LDA(At, 0, 1); PG8_STAGE(PG8_SB(0, 0), b2, voffB); PG8_STAGE(PG8_SB(0, 1), b2 + hstep, voffB); PG8_STAGE(PG8_SA(0, 0), a2, voffA);
            PG8_WAIT_V(8); PG8_WAIT_L(0); PG8_BAR; PG8_MMA(1, 0, At, B0); PG8_MMA(1, 1, At, B1); PG8_BAR; PG8_SCHED;
            PG8_LDB(B0, 1, 0); PG8_LDB(B1, 1, 1); PG8_SCHED; PG8_LDA(At, 1, 0); PG8_STAGE(PG8_SA(0, 1), a2 + hstep, voffA);
            PG8_WAIT_V(8); PG8_WAIT_L(0); PG8_BAR; PG8_MMA(0, 0, At, B0); PG8_MMA(0, 1, At, B1); PG8_BAR; PG8_SCHED;
            PG8_LDA(At, 1, 1); PG8_STAGE(PG8_SB(1, 0), b3, voffB); PG8_STAGE(PG8_SB(1, 1), b3 + hstep, voffB); PG8_STAGE(PG8_SA(1, 0), a3, voffA);
            PG8_WAIT_V(8); PG8_WAIT_L(0); PG8_BAR; PG8_MMA(1, 0, At, B0); PG8_MMA(1, 1, At, B1); PG8_BAR; PG8_SCHED;
            } else {
            PG8_LDB(B0, 0, 0); PG8_SCHED; PG8_LDA(At, 0, 0); PG8_STAGE(PG8_SA(1, 1), a1 + hstep, voffA);
            PG8_WAIT_L(8); PG8_BAR; PG8_WAIT_L(0); PG8_MMA(0, 0, At, B0); PG8_BAR; PG8_SCHED;
            PG8_LDB(B1, 0, 1); PG8_STAGE(PG8_SB(0, 0), b2, voffB);
            PG8_BAR; PG8_WAIT_L(0); PG8_MMA(0, 1, At, B1); PG8_BAR;
            PG8_LDA(At, 0, 1); PG8_STAGE(PG8_SA(0, 0), a2, voffA);
            PG8_BAR; PG8_WAIT_L(0); PG8_MMA(1, 0, At, B0); PG8_BAR; PG8_SCHED;
            PG8_STAGE(PG8_SB(0, 1), b2 + hstep, voffB);
            PG8_WAIT_V(6); PG8_BAR; PG8_MMA(1, 1, At, B1); PG8_BAR;
            PG8_LDB(B0, 1, 0); PG8_SCHED; PG8_LDA(At, 1, 0); PG8_STAGE(PG8_SA(0, 1), a2 + hstep, voffA);
            PG8_WAIT_L(8); PG8_BAR; PG8_WAIT_L(0); PG8_MMA(0, 0, At, B0); PG8_BAR; PG8_SCHED;
            PG8_LDB(B1, 1, 1); PG8_STAGE(PG8_SB(1, 0), b3, voffB);
            PG8_BAR; PG8_WAIT_L(0); PG8_MMA(0, 1, At, B1); PG8_BAR;
            PG8_LDA(At, 1, 1); PG8_STAGE(PG8_SA(1, 0), a3, voffA);
            PG8_BAR; PG8_WAIT_L(0); PG8_MMA(1, 0, At, B0); PG8_BAR; PG8_SCHED;
            PG8_STAGE(PG8_SB(1, 1), b3 + hstep, voffB);
            PG8_WAIT_V(6); PG8_BAR; PG8_MMA(1, 1, At, B1); PG8_BAR;
            }
        }
        if constexpr (ALIGN_EPI) { if (wr == 0) PG8_BAR; }
        if constexpr (!Epi::AFTER_DRAIN) { E(acc, cur, wr, wc, fr, fq); S.done(cur); }
        if (!has_next) break;
#pragma unroll
        for (int a = 0; a < 2; ++a)
#pragma unroll
            for (int b = 0; b < 2; ++b)
#pragma unroll
                for (int m = 0; m < 4; ++m)
#pragma unroll
                    for (int n = 0; n < 2; ++n) acc[a][b][m][n] = (f32x4){0.f, 0.f, 0.f, 0.f};
        cur = nxt; cA = nA; cB = nB; ++ui;
        if constexpr (ALIGN_EPI) { if (wr == 1) PG8_BAR; }
    }
    PG8_WAIT_V(0);
    if constexpr (!ALIGN_EPI) { if (wr == 0) PG8_BAR; }
    PG8_BAR;
    if constexpr (Epi::AFTER_DRAIN) { E.fused(acc, cur, wr, wc, fr, fq, lds, wid, lane); S.done(cur); }
#undef PG8_SA
#undef PG8_SB
#undef PG8_STAGE
#undef PG8_LDA
#undef PG8_LDB
#undef PG8_MMA
#undef PG8_WAIT_V
#undef PG8_WAIT_L
#undef PG8_BAR
#undef PG8_SCHED
}
}

namespace att {
#define ALDS __attribute__((address_space(3)))
typedef short bf16x8 __attribute__((ext_vector_type(8)));
typedef short s16x4 __attribute__((ext_vector_type(4)));
typedef float f32x16 __attribute__((ext_vector_type(16)));
typedef float f32x2 __attribute__((ext_vector_type(2)));
typedef unsigned u32x4 __attribute__((ext_vector_type(4)));
typedef unsigned short bf16_t;
constexpr int SEQ = 8192, DM = 1024, KVB = 64, QU = 128, NSLOT = 3, SLOT = 16384;
constexpr int L_K = 0, L_V = NSLOT * SLOT, L_LUT = 131072, L_LB = L_LUT + 512;
constexpr float LOG2E = 1.4426950408889634f, C2 = 0.125f * LOG2E;
__device__ __forceinline__ int crow(int r, int hi) { return (r & 3) + 8 * (r >> 2) + 4 * hi; }
__device__ __forceinline__ void glds16(const void* gsrc, unsigned lds_dst) { unsigned keep;
    asm volatile("s_mov_b32 %0, m0\n\ts_mov_b32 m0, %2\n\ts_nop 0\n\tglobal_load_lds_dwordx4 %1, off\n\ts_mov_b32 m0, %0" : "=&s"(keep) : "v"(gsrc), "s"(lds_dst) : "memory"); }
__device__ __forceinline__ unsigned cvtpk(float lo, float hi) { unsigned r; asm volatile("v_cvt_pk_bf16_f32 %0, %1, %2" : "=v"(r) : "v"(lo), "v"(hi)); return r; }
__device__ __forceinline__ float bf2f(short s) { return __uint_as_float(((unsigned)(unsigned short)s) << 16); }
#define ATT_WAIT_BAR(N) asm volatile("s_waitcnt vmcnt(" #N ") lgkmcnt(0)\n\ts_barrier" ::: "memory")

__device__ __forceinline__ void pv4(f32x16* o, unsigned vb, bf16x8 pa0, bf16x8 pa1, bf16x8 pa2, bf16x8 pa3) {
#pragma unroll
    for (int d0 = 0; d0 < 4; ++d0) { s16x4 lo[4], hi[4];
#pragma unroll
        for (int ks = 0; ks < 4; ++ks) {
            asm volatile("ds_read_b64_tr_b16 %0, %1 offset:%c2" : "=&v"(lo[ks]) : "v"(vb), "i"(d0 * 4096 + ks * 1024) : "memory");
            asm volatile("ds_read_b64_tr_b16 %0, %1 offset:%c2" : "=&v"(hi[ks]) : "v"(vb), "i"(d0 * 4096 + ks * 1024 + 512) : "memory"); }
        asm volatile("s_waitcnt lgkmcnt(0)" ::: "memory"); __builtin_amdgcn_sched_barrier(0);
#define ATT_PK(k) (bf16x8){lo[k][0], lo[k][1], lo[k][2], lo[k][3], hi[k][0], hi[k][1], hi[k][2], hi[k][3]}
        o[d0] = __builtin_amdgcn_mfma_f32_32x32x16_bf16(pa0, ATT_PK(0), o[d0], 0, 0, 0);
        o[d0] = __builtin_amdgcn_mfma_f32_32x32x16_bf16(pa1, ATT_PK(1), o[d0], 0, 0, 0);
        o[d0] = __builtin_amdgcn_mfma_f32_32x32x16_bf16(pa2, ATT_PK(2), o[d0], 0, 0, 0);
        o[d0] = __builtin_amdgcn_mfma_f32_32x32x16_bf16(pa3, ATT_PK(3), o[d0], 0, 0, 0);
#undef ATT_PK
    }
}

__device__ __forceinline__ void attn_unit(int b, int h, int qb, const bf16_t* Q, const bf16_t* K, const bf16_t* V, bf16_t* O, ALDS unsigned char* lds,
                                          const float* relb, float lam, float kmaxn, const float* subg, float outscale) {
    const int tid = opaque_tid(), lane = tid & 63, r32 = lane & 31, hi = lane >> 5;
    const int wid = __builtin_amdgcn_readfirstlane(tid >> 6), comp = wid >> 2, qw = wid & 3;
    const long rowbase = (long)b * SEQ; const int q0 = qb * QU;
    const unsigned lds0 = (unsigned)(uintptr_t)lds;
    ALDS float* lut = (ALDS float*)(lds + L_LUT);
    if (tid < 128) { const int n = tid; int bk; if (n < 16) bk = n; else { const int lg = 16 + (int)(logf((float)n / 16.0f) / logf(8.0f) * 16.0f); bk = lg < 31 ? lg : 31; }
        lut[tid] = relb[bk * 8 + h] * LOG2E; }
    float bmax = -1e30f;
    for (int i = 0; i < 32; ++i) bmax = fmaxf(bmax, relb[i * 8 + h]);
    bmax *= LOG2E; const float lut31 = relb[31 * 8 + h] * LOG2E;
    const bf16_t* Kh = K + rowbase * DM + h * 128; const bf16_t* Vh = V + rowbase * DM + h * 128;
    const bf16_t* ksrc = Kh + (long)lane * DM + wid * 8;
    const bf16_t* vsrc = Vh + (long)(16 * (wid & 3) + (lane >> 2)) * DM + (wid >> 2) * 32 + (lane & 3) * 8;
    const unsigned kdst = lds0 + L_K + wid * 1024, vdst = lds0 + L_V + wid * 1024;
#define ATT_DMA(t, s) do { const long go_ = (long)(t) * KVB * DM; const unsigned so_ = (unsigned)(s) * SLOT; \
        glds16(ksrc + go_, (unsigned)__builtin_amdgcn_readfirstlane(kdst + so_)); glds16(ksrc + go_ + 64, (unsigned)__builtin_amdgcn_readfirstlane(kdst + so_ + 8192)); \
        glds16(vsrc + go_, (unsigned)__builtin_amdgcn_readfirstlane(vdst + so_)); glds16(vsrc + go_ + 64, (unsigned)__builtin_amdgcn_readfirstlane(vdst + so_ + 8192)); } while (0)
    const int NT = 2 * (qb + 1);
    ATT_DMA(0, 0); ATT_DMA(1, 1);
    const bf16_t* Qw = Q + (rowbase + q0 + qw * 32 + r32) * DM + h * 128 + comp * 64 + hi * 8;
    bf16x8 qr[4];
#pragma unroll
    for (int d0 = 0; d0 < 4; ++d0) qr[d0] = *(const bf16x8*)(Qw + d0 * 16);
    float ssq = 0.f;
#pragma unroll
    for (int d0 = 0; d0 < 4; ++d0)
#pragma unroll
        for (int i = 0; i < 8; ++i) { const float f = bf2f(qr[d0][i]); ssq += f * f; }
    ssq += __shfl_xor(ssq, 32);
    const float bound = sqrtf(ssq) * kmaxn + bmax;
    const float cfar = lut31 - bound, cnear = -bound;
    f32x16 o[4];
#pragma unroll
    for (int d0 = 0; d0 < 4; ++d0)
#pragma unroll
        for (int r = 0; r < 16; ++r) o[d0][r] = 0.f;
    float l = 0.f;
    const int qabs = q0 + qw * 32 + r32;
    const unsigned vb0 = lds0 + L_V + ((lane >> 4) & 1) * 32 + (lane & 3) * 8 + (4 * hi + ((lane & 15) >> 2)) * 64;
    int slot = 0;
    for (int t = 0; t < NT; ++t) {
        if (t + 1 < NT) ATT_WAIT_BAR(4); else ATT_WAIT_BAR(0);
        if (t + 2 < NT) { const int s2 = slot == 0 ? 2 : slot - 1; ATT_DMA(t + 2, s2); }
        const ALDS unsigned char* kb = lds + L_K + slot * SLOT + comp * 8192 + hi * 1024 + r32 * 16;
        const bool band = t >= NT - 4;
        const float ci = band ? cnear : cfar;
        f32x16 p0, p1;
#pragma unroll
        for (int r = 0; r < 16; ++r) { p0[r] = ci; p1[r] = ci; }
#pragma unroll
        for (int d0 = 0; d0 < 4; ++d0) {
            const bf16x8 b0 = *(const ALDS bf16x8*)(kb + d0 * 2048);
            const bf16x8 b1 = *(const ALDS bf16x8*)(kb + d0 * 2048 + 512);
            p0 = __builtin_amdgcn_mfma_f32_32x32x16_bf16(b0, qr[d0], p0, 0, 0, 0);
            p1 = __builtin_amdgcn_mfma_f32_32x32x16_bf16(b1, qr[d0], p1, 0, 0, 0);
        }
        if (band) {
            const int relb0 = qabs - (t * KVB + 4 * hi);
#pragma unroll
            for (int r = 0; r < 16; ++r) {
                const int rel = relb0 - ((r & 3) + 8 * (r >> 2)); const int rel1 = rel - 32;
                const float a0 = lut[rel < 0 ? 0 : (rel > 127 ? 127 : rel)], a1 = lut[rel1 < 0 ? 0 : (rel1 > 127 ? 127 : rel1)];
                p0[r] = rel < 0 ? -INFINITY : p0[r] + a0; p1[r] = rel1 < 0 ? -INFINITY : p1[r] + a1;
            }
        }
        float sacc = 0.f;
#pragma unroll
        for (int r = 0; r < 16; ++r) { p0[r] = __builtin_amdgcn_exp2f(p0[r]); p1[r] = __builtin_amdgcn_exp2f(p1[r]); sacc += p0[r] + p1[r]; }
        l += sacc;
        u32x4 w0, w1, w2, w3;
        w0 = (u32x4){cvtpk(p0[0], p0[1]), cvtpk(p0[2], p0[3]), cvtpk(p0[4], p0[5]), cvtpk(p0[6], p0[7])};
        w1 = (u32x4){cvtpk(p0[8], p0[9]), cvtpk(p0[10], p0[11]), cvtpk(p0[12], p0[13]), cvtpk(p0[14], p0[15])};
        w2 = (u32x4){cvtpk(p1[0], p1[1]), cvtpk(p1[2], p1[3]), cvtpk(p1[4], p1[5]), cvtpk(p1[6], p1[7])};
        w3 = (u32x4){cvtpk(p1[8], p1[9]), cvtpk(p1[10], p1[11]), cvtpk(p1[12], p1[13]), cvtpk(p1[14], p1[15])};
        pv4(o, vb0 + slot * SLOT, __builtin_bit_cast(bf16x8, w0), __builtin_bit_cast(bf16x8, w1), __builtin_bit_cast(bf16x8, w2), __builtin_bit_cast(bf16x8, w3));
        slot = slot == 2 ? 0 : slot + 1;
    }
    l += __shfl_xor(l, 32);
    ATT_WAIT_BAR(0);
    ALDS float* ob = (ALDS float*)lds + comp * (QU * 128);
    ALDS float* lb = (ALDS float*)(lds + L_LB);
    if (hi == 0) lb[comp * QU + qw * 32 + r32] = l;
#pragma unroll
    for (int d0 = 0; d0 < 4; ++d0)
#pragma unroll
        for (int r = 0; r < 16; ++r) ob[(qw * 32 + crow(r, hi)) * 128 + d0 * 32 + r32] = o[d0][r];
    ATT_WAIT_BAR(0);
    const f32x2 sg = *(const f32x2*)(subg + 2 * lane);
    for (int i = 0; i < 16; ++i) {
        const int q = 16 * wid + i;
        const f32x2 a = *(const ALDS f32x2*)(lds + (q * 128 + 2 * lane) * 4), bb = *(const ALDS f32x2*)(lds + 65536 + (q * 128 + 2 * lane) * 4);
        const float i1 = 1.0f / lb[q], i2 = lam / lb[QU + q];
        const float ox = a.x * i1 - bb.x * i2, oy = a.y * i1 - bb.y * i2;
        float ss = ox * ox + oy * oy;
#pragma unroll
        for (int s = 1; s < 64; s <<= 1) ss += __shfl_xor(ss, s);
        const float rs = outscale / sqrtf(ss * (1.0f / 128.0f) + 1e-6f);
        *(unsigned*)(O + (rowbase + q0 + q) * DM + h * 128 + 2 * lane) = cvtpk(ox * rs * sg.x, oy * rs * sg.y);
    }
    ATT_WAIT_BAR(0);
#undef ATT_DMA
}
}

#define LAS __attribute__((address_space(3)))
typedef unsigned short bf16;
typedef unsigned v4u __attribute__((ext_vector_type(4)));
typedef unsigned v2u __attribute__((ext_vector_type(2)));
typedef float f32x4 __attribute__((ext_vector_type(4)));
typedef float f32x2 __attribute__((ext_vector_type(2)));
typedef short bf16x8 __attribute__((ext_vector_type(8)));
constexpr int NWAVES = 8, NTHREADS = 512;
constexpr int M = 32768, D = 1024, F = 2816, SEQ = 8192, NB = 4, NMOD = 9 * 1024;
constexpr int LDS_BYTES = 147456;
constexpr size_t MiB = 1u << 20;
constexpr size_t WS_MOD = 0;
constexpr size_t WS_W = 1 * MiB;
constexpr size_t W_FFN_STRIDE = 33 * MiB / 2;
constexpr size_t W_GU_BYTES = 11 * MiB;
constexpr size_t WS_WQKV = WS_W + 66 * MiB, WS_WO = WS_W + 72 * MiB, WS_WIN = WS_W + 74 * MiB, WS_WOUT = WS_W + 78 * MiB;
constexpr size_t WS_A = 82 * MiB;
constexpr size_t WS_H = 146 * MiB;
constexpr size_t WS_Q = WS_H, WS_K = WS_H + 64 * MiB, WS_V = WS_H + 128 * MiB;
constexpr size_t WS_Z = WS_H, WS_G = WS_H + 128 * MiB;
constexpr size_t WS_END = 338 * MiB;

__device__ __forceinline__ unsigned pk2(float lo, float hi) { unsigned r; asm volatile("v_cvt_pk_bf16_f32 %0, %1, %2" : "=v"(r) : "v"(lo), "v"(hi)); return r; }
__device__ __forceinline__ float bf_lo(unsigned w) { return __uint_as_float(w << 16); }
__device__ __forceinline__ float bf_hi(unsigned w) { return __uint_as_float(w & 0xffff0000u); }
__device__ __forceinline__ float wave_sum(float v) {
#pragma unroll
    for (int o = 1; o < 64; o <<= 1) v += __shfl_xor(v, o);
    return v;
}
__device__ __forceinline__ float wave_max(float v) {
#pragma unroll
    for (int o = 1; o < 64; o <<= 1) v = fmaxf(v, __shfl_xor(v, o));
    return v;
}

__device__ __forceinline__ void transpose_item(const float* W, int K, int N, bf16* WT, int kb, int n0, int row_base, LAS float* scr, int lane) {
    const int k0 = 64 * kb;
#pragma unroll 8
    for (int i = 0; i < 32; ++i) { const int kk = 2 * i + (lane >> 5); scr[kk * 33 + (lane & 31)] = W[(size_t)(k0 + kk) * N + n0 + (lane & 31)]; }
    asm volatile("s_waitcnt lgkmcnt(0)" ::: "memory");
    const int c = lane & 7;
#pragma unroll
    for (int j = 0; j < 4; ++j) { const int n = (lane >> 3) + 8 * j; const LAS float* s = scr + (8 * c) * 33 + n;
        v4u o; o.x = pk2(s[0 * 33], s[1 * 33]); o.y = pk2(s[2 * 33], s[3 * 33]); o.z = pk2(s[4 * 33], s[5 * 33]); o.w = pk2(s[6 * 33], s[7 * 33]);
        *(v4u*)(WT + (size_t)(row_base + n) * K + k0 + 8 * c) = o; }
    asm volatile("s_waitcnt lgkmcnt(0)" ::: "memory");
}

struct Params { const float* in[30]; float* out; unsigned char* ws; int ph_lo, ph_hi; };
enum { I_X = 0, I_C, I_RELB, I_ADAW, I_ADAB, I_LNF1, I_F1G, I_F1U, I_F1D, I_LNMIX, I_LNF2, I_F2G, I_F2U, I_F2D, I_LNOUT, I_WQKV, I_QN, I_KN, I_LQ1, I_LK1, I_LQ2, I_LK2, I_SUBLN, I_WO,
       I_WIN, I_SLNG, I_SLNB, I_SWS, I_SBS, I_WOUT };
constexpr int NPHASE = 22;
#ifndef PHMASK
#define PHMASK 0xff
#endif

__device__ __forceinline__ void convert_weights(const Params& P, LAS unsigned char* lds, int gw, int NGW, int wave, int lane) {
    LAS float* scr = (LAS float*)(lds + wave * 8448);
    constexpr int IT_F = 1408, IT_FFN = 12 * IT_F, IT_QKV = 1536, IT_WO = 512, IT_WIN = 1024, IT_WOUT = 512;
    constexpr int NITEMS = IT_FFN + IT_QKV + IT_WO + IT_WIN + IT_WOUT;
    for (int it = gw; it < NITEMS; it += NGW) {
        int r = it;
        if (r < IT_FFN) {
            const int mi = r / IT_F, ri = r % IT_F; const int l = mi / 6, w = mi % 6; const int f = w / 3, kind = w % 3;
            bf16* gu = (bf16*)(P.ws + WS_W + (size_t)(l * 2 + f) * W_FFN_STRIDE); bf16* dn = (bf16*)((unsigned char*)gu + W_GU_BYTES);
            if (kind < 2) { const float* W = (f == 0 ? (kind == 0 ? P.in[I_F1G] : P.in[I_F1U]) : (kind == 0 ? P.in[I_F2G] : P.in[I_F2U])) + (size_t)l * D * F; const int nblk = F / 32, kb = ri / nblk, n0 = 32 * (ri % nblk);
                transpose_item(W, D, F, gu, kb, n0, 256 * (n0 >> 7) + (n0 & 127) + 128 * kind, scr, lane); }
            else { const float* W = (f == 0 ? P.in[I_F1D] : P.in[I_F2D]) + (size_t)l * F * D; const int nblk = D / 32, kb = ri / nblk, n0 = 32 * (ri % nblk);
                transpose_item(W, F, D, dn, kb, n0, n0, scr, lane); }
            continue;
        }
        r -= IT_FFN;
        if (r < IT_QKV) { const int nblk = 3072 / 32, kb = r / nblk, n0 = 32 * (r % nblk); const int pn = n0 >> 8, rr = n0 & 255, wc = rr >> 6, bj = (rr >> 5) & 1;
            transpose_item(P.in[I_WQKV], D, 3072, (bf16*)(P.ws + WS_WQKV), kb, n0, 256 * pn + 128 * bj + 32 * wc, scr, lane); continue; }
        r -= IT_QKV;
        if (r < IT_WO) { const int nblk = D / 32, kb = r / nblk, n0 = 32 * (r % nblk); transpose_item(P.in[I_WO], D, D, (bf16*)(P.ws + WS_WO), kb, n0, n0, scr, lane); continue; }
        r -= IT_WO;
        if (r < IT_WIN) { const int nblk = 2048 / 32, kb = r / nblk, n0 = 32 * (r % nblk); transpose_item(P.in[I_WIN], D, 2048, (bf16*)(P.ws + WS_WIN), kb, n0, n0, scr, lane); continue; }
        r -= IT_WIN;
        { const int nblk = D / 32, kb = r / nblk, n0 = 32 * (r % nblk); transpose_item(P.in[I_WOUT], D, D, (bf16*)(P.ws + WS_WOUT), kb, n0, n0, scr, lane); }
    }
}

__device__ __forceinline__ void ada_phase(const Params& P, LAS unsigned char* lds, int vcu, int G, int tid, int wave, int lane) {
    if (vcu >= 144) return;
    LAS float* cact = (LAS float*)(lds + 69632);
    LAS float* red = (LAS float*)(lds + 86016);
    const float* c = P.in[I_C];
    for (int i = tid; i < 4096; i += NTHREADS) { const float x = c[i]; cact[i] = x / (1.0f + expf(-x)); }
    __syncthreads();
    float* mod = (float*)(P.ws + WS_MOD);
    for (int item = vcu; item < 144; item += G) {
        const int l = item / 72, jb = item % 72;
        const float* W = P.in[I_ADAW] + (size_t)l * D * NMOD + jb * 128 + 2 * lane;
        float acc[4][2];
#pragma unroll
        for (int b = 0; b < 4; ++b) { acc[b][0] = 0.f; acc[b][1] = 0.f; }
#pragma unroll 8
        for (int kk = 0; kk < 128; ++kk) { const int k = wave * 128 + kk; const f32x2 w = *(const f32x2*)(W + (size_t)k * NMOD);
#pragma unroll
            for (int b = 0; b < 4; ++b) { const float cv = cact[b * 1024 + k]; acc[b][0] += cv * w.x; acc[b][1] += cv * w.y; } }
#pragma unroll
        for (int b = 0; b < 4; ++b) { red[(wave * 4 + b) * 128 + 2 * lane] = acc[b][0]; red[(wave * 4 + b) * 128 + 2 * lane + 1] = acc[b][1]; }
        __syncthreads();
        { const int b = tid >> 7, col = tid & 127; float s = 0.f;
#pragma unroll
            for (int w = 0; w < 8; ++w) s += red[(w * 4 + b) * 128 + col];
            mod[(size_t)(l * 4 + b) * NMOD + jb * 128 + col] = s + P.in[I_ADAB][(size_t)l * NMOD + jb * 128 + col]; }
        __syncthreads();
    }
}

__device__ __forceinline__ void norm_phase(const float* xsrc, float* xdst, const float* gout, bf16* a, const float* g, const float* sh, const float* sc, int mode, int gw, int NGW, int lane) {
    for (int row = gw; row < M; row += NGW) {
        const int b = row >> 13;
        const f32x4* xr = (const f32x4*)(xsrc + (size_t)row * D) + lane;
        f32x4 v[4];
#pragma unroll
        for (int j = 0; j < 4; ++j) v[j] = xr[64 * j];
        if (mode >= 1) {
            float ss = 0.f;
#pragma unroll
            for (int j = 0; j < 4; ++j) ss += (v[j].x * v[j].x + v[j].y * v[j].y) + (v[j].z * v[j].z + v[j].w * v[j].w);
            const float rs = 1.0f / sqrtf(wave_sum(ss) * (1.0f / D) + 1e-6f);
            f32x4* xo = (f32x4*)(xdst + (size_t)row * D) + lane;
#pragma unroll
            for (int j = 0; j < 4; ++j) { const f32x4 gg = *((const f32x4*)gout + lane + 64 * j); v[j] = v[j] * rs * gg; xo[64 * j] = v[j]; }
        }
        if (mode != 2) {
            float ss = 0.f;
#pragma unroll
            for (int j = 0; j < 4; ++j) ss += (v[j].x * v[j].x + v[j].y * v[j].y) + (v[j].z * v[j].z + v[j].w * v[j].w);
            const float rs = 1.0f / sqrtf(wave_sum(ss) * (1.0f / D) + 1e-6f);
            v2u* ao = (v2u*)(a + (size_t)row * D) + lane;
#pragma unroll
            for (int j = 0; j < 4; ++j) { const f32x4 gg = *((const f32x4*)g + lane + 64 * j), s4 = *((const f32x4*)(sh + (size_t)b * NMOD) + lane + 64 * j), c4 = *((const f32x4*)(sc + (size_t)b * NMOD) + lane + 64 * j);
                const f32x4 y = (v[j] * rs * gg) * (c4 + 1.0f) + s4; v2u w; w.x = pk2(y.x, y.y); w.y = pk2(y.z, y.w); ao[64 * j] = w; }
        }
    }
}

__device__ __forceinline__ void sgu_phase(const Params& P, LAS unsigned char* lds, int vcu, int G, int tid, int wave, int lane) {
    constexpr int ST = 136;
    LAS bf16* Wt = (LAS bf16*)lds; LAS bf16* Vt = (LAS bf16*)(lds + 34816); LAS float* st = (LAS float*)(lds + 69632);
    const bf16* Z = (const bf16*)(P.ws + WS_Z); bf16* Gt = (bf16*)(P.ws + WS_G);
    const float* wsp = P.in[I_SWS]; const float* bs = P.in[I_SBS]; const float* lng = P.in[I_SLNG]; const float* lnb = P.in[I_SLNB];
    const int fr = lane & 15, fq = lane >> 4;
    for (int unit = vcu; unit < 256; unit += G) {
        const size_t r0 = (size_t)unit * 128;
        for (int i = 0; i < 16; ++i) { const int row = 16 * wave + i; const v4u* p = (const v4u*)(Z + (r0 + row) * 2048 + 1024 + lane * 16);
            const v4u a = p[0], b = p[1]; float x[16];
            x[0] = bf_lo(a.x); x[1] = bf_hi(a.x); x[2] = bf_lo(a.y); x[3] = bf_hi(a.y); x[4] = bf_lo(a.z); x[5] = bf_hi(a.z); x[6] = bf_lo(a.w); x[7] = bf_hi(a.w);
            x[8] = bf_lo(b.x); x[9] = bf_hi(b.x); x[10] = bf_lo(b.y); x[11] = bf_hi(b.y); x[12] = bf_lo(b.z); x[13] = bf_hi(b.z); x[14] = bf_lo(b.w); x[15] = bf_hi(b.w);
            float s = 0.f;
#pragma unroll
            for (int k = 0; k < 16; ++k) s += x[k];
            const float mean = wave_sum(s) * (1.0f / 1024.0f); float q = 0.f;
#pragma unroll
            for (int k = 0; k < 16; ++k) { const float d = x[k] - mean; q += d * d; }
            const float rstd = 1.0f / sqrtf(wave_sum(q) * (1.0f / 1024.0f) + 1e-6f);
            if (lane == 0) { st[row * 2] = mean; st[row * 2 + 1] = rstd; } }
        __syncthreads();
        for (int g = 0; g < 8; ++g) {
#pragma unroll
            for (int it = 0; it < 4; ++it) { const int idx = it * NTHREADS + tid, t = idx >> 4, s0 = (idx & 15) * 8; const float* wp = wsp + ((size_t)g * 128 + t) * 128 + s0;
                const f32x4 a = *(const f32x4*)wp, b = *(const f32x4*)(wp + 4); float w[8] = {a.x, a.y, a.z, a.w, b.x, b.y, b.z, b.w};
#pragma unroll
                for (int k = 0; k < 8; ++k) w[k] = (s0 + k <= t) ? w[k] : 0.f;
                v4u o; o.x = pk2(w[0], w[1]); o.y = pk2(w[2], w[3]); o.z = pk2(w[4], w[5]); o.w = pk2(w[6], w[7]);
                *(LAS v4u*)(Wt + t * ST + s0) = o; }
#pragma unroll
            for (int it = 0; it < 4; ++it) { const int idx = it * NTHREADS + tid, s = idx & 127, cc = idx >> 7;
                const v4u a = *(const v4u*)(Z + (r0 + s) * 2048 + 1024 + g * 128 + cc * 8);
                const float mean = st[s * 2], rstd = st[s * 2 + 1];
                float x[8] = {bf_lo(a.x), bf_hi(a.x), bf_lo(a.y), bf_hi(a.y), bf_lo(a.z), bf_hi(a.z), bf_lo(a.w), bf_hi(a.w)};
                const f32x4 g0 = *(const f32x4*)(lng + g * 128 + cc * 8), g1 = *(const f32x4*)(lng + g * 128 + cc * 8 + 4), b0 = *(const f32x4*)(lnb + g * 128 + cc * 8), b1 = *(const f32x4*)(lnb + g * 128 + cc * 8 + 4);
                const float gg[8] = {g0.x, g0.y, g0.z, g0.w, g1.x, g1.y, g1.z, g1.w}, bb[8] = {b0.x, b0.y, b0.z, b0.w, b1.x, b1.y, b1.z, b1.w};
#pragma unroll
                for (int k = 0; k < 8; k += 2) { const unsigned w = pk2((x[k] - mean) * rstd * gg[k] + bb[k], (x[k + 1] - mean) * rstd * gg[k + 1] + bb[k + 1]);
                    Vt[(cc * 8 + k) * ST + s] = (bf16)(w & 0xffffu); Vt[(cc * 8 + k + 1) * ST + s] = (bf16)(w >> 16); } }
            __syncthreads();
            f32x4 acc[8];
#pragma unroll
            for (int n = 0; n < 8; ++n) acc[n] = (f32x4){0.f, 0.f, 0.f, 0.f};
            const int nks = (16 * wave + 15) / 32 + 1;
            for (int ks = 0; ks < nks; ++ks) {
                const bf16x8 af = *(const LAS bf16x8*)(Wt + (16 * wave + fr) * ST + 32 * ks + 8 * fq);
#pragma unroll
                for (int n = 0; n < 8; ++n) { const bf16x8 bfv = *(const LAS bf16x8*)(Vt + (16 * n + fr) * ST + 32 * ks + 8 * fq);
                    acc[n] = __builtin_amdgcn_mfma_f32_16x16x32_bf16(bfv, af, acc[n], 0, 0, 0); }
            }
            const int t = 16 * wave + fr; const float bias = bs[g * 128 + t]; const size_t row = r0 + t;
#pragma unroll
            for (int n = 0; n < 8; ++n) { const int col = g * 128 + 16 * n + 4 * fq; const v2u uu = *(const v2u*)(Z + row * 2048 + col);
                v2u w; w.x = pk2(bf_lo(uu.x) * (acc[n][0] + bias), bf_hi(uu.x) * (acc[n][1] + bias)); w.y = pk2(bf_lo(uu.y) * (acc[n][2] + bias), bf_hi(uu.y) * (acc[n][3] + bias));
                *(v2u*)(Gt + row * 1024 + col) = w; }
            __syncthreads();
        }
    }
}

template <class Epi> __device__ __forceinline__ void run_gemm(LAS unsigned char* lds, const bf16* A, const bf16* Bt, int N, int K, int G, const Epi& E) {
    pg8::Gemm g{A, Bt, M, N, K}; pg8::StaticOrder S; S.init(M, N, G, (int)blockIdx.x);
    pg8::gemm_phase<Epi, pg8::StaticOrder, true, true>(lds, g, S, E);
}

__global__ void __launch_bounds__(NTHREADS, 2) mega_fwd(Params P) {
    extern __shared__ __attribute__((aligned(16))) unsigned char lds_raw[];
    LAS unsigned char* lds = (LAS unsigned char*)lds_raw;
    cg::grid_group grid = cg::this_grid();
    const int G = gridDim.x, bx = blockIdx.x;
    const int vcu = (G % 8 == 0) ? (bx % 8) * (G / 8) + bx / 8 : bx;
    const int NGW = G * NWAVES;
    unsigned char* ws = P.ws;
    float* mod = (float*)(ws + WS_MOD);
    bf16* Abuf = (bf16*)(ws + WS_A); bf16* Hbuf = (bf16*)(ws + WS_H);
    float* out = P.out;
    for (int ph = P.ph_lo; ph < P.ph_hi; ++ph) {
        const int tid = opaque_tid(), lane = tid & 63, wave = __builtin_amdgcn_readfirstlane(tid >> 6); const int gw = vcu * NWAVES + wave;
        int type = 0;
        int l = 0, f = 0, nmode = 0, ln_idx = 0, modoff = 0; const float* xsrc = out;
        const bf16* rA = Hbuf; const bf16* rB = nullptr; int rK = F; float rgs = 0.5f;
        switch (ph) {
            case 0: type = 0; break;
            case 1: type = 1; l = 0; nmode = 0; ln_idx = I_LNF1; modoff = 0; xsrc = P.in[I_X]; break;
            case 2: type = 2; l = 0; f = 0; break;
            case 3: type = 3; l = 0; rB = (const bf16*)(ws + WS_W + 0 * W_FFN_STRIDE + W_GU_BYTES); modoff = 2048; xsrc = P.in[I_X]; break;
            case 4: type = 1; l = 0; nmode = 0; ln_idx = I_LNMIX; modoff = 3072; break;
            case 5: type = 4; break;
            case 6: type = 5; break;
            case 7: type = 3; l = 0; rA = Abuf; rB = (const bf16*)(ws + WS_WO); rK = D; rgs = 1.0f; modoff = 5120; break;
            case 8: type = 1; l = 0; nmode = 0; ln_idx = I_LNF2; modoff = 6144; break;
            case 9: type = 2; l = 0; f = 1; break;
            case 10: type = 3; l = 0; rB = (const bf16*)(ws + WS_W + 1 * W_FFN_STRIDE + W_GU_BYTES); modoff = 8192; break;
            case 11: type = 1; l = 1; nmode = 1; ln_idx = I_LNF1; modoff = 0; break;
            case 12: type = 2; l = 1; f = 0; break;
            case 13: type = 3; l = 1; rB = (const bf16*)(ws + WS_W + 2 * W_FFN_STRIDE + W_GU_BYTES); modoff = 2048; break;
            case 14: type = 1; l = 1; nmode = 0; ln_idx = I_LNMIX; modoff = 3072; break;
            case 15: type = 6; break;
            case 16: type = 7; break;
            case 17: type = 3; l = 1; rA = (const bf16*)(ws + WS_G); rB = (const bf16*)(ws + WS_WOUT); rK = D; rgs = 1.0f; modoff = 5120; break;
            case 18: type = 1; l = 1; nmode = 0; ln_idx = I_LNF2; modoff = 6144; break;
            case 19: type = 2; l = 1; f = 1; break;
            case 20: type = 3; l = 1; rB = (const bf16*)(ws + WS_W + 3 * W_FFN_STRIDE + W_GU_BYTES); modoff = 8192; break;
            default: type = 1; l = 1; nmode = 2; break;
        }
        const float* modl = mod + (size_t)l * 4 * NMOD;
        if ((PHMASK & 1) && type == 0) {
            convert_weights(P, lds, gw, NGW, wave, lane);
            ada_phase(P, lds, vcu, G, tid, wave, lane);
        } else if ((PHMASK & 2) && type == 1) {
            const float* gout = P.in[I_LNOUT] + (nmode == 1 ? 0 : D);
            norm_phase(xsrc, out, gout, Abuf, (ln_idx == I_LNF1 ? P.in[I_LNF1] : (ln_idx == I_LNMIX ? P.in[I_LNMIX] : P.in[I_LNF2])) + (size_t)l * D, modl + modoff, modl + modoff + 1024, nmode, gw, NGW, lane);
        } else if ((PHMASK & 32) && type == 5) {
            const float p1 = wave_sum(P.in[I_LQ1][lane] * P.in[I_LK1][lane]), p2 = wave_sum(P.in[I_LQ2][lane] * P.in[I_LK2][lane]);
            const float lam = expf(p1) - expf(p2) + 0.2f;
            const float kmaxn = wave_max(fabsf(P.in[I_KN][lane])) * 8.0f * 1.02f;
            for (int v = vcu; v < 256; v += G) {
                const int bh = v >> 3, j = v & 7;
                for (int i = 0; i < 8; ++i) { const int s = j + 8 * (i >> 1); const int qb = (i & 1) ? 63 - s : s;
                    att::attn_unit(bh >> 3, bh & 7, qb, (const bf16*)(ws + WS_Q), (const bf16*)(ws + WS_K), (const bf16*)(ws + WS_V), Abuf, lds, P.in[I_RELB], lam, kmaxn, P.in[I_SUBLN], 0.8f); }
            }
        } else if ((PHMASK & 4) && (type == 2 || type == 3 || type == 4 || type == 6)) {
            pg8::EpiMulti E{}; const bf16* gA = Abuf; const bf16* gB = nullptr; int gN = D, gK = D;
            if (type == 2) { E.kind = 0; E.p0 = Hbuf; E.i0 = F; gB = (const bf16*)(ws + WS_W + (size_t)(l * 2 + f) * W_FFN_STRIDE); gN = 2 * F; }
            else if (type == 3) { E.kind = 1; E.g0 = xsrc; E.p0 = out; E.g1 = modl + modoff; E.f0 = rgs; gA = rA; gB = rB; gK = rK; }
            else if (type == 4) { E.kind = 2; E.p0 = ws + WS_Q; E.p1 = ws + WS_K; E.p2 = ws + WS_V; E.g0 = P.in[I_QN]; E.g1 = P.in[I_KN]; E.f0 = att::C2; gB = (const bf16*)(ws + WS_WQKV); gN = 3 * D; }
            else { E.kind = 3; E.p0 = ws + WS_Z; E.i0 = 2048; gB = (const bf16*)(ws + WS_WIN); gN = 2048; }
            run_gemm(lds, gA, gB, gN, gK, G, E);
        } else if (PHMASK & 128) {
            sgu_phase(P, lds, vcu, G, tid, wave, lane);
        }
        if (ph + 1 < P.ph_hi) grid.sync();
    }
}

#ifndef N_LAUNCH_MODE
#define N_LAUNCH_MODE 1
#endif
extern "C" void kernel_launch(void* const* d_in, const int* in_sizes, int n_in, void* d_out, int out_size, void* d_ws, size_t ws_size, hipStream_t stream) {
    static int grid = 0;
    if (grid == 0) {
        if (n_in != 30 || out_size != M * D || ws_size < WS_END) { fprintf(stderr, "kernel_launch: unexpected problem (n_in %d out %d ws %zu)\n", n_in, out_size, ws_size); grid = -1; return; }
        int dev = 0, cus = 0, per_cu = 0;
        hipGetDevice(&dev); hipDeviceGetAttribute(&cus, hipDeviceAttributeMultiprocessorCount, dev);
        if (hipFuncSetAttribute((const void*)mega_fwd, hipFuncAttributeMaxDynamicSharedMemorySize, LDS_BYTES) != hipSuccess) { fprintf(stderr, "kernel_launch: hipFuncSetAttribute failed\n"); grid = -1; return; }
        if (hipOccupancyMaxActiveBlocksPerMultiprocessor(&per_cu, (const void*)mega_fwd, NTHREADS, LDS_BYTES) != hipSuccess || per_cu < 1) { fprintf(stderr, "kernel_launch: occupancy query gives %d\n", per_cu); per_cu = 1; }
        (void)hipGetLastError();
        grid = cus * 1;
        if (grid <= 0) grid = 256;
    }
    if (grid < 0) return;
    Params p{};
    for (int i = 0; i < 30; ++i) p.in[i] = (const float*)d_in[i];
    p.out = (float*)d_out; p.ws = (unsigned char*)d_ws;
#if N_LAUNCH_MODE == 1
    for (int ph = 0; ph < NPHASE; ++ph) { p.ph_lo = ph; p.ph_hi = ph + 1; hipLaunchKernelGGL(mega_fwd, dim3(grid), dim3(NTHREADS), LDS_BYTES, stream, p); }
#else
    p.ph_lo = 0; p.ph_hi = NPHASE;
    void* args[] = {&p};
    hipError_t e = hipLaunchCooperativeKernel((const void*)mega_fwd, dim3(grid), dim3(NTHREADS), args, LDS_BYTES, stream);
    if (e != hipSuccess) fprintf(stderr, "cooperative launch failed: %s (grid %d)\n", hipGetErrorString(e), grid);
#endif
}
```

```cpp
#include <hip/hip_runtime.h>
#include <hip/hip_cooperative_groups.h>
#include <cstdio>
#include <cstdint>
#include <cmath>
namespace cg = cooperative_groups;
template <int MASK> __device__ __forceinline__ float xadd(float v) {
    if constexpr (MASK == 32) { auto rr = __builtin_amdgcn_permlane32_swap(__float_as_uint(v), __float_as_uint(v), false, false); return __uint_as_float(rr[0]) + __uint_as_float(rr[1]); }
    else return v + __uint_as_float((unsigned)__builtin_amdgcn_ds_swizzle((int)__float_as_uint(v), (MASK << 10) | 0x1f));
}
template <int MASK> __device__ __forceinline__ float xmax(float v) {
    if constexpr (MASK == 32) { auto rr = __builtin_amdgcn_permlane32_swap(__float_as_uint(v), __float_as_uint(v), false, false); return fmaxf(__uint_as_float(rr[0]), __uint_as_float(rr[1])); }
    else return fmaxf(v, __uint_as_float((unsigned)__builtin_amdgcn_ds_swizzle((int)__float_as_uint(v), (MASK << 10) | 0x1f)));
}
__device__ __forceinline__ float wave_sum(float v) { v = xadd<1>(v); v = xadd<2>(v); v = xadd<4>(v); v = xadd<8>(v); v = xadd<16>(v); return xadd<32>(v); }
__device__ __forceinline__ float wave_max(float v) { v = xmax<1>(v); v = xmax<2>(v); v = xmax<4>(v); v = xmax<8>(v); v = xmax<16>(v); return xmax<32>(v); }
__device__ __forceinline__ int opaque_tid() { int t = threadIdx.x; asm volatile("" : "+v"(t)); return t; }
namespace pg8 {
#define PG8_LAS __attribute__((address_space(3)))
typedef unsigned short bf16_t;
typedef short bf16x8 __attribute__((ext_vector_type(8)));
typedef float f32x4 __attribute__((ext_vector_type(4)));
typedef unsigned u32x4 __attribute__((ext_vector_type(4)));
constexpr int BM = 256, BK = 64, HALF = 128, HTB = HALF * BK * 2  , STAGE_BYTES = 8 * HTB, NXCD = 8, WGM = 8;

__host__ __device__ __forceinline__ int lds_byte(int r, int c) { const int st = (r >> 4) * 2 + (c >> 5), rr = r & 15, cc = c & 31, ob = rr * 64 + cc * 2; return st * 1024 + (ob ^ (((ob >> 9) & 1) << 5)); }
__host__ __device__ __forceinline__ void stage_rc(int b, int& R, int& C) { const int st = b / 1024, sb = b % 1024, swz = sb ^ (((sb >> 9) & 1) << 5); R = (st >> 1) * 16 + swz / 64; C = (st & 1) * 32 + (swz % 64) / 2; }
__host__ __device__ __forceinline__ int perm32(int rho) { const int n = rho >> 4, i = rho & 15; return 8 * (i >> 2) + 4 * n + (i & 3); }

struct Unit { int pm, pn; };
struct Gemm { const bf16_t* A; const bf16_t* Bt; int M, N, K; };

struct StaticOrder {
    int nM, nN, nwg, G, c;
    __host__ __device__ void init(int M, int N, int G_, int c_) { nM = M / BM; nN = N / BM; nwg = nM * nN; G = G_; c = c_; }
    __host__ __device__ bool next(int i, Unit& u) const {
        const long L = (long)i * G + c; if (L >= nwg) return false;
        int wgid = (int)L; { const int q = nwg / NXCD, r = nwg % NXCD, xcd = wgid % NXCD, off = wgid / NXCD; wgid = (xcd < r ? xcd * (q + 1) : r * (q + 1) + (xcd - r) * q) + off; }
        const int nig = WGM * nN, gid = wgid / nig, fm = gid * WGM, gsz = (nM - fm) < WGM ? (nM - fm) : WGM;
        u.pm = fm + ((wgid % nig) % gsz); u.pn = (wgid % nig) / gsz; return true;
    }
    __device__ __forceinline__ void a_ready(const Unit&) const {}
    __device__ __forceinline__ void done(const Unit&) const {}
};

__device__ __forceinline__ unsigned cvt_pk_bf16(float lo, float hi) { unsigned r; asm volatile("v_cvt_pk_bf16_f32 %0, %1, %2" : "=v"(r) : "v"(lo), "v"(hi)); return r; }
typedef float f32x2 __attribute__((ext_vector_type(2)));
__device__ __forceinline__ f32x2 gelu_pk(f32x2 v) {
    const f32x2 av = __builtin_elementwise_abs(v), d = av * 0.2316418882f + 1.0f;
    f32x2 t; t.x = __builtin_amdgcn_rcpf(d.x); t.y = __builtin_amdgcn_rcpf(d.y);
    f32x2 q = t * 0.5307027145f + (-0.7265760135f); q = q * t + 0.7107068705f; q = q * t + (-0.142248368f); q = q * t + 0.127414796f; q = q * t;
    const f32x2 s = (v * v) * (-0.72134752044f);
    f32x2 e; e.x = __builtin_amdgcn_exp2f(s.x); e.y = __builtin_amdgcn_exp2f(s.y);
    const f32x2 m = v * (q * e), r = v - m;
    f32x2 o; o.x = v.x < 0.f ? m.x : r.x; o.y = v.y < 0.f ? m.y : r.y; return o;
}
typedef unsigned u32x2 __attribute__((ext_vector_type(2)));
__device__ __forceinline__ float silu_f(float g) { return g * __builtin_amdgcn_rcpf(1.0f + __builtin_amdgcn_exp2f(-1.4426950408889634f * g)); }
__device__ __forceinline__ float row_scale(const float* ssqA, const float* ssqB, int row) {
    float r = __builtin_amdgcn_rsqf(ssqA[row] * (1.0f / 1024.0f) + 1e-6f);
    if (ssqB) r *= __builtin_amdgcn_rsqf(r * r * ssqB[row] * (1.0f / 1024.0f) + 1e-6f);
    return r;
}

struct EpiSwiglu {
    static constexpr bool PERM = true, AFTER_DRAIN = false;
    static __device__ __forceinline__ void run(const f32x4 (&acc)[2][2][4][2], const Unit& u, int wr, int wc, int fr, int fq, bf16_t* H, int ldh, const float* ssqA, const float* ssqB, const float* bvec) {
        const int b = (u.pm * BM) >> 13; const int row0 = u.pm * BM + wr * 64 + fr; const int col0 = u.pn * 128 + wc * 32 + 8 * fq;
        const float* bp = bvec + ((unsigned)b * (unsigned)(2 * ldh) + (unsigned)(u.pn * BM + wc * 32 + 8 * fq));
        const f32x4 bg0 = *(const f32x4*)bp * 1.4426950408889634f, bg1 = *(const f32x4*)(bp + 4) * 1.4426950408889634f, bu0 = *(const f32x4*)(bp + HALF) * 0.6931471805599453f, bu1 = *(const f32x4*)(bp + HALF + 4) * 0.6931471805599453f;
#define SWG_(gv, uv) ((gv) * (uv) * __builtin_amdgcn_rcpf(1.0f + __builtin_amdgcn_exp2f(-(gv))))
#pragma unroll
        for (int ai = 0; ai < 2; ++ai)
#pragma unroll
            for (int m = 0; m < 4; ++m) {
                const int row = row0 + ai * HALF + m * 16; const float r = row_scale(ssqA, ssqB, row); const float rg = r * 1.4426950408889634f, ru = r * 0.6931471805599453f;
                bf16_t* p = H + ((unsigned)row * (unsigned)ldh + (unsigned)col0);
                const f32x4 g0 = acc[ai][0][m][0] * rg + bg0, g1 = acc[ai][0][m][1] * rg + bg1, u0 = acc[ai][1][m][0] * ru + bu0, u1 = acc[ai][1][m][1] * ru + bu1;
                u32x4 w;
                w.x = cvt_pk_bf16(SWG_(g0[0], u0[0]), SWG_(g0[1], u0[1]));
                w.y = cvt_pk_bf16(SWG_(g0[2], u0[2]), SWG_(g0[3], u0[3]));
                w.z = cvt_pk_bf16(SWG_(g1[0], u1[0]), SWG_(g1[1], u1[1]));
                w.w = cvt_pk_bf16(SWG_(g1[2], u1[2]), SWG_(g1[3], u1[3]));
                __builtin_nontemporal_store(w, (u32x4*)p);
                asm volatile("" ::: "memory");
            }
    }
};

struct EpiGelu {
    static constexpr bool PERM = true, AFTER_DRAIN = false;
    static __device__ __forceinline__ void run(const f32x4 (&acc)[2][2][4][2], const Unit& u, int wr, int wc, int fr, int fq, bf16_t* O, int ldc, const float* ssqA, const float* bvec) {
        const int b = (u.pm * BM) >> 13; const int row0 = u.pm * BM + wr * 64 + fr; const int col0 = u.pn * BM + wc * 32 + 8 * fq;
        const float* bp = bvec + ((unsigned)b * (unsigned)ldc + (unsigned)col0);
        f32x4 bv[2][2];
#pragma unroll
        for (int bj = 0; bj < 2; ++bj)
#pragma unroll
            for (int n = 0; n < 2; ++n) bv[bj][n] = *(const f32x4*)(bp + bj * HALF + 4 * n);
#pragma unroll
        for (int ai = 0; ai < 2; ++ai)
#pragma unroll
            for (int m = 0; m < 4; ++m) { const int row = row0 + ai * HALF + m * 16; const float r = row_scale(ssqA, nullptr, row); bf16_t* rowp = O + ((unsigned)row * (unsigned)ldc + (unsigned)col0);
#pragma unroll
                for (int bj = 0; bj < 2; ++bj) { const f32x4 v0 = acc[ai][bj][m][0] * r + bv[bj][0], v1 = acc[ai][bj][m][1] * r + bv[bj][1];
                    const f32x2 a = gelu_pk((f32x2){v0[0], v0[1]}), b2 = gelu_pk((f32x2){v0[2], v0[3]}), c = gelu_pk((f32x2){v1[0], v1[1]}), d = gelu_pk((f32x2){v1[2], v1[3]});
                    u32x4 w; w.x = cvt_pk_bf16(a.x, a.y); w.y = cvt_pk_bf16(b2.x, b2.y); w.z = cvt_pk_bf16(c.x, c.y); w.w = cvt_pk_bf16(d.x, d.y);
                    *(u32x4*)(rowp + bj * HALF) = w; }
                asm volatile("" ::: "memory"); }
    }
};

struct EpiQKV {
    static constexpr bool PERM = true, AFTER_DRAIN = false;
    static __device__ __forceinline__ void run(const f32x4 (&acc)[2][2][4][2], const Unit& u, int wr, int wc, int fr, int fq, bf16_t* Q, bf16_t* K, bf16_t* V, const float* qg, const float* kg, float qscale, const float* ssqA, const float* bvec) {
        const int b = (u.pm * BM) >> 13; const int sect = u.pn >> 2; const int row0 = u.pm * BM + wr * 64 + fr; const int colb = (u.pn & 3) * 256 + 64 * wc + 8 * fq;
        bf16_t* base = sect == 0 ? Q : (sect == 1 ? K : V);
        const float* gp = (sect == 0 ? qg : kg) + 8 * fq; const float sc = sect == 0 ? qscale : 1.0f;
        const float* bp = bvec + ((unsigned)b * 3072u + (unsigned)(u.pn * BM + wc * 32 + 8 * fq));
#pragma unroll
        for (int ai = 0; ai < 2; ++ai)
#pragma unroll
            for (int m = 0; m < 4; ++m) {
                const int row = row0 + ai * HALF + m * 16; const float r = row_scale(ssqA, nullptr, row);
                f32x4 v[2][2]; float ss = 0.f;
#pragma unroll
                for (int bj = 0; bj < 2; ++bj)
#pragma unroll
                    for (int n = 0; n < 2; ++n) { const f32x4 x = acc[ai][bj][m][n] * r + *(const f32x4*)(bp + bj * HALF + 4 * n); v[bj][n] = x; ss += (x[0] * x[0] + x[1] * x[1]) + (x[2] * x[2] + x[3] * x[3]); }
                ss = xadd<16>(ss); ss = xadd<32>(ss);
                const float rs = sect < 2 ? __builtin_amdgcn_rsqf(ss * (1.0f / 64.0f) + 1e-6f) * sc : 1.0f;
                bf16_t* rowp = base + ((unsigned)row * 1024u + (unsigned)colb);
#pragma unroll
                for (int bj = 0; bj < 2; ++bj) {
                    f32x4 v0 = v[bj][0] * rs, v1 = v[bj][1] * rs;
                    if (sect < 2) { v0 = v0 * *(const f32x4*)(gp + 32 * bj); v1 = v1 * *(const f32x4*)(gp + 32 * bj + 4); }
                    u32x4 w; w.x = cvt_pk_bf16(v0[0], v0[1]); w.y = cvt_pk_bf16(v0[2], v0[3]); w.z = cvt_pk_bf16(v1[0], v1[1]); w.w = cvt_pk_bf16(v1[2], v1[3]);
                    *(u32x4*)(rowp + 32 * bj) = w; }
                asm volatile("" ::: "memory");
            }
    }
};

template <bool LAZY, bool WG2> struct EpiResidT {
    static constexpr bool PERM = true, AFTER_DRAIN = false;
    static __device__ __forceinline__ void run(const f32x4 (&acc)[2][2][4][2], const Unit& u, int wr, int wc, int fr, int fq, const float* xin, float* xout, const float* gate, float gs, const float* lazy_ssq, const float* lazy_g,
                                                bf16_t* aout, const float* wg, const float* wsc, const float* wg2, float* ssq_out, float* ssqB_out) {
        const unsigned b = (unsigned)(u.pm * BM) >> 13; const unsigned row0 = u.pm * BM + wr * 64 + fr; const unsigned col0 = u.pn * BM + wc * 32 + 8 * fq;
        float rl[2][4], sq[2][4], sqb[2][4];
#pragma unroll
        for (int ai = 0; ai < 2; ++ai)
#pragma unroll
            for (int m = 0; m < 4; ++m) { rl[ai][m] = LAZY ? __builtin_amdgcn_rsqf(lazy_ssq[row0 + ai * HALF + m * 16] * (1.0f / 1024.0f) + 1e-6f) : 1.0f; sq[ai][m] = 0.f; sqb[ai][m] = 0.f; }
#pragma unroll
        for (int bj = 0; bj < 2; ++bj) {
            const unsigned col = col0 + bj * HALF;
            f32x4 gv[2], lg[2], wv[2], w2[2];
#pragma unroll
            for (int n = 0; n < 2; ++n) {
                gv[n] = *(const f32x4*)(gate + (b * 9216u + col + 4 * n)) * gs;
                lg[n] = (f32x4){1.f, 1.f, 1.f, 1.f}; if (LAZY) lg[n] = *(const f32x4*)(lazy_g + col + 4 * n);
                wv[n] = (f32x4){0.f, 0.f, 0.f, 0.f}; w2[n] = (f32x4){1.f, 1.f, 1.f, 1.f};
                if (aout) { wv[n] = *(const f32x4*)(wg + col + 4 * n) * (*(const f32x4*)(wsc + (b * 9216u + col + 4 * n)) + 1.0f); if (WG2) { w2[n] = *(const f32x4*)(wg2 + col + 4 * n); wv[n] = wv[n] * w2[n]; } }
            }
#pragma unroll
            for (int ai = 0; ai < 2; ++ai)
#pragma unroll
                for (int m = 0; m < 4; ++m) { const unsigned off = (row0 + ai * HALF + m * 16) * 1024u + col;
                    const f32x4 xi0 = *(const f32x4*)(xin + off), xi1 = *(const f32x4*)(xin + off + 4);
                    f32x4 xo0 = gv[0] * acc[ai][bj][m][0], xo1 = gv[1] * acc[ai][bj][m][1];
                    if (LAZY) { xo0 = xo0 + xi0 * lg[0] * rl[ai][m]; xo1 = xo1 + xi1 * lg[1] * rl[ai][m]; } else { xo0 = xo0 + xi0; xo1 = xo1 + xi1; }
                    *(f32x4*)(xout + off) = xo0; *(f32x4*)(xout + off + 4) = xo1;
                    if (aout) { const f32x4 a0 = xo0 * wv[0], a1 = xo1 * wv[1]; u32x4 w; w.x = cvt_pk_bf16(a0[0], a0[1]); w.y = cvt_pk_bf16(a0[2], a0[3]); w.z = cvt_pk_bf16(a1[0], a1[1]); w.w = cvt_pk_bf16(a1[2], a1[3]);
                        *(u32x4*)(aout + off) = w;
                        sq[ai][m] += ((xo0[0] * xo0[0] + xo0[1] * xo0[1]) + (xo0[2] * xo0[2] + xo0[3] * xo0[3])) + ((xo1[0] * xo1[0] + xo1[1] * xo1[1]) + (xo1[2] * xo1[2] + xo1[3] * xo1[3]));
                        if (WG2) { const f32x4 b0 = xo0 * w2[0], b1 = xo1 * w2[1]; sqb[ai][m] += ((b0[0] * b0[0] + b0[1] * b0[1]) + (b0[2] * b0[2] + b0[3] * b0[3])) + ((b1[0] * b1[0] + b1[1] * b1[1]) + (b1[2] * b1[2] + b1[3] * b1[3])); } }
                    if (m & 1) asm volatile("" ::: "memory"); }
        }
        if (aout) {
#pragma unroll
            for (int ai = 0; ai < 2; ++ai)
#pragma unroll
                for (int m = 0; m < 4; ++m) { float s = sq[ai][m]; s = xadd<16>(s); s = xadd<32>(s);
                    float sb = sqb[ai][m]; if (WG2) { sb = xadd<16>(sb); sb = xadd<32>(sb); }
                    if (fq == 0) { unsafeAtomicAdd(ssq_out + (row0 + ai * HALF + m * 16), s); if (WG2) unsafeAtomicAdd(ssqB_out + (row0 + ai * HALF + m * 16), sb); } }
        }
    }
};

struct EpiMulti {
    static constexpr bool PERM = true, AFTER_DRAIN = false;
    int kind; int i0; float f0;
    void* p0; void* p1; void* p2; const float* g0; const float* g1; const float* ssqA; const float* ssqB; const float* bvec;
    const float* lazy_ssq; const float* lazy_g; void* aout; const float* wg; const float* wsc; const float* wg2; float* ssq_out; float* ssqB_out;
};

#ifndef EPIMASK
#define EPIMASK 15
#endif
struct EpiLds {
    static constexpr bool PERM = true, AFTER_DRAIN = false;
    const PG8_LAS unsigned* d;
    __device__ __forceinline__ unsigned u(int i) const { return (unsigned)__builtin_amdgcn_readfirstlane((int)d[i]); }
    template <class T> __device__ __forceinline__ T* p(int i) const { const unsigned long long lo = u(i), hi = u(i + 1); return (T*)(__attribute__((address_space(1))) T*)((hi << 32) | lo); }
    __device__ __forceinline__ void operator()(const f32x4 (&acc)[2][2][4][2], const Unit& un, int wr, int wc, int fr, int fq) const {
        const int kind = (int)u(0);
        { const int t_ = opaque_tid(), w_ = __builtin_amdgcn_readfirstlane(t_ >> 6), l_ = t_ & 63; wr = w_ >> 2; wc = w_ & 3; fr = l_ & 15; fq = l_ >> 4; }
        if ((EPIMASK & 1) && kind == 0) EpiSwiglu::run(acc, un, wr, wc, fr, fq, p<bf16_t>(4), (int)u(1), p<const float>(14), p<const float>(16), p<const float>(18));
        else if ((EPIMASK & 2) && kind == 1) EpiResidT<false, false>::run(acc, un, wr, wc, fr, fq, p<const float>(10), p<float>(4), p<const float>(12), __uint_as_float(u(2)), nullptr, nullptr, p<bf16_t>(24), p<const float>(26), p<const float>(28), nullptr, p<float>(32), nullptr);
        else if ((EPIMASK & 2) && kind == 4) EpiResidT<false, true>::run(acc, un, wr, wc, fr, fq, p<const float>(10), p<float>(4), p<const float>(12), __uint_as_float(u(2)), nullptr, nullptr, p<bf16_t>(24), p<const float>(26), p<const float>(28), p<const float>(30), p<float>(32), p<float>(34));
        else if ((EPIMASK & 2) && kind == 5) EpiResidT<true, false>::run(acc, un, wr, wc, fr, fq, p<const float>(10), p<float>(4), p<const float>(12), __uint_as_float(u(2)), p<const float>(20), p<const float>(22), p<bf16_t>(24), p<const float>(26), p<const float>(28), nullptr, p<float>(32), nullptr);
        else if ((EPIMASK & 4) && kind == 2) EpiQKV::run(acc, un, wr, wc, fr, fq, p<bf16_t>(4), p<bf16_t>(6), p<bf16_t>(8), p<const float>(10), p<const float>(12), __uint_as_float(u(2)), p<const float>(14), p<const float>(18));
        else if (EPIMASK & 8) EpiGelu::run(acc, un, wr, wc, fr, fq, p<bf16_t>(4), (int)u(1), p<const float>(14), p<const float>(18));
    }
};

template <class Epi, class Sched, bool ALIGN_EPI = false, bool SP2 = false>
__device__ __forceinline__ void gemm_phase(PG8_LAS unsigned char* lds, const Gemm g, const Sched& S, const Epi& E) {
    const int tid = opaque_tid(), wid = __builtin_amdgcn_readfirstlane(tid >> 6), lane = tid & 63, wr = wid >> 2, wc = wid & 3, fr = lane & 15, fq = lane >> 4;
    const int K = g.K, nt = K / BK;
    unsigned voffA[2], voffB[2];
#pragma unroll
    for (int i = 0; i < 2; ++i) { int R, C; stage_rc(tid * 16 + i * 8192, R, C); const int Rb = Epi::PERM ? ((R & ~31) + perm32(R & 31)) : R;
        voffA[i] = (unsigned)(R * K + C) * 2u; voffB[i] = (unsigned)(Rb * K + C) * 2u; }
    const size_t kstep = (size_t)(BK * 2);
    const size_t hstep = (size_t)HALF * K * 2;
    const size_t tstep = 2 * hstep;
    const unsigned ldsw = (unsigned)wid * 1024u;
    const int aoff = lds_byte(wr * 64 + fr, fq * 8), boff = lds_byte(wc * 32 + fr, fq * 8);
#define PG8_SA(b, h) (((b) * 2 + (h)) * HTB)
#define PG8_SB(b, h) ((4 + (b) * 2 + (h)) * HTB)
#define PG8_STAGE(bufoff, gbase, voff) do { _Pragma("unroll") for (int _i = 0; _i < 2; ++_i) \
        __builtin_amdgcn_global_load_lds((const unsigned*)((const char*)(gbase) + (voff)[_i]), (PG8_LAS unsigned*)(lds + (bufoff) + ldsw + _i * 8192), 16, 0, 0); } while (0)
#define PG8_LDA(dst, b, h) do { _Pragma("unroll") for (int m = 0; m < 4; ++m) _Pragma("unroll") for (int k = 0; k < 2; ++k) dst[m][k] = *(const PG8_LAS bf16x8*)(lds + PG8_SA(b, h) + aoff + m * 2048 + k * 1024); } while (0)
#define PG8_LDB(dst, b, h) do { _Pragma("unroll") for (int n = 0; n < 2; ++n) _Pragma("unroll") for (int k = 0; k < 2; ++k) dst[n][k] = *(const PG8_LAS bf16x8*)(lds + PG8_SB(b, h) + boff + n * 2048 + k * 1024); } while (0)
#define PG8_MMA(ai, bj, At, Bt) do { __builtin_amdgcn_s_setprio(1); _Pragma("unroll") for (int m = 0; m < 4; ++m) _Pragma("unroll") for (int n = 0; n < 2; ++n) _Pragma("unroll") for (int k = 0; k < 2; ++k) \
        acc[ai][bj][m][n] = __builtin_amdgcn_mfma_f32_16x16x32_bf16(Bt[n][k], At[m][k], acc[ai][bj][m][n], 0, 0, 0); __builtin_amdgcn_s_setprio(0); } while (0)
#define PG8_WAIT_V(n) asm volatile("s_waitcnt vmcnt(" #n ")" ::: "memory")
#define PG8_WAIT_L(n) asm volatile("s_waitcnt lgkmcnt(" #n ")" ::: "memory")
#define PG8_BAR __builtin_amdgcn_s_barrier()
#define PG8_SCHED __builtin_amdgcn_sched_barrier(0)
    Unit cur, nxt; int ui = 0;
    if (!S.next(0, cur)) return;
    f32x4 acc[2][2][4][2];
#pragma unroll
    for (int a = 0; a < 2; ++a)
#pragma unroll
        for (int b = 0; b < 2; ++b)
#pragma unroll
            for (int m = 0; m < 4; ++m)
#pragma unroll
                for (int n = 0; n < 2; ++n) acc[a][b][m][n] = (f32x4){0.f, 0.f, 0.f, 0.f};
    bf16x8 At[4][2], B0[2][2], B1[2][2];
    const char* cA = (const char*)g.A + (size_t)cur.pm * tstep; const char* cB = (const char*)g.Bt + (size_t)cur.pn * tstep;
    S.a_ready(cur);
    if constexpr (SP2) {
        PG8_STAGE(PG8_SB(0, 0), cB, voffB); PG8_STAGE(PG8_SB(0, 1), cB + hstep, voffB); PG8_STAGE(PG8_SA(0, 0), cA, voffA); PG8_STAGE(PG8_SA(0, 1), cA + hstep, voffA);
        if (wr == 1) PG8_BAR;
        PG8_WAIT_V(2); PG8_BAR;
        PG8_STAGE(PG8_SB(1, 0), cB + kstep, voffB); PG8_STAGE(PG8_SA(1, 0), cA + kstep, voffA); PG8_STAGE(PG8_SB(1, 1), cB + hstep + kstep, voffB);
        PG8_WAIT_V(6); PG8_BAR;
    } else {
        PG8_STAGE(PG8_SB(0, 0), cB, voffB); PG8_STAGE(PG8_SA(0, 0), cA, voffA); PG8_STAGE(PG8_SB(0, 1), cB + hstep, voffB); PG8_STAGE(PG8_SA(0, 1), cA + hstep, voffA);
        if (wr == 1) PG8_BAR;
        PG8_WAIT_V(4); PG8_BAR;
        PG8_STAGE(PG8_SB(1, 0), cB + kstep, voffB); PG8_STAGE(PG8_SA(1, 0), cA + kstep, voffA); PG8_STAGE(PG8_SB(1, 1), cB + hstep + kstep, voffB);
        PG8_WAIT_V(6); PG8_BAR;
    }
    for (;;) {
        const bool has_next = S.next(ui + 1, nxt);
        const char* nA = has_next ? (const char*)g.A + (size_t)nxt.pm * tstep : cA; const char* nB = has_next ? (const char*)g.Bt + (size_t)nxt.pn * tstep : cB;
        for (int t = 0; t < nt; t += 2) {
            const bool last = (t == nt - 2);
            const char* a1 = cA + (size_t)(t + 1) * kstep;
            const char* a2 = last ? nA : cA + (size_t)(t + 2) * kstep; const char* b2 = last ? nB : cB + (size_t)(t + 2) * kstep;
            const char* a3 = a2 + kstep; const char* b3 = b2 + kstep;
            if (last && has_next) S.a_ready(nxt);
            if constexpr (SP2) {
            PG8_LDB(B0, 0, 0); PG8_LDB(B1, 0, 1); PG8_SCHED; PG8_LDA(At, 0, 0); PG8_STAGE(PG8_SA(1, 1), a1 + hstep, voffA);
            PG8_WAIT_V(8); PG8_WAIT_L(0); PG8_BAR; PG8_MMA(0, 0, At, B0); PG8_MMA(0, 1, At, B1); PG8_BAR; PG8_SCHED;
            PG8_LDA(At, 0, 1); PG8_STAGE(PG8_SB(0, 0), b2, voffB); PG8_STAGE(PG8_SB(0, 1), b2 + hstep, voffB); PG8_STAGE(PG8_SA(0, 0), a2, voffA);
            PG8_WAIT_V(8); PG8_WAIT_L(0); PG8_BAR; PG8_MMA(1, 0, At, B0); PG8_MMA(1, 1, At, B1); PG8_BAR; PG8_SCHED;
            PG8_LDB(B0, 1, 0); PG8_LDB(B1, 1, 1); PG8_SCHED; PG8_LDA(At, 1, 0); PG8_STAGE(PG8_SA(0, 1), a2 + hstep, voffA);
            PG8_WAIT_V(8); PG8_WAIT_L(0); PG8_BAR; PG8_MMA(0, 0, At, B0); PG8_MMA(0, 1, At, B1); PG8_BAR; PG8_SCHED;
            PG8_LDA(At, 1, 1); PG8_STAGE(PG8_SB(1, 0), b3, voffB); PG8_STAGE(PG8_SB(1, 1), b3 + hstep, voffB); PG8_STAGE(PG8_SA(1, 0), a3, voffA);
            PG8_WAIT_V(8); PG8_WAIT_L(0); PG8_BAR; PG8_MMA(1, 0, At, B0); PG8_MMA(1, 1, At, B1); PG8_BAR; PG8_SCHED;
            } else {
            PG8_LDB(B0, 0, 0); PG8_SCHED; PG8_LDA(At, 0, 0); PG8_STAGE(PG8_SA(1, 1), a1 + hstep, voffA);
            PG8_WAIT_L(8); PG8_BAR; PG8_WAIT_L(0); PG8_MMA(0, 0, At, B0); PG8_BAR; PG8_SCHED;
            PG8_LDB(B1, 0, 1); PG8_STAGE(PG8_SB(0, 0), b2, voffB);
            PG8_BAR; PG8_WAIT_L(0); PG8_MMA(0, 1, At, B1); PG8_BAR;
            PG8_LDA(At, 0, 1); PG8_STAGE(PG8_SA(0, 0), a2, voffA);
            PG8_BAR; PG8_WAIT_L(0); PG8_MMA(1, 0, At, B0); PG8_BAR; PG8_SCHED;
            PG8_STAGE(PG8_SB(0, 1), b2 + hstep, voffB);
            PG8_WAIT_V(6); PG8_BAR; PG8_MMA(1, 1, At, B1); PG8_BAR;
            PG8_LDB(B0, 1, 0); PG8_SCHED; PG8_LDA(At, 1, 0); PG8_STAGE(PG8_SA(0, 1), a2 + hstep, voffA);
            PG8_WAIT_L(8); PG8_BAR; PG8_WAIT_L(0); PG8_MMA(0, 0, At, B0); PG8_BAR; PG8_SCHED;
            PG8_LDB(B1, 1, 1); PG8_STAGE(PG8_SB(1, 0), b3, voffB);
            PG8_BAR; PG8_WAIT_L(0); PG8_MMA(0, 1, At, B1); PG8_BAR;
            PG8_LDA(At, 1, 1); PG8_STAGE(PG8_SA(1, 0), a3, voffA);
            PG8_BAR; PG8_WAIT_L(0); PG8_MMA(1, 0, At, B0); PG8_BAR; PG8_SCHED;
            PG8_STAGE(PG8_SB(1, 1), b3 + hstep, voffB);
            PG8_WAIT_V(6); PG8_BAR; PG8_MMA(1, 1, At, B1); PG8_BAR;
            }
        }
        if constexpr (ALIGN_EPI) { if (wr == 0) PG8_BAR; }
        if constexpr (!Epi::AFTER_DRAIN) { E(acc, cur, wr, wc, fr, fq); S.done(cur); }
        if (!has_next) break;
#pragma unroll
        for (int a = 0; a < 2; ++a)
#pragma unroll
            for (int b = 0; b < 2; ++b)
#pragma unroll
                for (int m = 0; m < 4; ++m)
#pragma unroll
                    for (int n = 0; n < 2; ++n) acc[a][b][m][n] = (f32x4){0.f, 0.f, 0.f, 0.f};
        cur = nxt; cA = nA; cB = nB; ++ui;
        if constexpr (ALIGN_EPI) { if (wr == 1) PG8_BAR; }
    }
    PG8_WAIT_V(0);
    if constexpr (!ALIGN_EPI) { if (wr == 0) PG8_BAR; }
    PG8_BAR;
    if constexpr (Epi::AFTER_DRAIN) { E.fused(acc, cur, wr, wc, fr, fq, lds, wid, lane); S.done(cur); }
#undef PG8_SA
#undef PG8_SB
#undef PG8_STAGE
#undef PG8_LDA
#undef PG8_LDB
#undef PG8_MMA
#undef PG8_WAIT_V
#undef PG8_WAIT_L
#undef PG8_BAR
#undef PG8_SCHED
}
}

namespace att {
#define ALDS __attribute__((address_space(3)))
typedef short bf16x8 __attribute__((ext_vector_type(8)));
typedef short s16x4 __attribute__((ext_vector_type(4)));
typedef float f32x16 __attribute__((ext_vector_type(16)));
typedef float f32x2 __attribute__((ext_vector_type(2)));
typedef unsigned u32x4 __attribute__((ext_vector_type(4)));
typedef unsigned short bf16_t;
constexpr int SEQ = 8192, DM = 1024, KVB = 64, QU = 128, NSLOT = 4, SLOT = 16384;
constexpr int L_K = 0, L_V = NSLOT * SLOT, L_LUT = 131072, L_LB = L_LUT + 512;
constexpr float LOG2E = 1.4426950408889634f, C2 = 0.125f * LOG2E;
__device__ __forceinline__ int crow(int r, int hi) { return (r & 3) + 8 * (r >> 2) + 4 * hi; }
__device__ __forceinline__ void glds16(const void* gsrc, unsigned lds_dst) { unsigned keep;
    asm volatile("s_mov_b32 %0, m0\n\ts_mov_b32 m0, %2\n\ts_nop 0\n\tglobal_load_lds_dwordx4 %1, off\n\ts_mov_b32 m0, %0" : "=&s"(keep) : "v"(gsrc), "s"(lds_dst) : "memory"); }
__device__ __forceinline__ void glds16s(unsigned voff, const void* sbase, unsigned lds_dst) { unsigned keep;
    asm volatile("s_mov_b32 %0, m0\n\ts_mov_b32 m0, %3\n\ts_nop 0\n\tglobal_load_lds_dwordx4 %1, %2\n\ts_mov_b32 m0, %0" : "=&s"(keep) : "v"(voff), "s"(sbase), "s"(lds_dst) : "memory"); }
__device__ __forceinline__ unsigned cvtpk(float lo, float hi) { typedef float f2 __attribute__((ext_vector_type(2))); typedef __bf16 b2 __attribute__((ext_vector_type(2)));
    f2 v = {lo, hi}; b2 r = __builtin_convertvector(v, b2); return __builtin_bit_cast(unsigned, r); }
__device__ __forceinline__ float bf2f(short s) { return __uint_as_float(((unsigned)(unsigned short)s) << 16); }
typedef short v4i16_t __attribute__((ext_vector_type(4)));
__device__ __forceinline__ s16x4 vtr(const ALDS unsigned char* p) { return __builtin_bit_cast(s16x4, __builtin_amdgcn_ds_read_tr16_b64_v4i16((ALDS v4i16_t*)p)); }
#define ATT_WAIT_BAR(N) asm volatile("s_waitcnt vmcnt(" #N ") lgkmcnt(0)\n\ts_barrier" ::: "memory")

__device__ __forceinline__ float attn_head_setup(ALDS unsigned char* lds, const float* relb, int h) {
    const int tid = threadIdx.x; ALDS float* lut = (ALDS float*)(lds + L_LUT);
    if (tid < 128) { const int n = tid; int bk; if (n < 16) bk = n; else { const int lg = 16 + (int)(logf((float)n / 16.0f) / logf(8.0f) * 16.0f); bk = lg < 31 ? lg : 31; }
        lut[tid] = (relb[bk * 8 + h] - relb[31 * 8 + h]) * LOG2E; }
    float bmax = -1e30f;
    for (int i = 0; i < 32; ++i) bmax = fmaxf(bmax, relb[i * 8 + h]);
    return (bmax - relb[31 * 8 + h]) * LOG2E;
}
__device__ __forceinline__ void attn_unit(int b, int h, int qb, const bf16_t* Q, const bf16_t* K, const bf16_t* V, bf16_t* O, ALDS unsigned char* lds,
                                          float bmax, float lut31, float lam, float kmaxn, const float* subg, float outscale) {
    const int tid = opaque_tid(), lane = tid & 63, r32 = lane & 31, hi = lane >> 5;
    const int wid = __builtin_amdgcn_readfirstlane(tid >> 6), comp = wid >> 2, qw = wid & 3;
    const long rowbase = (long)b * SEQ; const int q0 = qb * QU;
    const unsigned lds0 = (unsigned)(uintptr_t)lds;
    ALDS float* lut = (ALDS float*)(lds + L_LUT);
    const bf16_t* Kh = K + rowbase * DM + h * 128; const bf16_t* Vh = V + rowbase * DM + h * 128;
    const int gdma = ((lane >> 4) << 2) | (wid & 3);
    const unsigned dof0 = (unsigned)((4 * wid + (lane >> 4)) * DM + ((lane & 15) ^ gdma) * 8) * 2u, dof1 = dof0 + 32u * DM * 2u;
    const unsigned kdst = lds0 + L_K + wid * 1024, vdst = lds0 + L_V + wid * 1024;
#define ATT_DMA(t, s) do { const bf16_t* kt_ = Kh + (long)(t) * KVB * DM; const bf16_t* vt_ = Vh + (long)(t) * KVB * DM; const unsigned so_ = (unsigned)(s) * SLOT; \
        glds16s(dof0, kt_, (unsigned)__builtin_amdgcn_readfirstlane(kdst + so_)); glds16s(dof1, kt_, (unsigned)__builtin_amdgcn_readfirstlane(kdst + so_ + 8192)); \
        glds16s(dof0, vt_, (unsigned)__builtin_amdgcn_readfirstlane(vdst + so_)); glds16s(dof1, vt_, (unsigned)__builtin_amdgcn_readfirstlane(vdst + so_ + 8192)); } while (0)
    const int NT = 2 * (qb + 1);
    ATT_DMA(0, 0); ATT_DMA(1, 1); if (NT > 2) ATT_DMA(2, 2);
    const bf16_t* Qw = Q + (rowbase + q0 + qw * 32 + r32) * DM + h * 128 + comp * 64 + hi * 8;
    bf16x8 qr[4];
#pragma unroll
    for (int d0 = 0; d0 < 4; ++d0) qr[d0] = *(const bf16x8*)(Qw + d0 * 16);
    float ssq = 0.f;
#pragma unroll
    for (int d0 = 0; d0 < 4; ++d0)
#pragma unroll
        for (int i = 0; i < 8; ++i) { const float f = bf2f(qr[d0][i]); ssq += f * f; }
    ssq = xadd<32>(ssq);
    const float bound = sqrtf(ssq) * kmaxn + bmax;
    const bool needshift = __any(bound > 60.0f);
    f32x16 o[4];
#pragma unroll
    for (int d0 = 0; d0 < 4; ++d0)
#pragma unroll
        for (int r = 0; r < 16; ++r) o[d0][r] = 0.f;
    float l = 0.f;
    const int qabs = q0 + qw * 32 + r32;
    const ALDS unsigned char* kp0 = lds + L_K + 256 * r32;
    int kofs[4]; { const int gk = ((r32 & 3) << 2) | ((r32 >> 2) & 3);
#pragma unroll
        for (int d0 = 0; d0 < 4; ++d0) kofs[d0] = 16 * ((8 * comp + 2 * d0 + hi) ^ gk); }
    const ALDS unsigned char* vp0 = lds + L_V;
    int vofs[4][2]; { const int blk = (lane >> 4) & 1, q = (lane & 15) >> 2, p = lane & 3;
#pragma unroll
        for (int c = 0; c < 4; ++c)
#pragma unroll
            for (int t2 = 0; t2 < 2; ++t2) { const int gv = (q << 2) | ((hi + 2 * t2) & 3); vofs[c][t2] = 256 * (4 * hi + 8 * t2 + q) + 16 * ((4 * c + 2 * blk + (p >> 1)) ^ gv) + 8 * (p & 1); } }
    if (NT > 2) ATT_WAIT_BAR(8); else ATT_WAIT_BAR(4);
    bf16x8 kf[8];
#pragma unroll
    for (int d0 = 0; d0 < 4; ++d0) { kf[2 * d0] = *(const ALDS bf16x8*)(kp0 + kofs[d0]); kf[2 * d0 + 1] = *(const ALDS bf16x8*)(kp0 + kofs[d0] + 8192); }
    f32x16 p0, p1; u32x4 w[4]; const f32x16 zero16 = {};
#define ATT_QK(t) do { \
        p0 = __builtin_amdgcn_mfma_f32_32x32x16_bf16(kf[0], qr[0], zero16, 0, 0, 0); p1 = __builtin_amdgcn_mfma_f32_32x32x16_bf16(kf[1], qr[0], zero16, 0, 0, 0); \
        _Pragma("unroll") for (int d0 = 1; d0 < 4; ++d0) { \
            p0 = __builtin_amdgcn_mfma_f32_32x32x16_bf16(kf[2 * d0], qr[d0], p0, 0, 0, 0); \
            p1 = __builtin_amdgcn_mfma_f32_32x32x16_bf16(kf[2 * d0 + 1], qr[d0], p1, 0, 0, 0); } } while (0)
#define ATT_SYNC(t) do { if ((t) + 1 < NT) { \
            if ((t) + 2 < NT) ATT_WAIT_BAR(4); else ATT_WAIT_BAR(0);         \
            if ((t) + 3 < NT) ATT_DMA((t) + 3, ((t) + 3) & 3); \
            const ALDS unsigned char* kp_ = kp0 + (((t) + 1) & 3) * SLOT; \
            _Pragma("unroll") for (int d0 = 0; d0 < 4; ++d0) { kf[2 * d0] = *(const ALDS bf16x8*)(kp_ + kofs[d0]); kf[2 * d0 + 1] = *(const ALDS bf16x8*)(kp_ + kofs[d0] + 8192); } } } while (0)
#define ATT_EXP(t) do { if ((t) >= NT - 4) { const int relb0 = qabs - ((t) * KVB + 4 * hi); \
            _Pragma("unroll") for (int r = 0; r < 16; ++r) { \
                const int rel = relb0 - ((r & 3) + 8 * (r >> 2)); const int rel1 = rel - 32; \
                const float a0 = lut[rel < 0 ? 0 : (rel > 127 ? 127 : rel)], a1 = lut[rel1 < 0 ? 0 : (rel1 > 127 ? 127 : rel1)]; \
                p0[r] = rel < 0 ? -INFINITY : p0[r] + a0; p1[r] = rel1 < 0 ? -INFINITY : p1[r] + a1; } } \
        if (needshift) { _Pragma("unroll") for (int r = 0; r < 16; ++r) { p0[r] -= bound; p1[r] -= bound; } } \
        float sacc = 0.f; \
        _Pragma("unroll") for (int r = 0; r < 16; ++r) { p0[r] = __builtin_amdgcn_exp2f(p0[r]); p1[r] = __builtin_amdgcn_exp2f(p1[r]); sacc += p0[r] + p1[r]; } \
        l += sacc; \
        w[0] = (u32x4){cvtpk(p0[0], p0[1]), cvtpk(p0[2], p0[3]), cvtpk(p0[4], p0[5]), cvtpk(p0[6], p0[7])}; \
        w[1] = (u32x4){cvtpk(p0[8], p0[9]), cvtpk(p0[10], p0[11]), cvtpk(p0[12], p0[13]), cvtpk(p0[14], p0[15])}; \
        w[2] = (u32x4){cvtpk(p1[0], p1[1]), cvtpk(p1[2], p1[3]), cvtpk(p1[4], p1[5]), cvtpk(p1[6], p1[7])}; \
        w[3] = (u32x4){cvtpk(p1[8], p1[9]), cvtpk(p1[10], p1[11]), cvtpk(p1[12], p1[13]), cvtpk(p1[14], p1[15])}; } while (0)
#define ATT_PV(t) do { const ALDS unsigned char* vp_ = vp0 + ((t) & 3) * SLOT; \
        _Pragma("unroll") for (int ks = 0; ks < 4; ++ks) { const bf16x8 pa = __builtin_bit_cast(bf16x8, w[ks]); \
            _Pragma("unroll") for (int d0 = 0; d0 < 4; ++d0) { \
                const s16x4 vl = vtr(vp_ + vofs[d0][0] + ks * 4096), vh = vtr(vp_ + vofs[d0][1] + ks * 4096); \
                const bf16x8 vf = (bf16x8){vl[0], vl[1], vl[2], vl[3], vh[0], vh[1], vh[2], vh[3]}; \
                o[d0] = __builtin_amdgcn_mfma_f32_32x32x16_bf16(pa, vf, o[d0], 0, 0, 0); } } } while (0)
    if (comp == 0) {
        for (int t = 0; t < NT; ++t) { ATT_QK(t); ATT_SYNC(t); ATT_EXP(t); ATT_PV(t); }
    } else {
        ATT_QK(0); ATT_EXP(0);
        for (int t = 0; t < NT; ++t) { ATT_SYNC(t); ATT_PV(t); if (t + 1 < NT) { ATT_QK(t + 1); ATT_EXP(t + 1); } }
    }
#undef ATT_QK
#undef ATT_SYNC
#undef ATT_EXP
#undef ATT_PV
    l = xadd<32>(l);
    ATT_WAIT_BAR(0);
    ALDS float* ob = (ALDS float*)lds + comp * (QU * 128);
    ALDS float* lb = (ALDS float*)(lds + L_LB);
    if (hi == 0) lb[comp * QU + qw * 32 + r32] = l;
#pragma unroll
    for (int d0 = 0; d0 < 4; ++d0)
#pragma unroll
        for (int r = 0; r < 16; ++r) ob[(qw * 32 + crow(r, hi)) * 128 + d0 * 32 + r32] = o[d0][r];
    ATT_WAIT_BAR(0);
    {
        typedef float f32x4_t __attribute__((ext_vector_type(4)));
        const int rsub = lane >> 4, c16 = lane & 15;
        const f32x4_t sg0 = *(const f32x4_t*)(subg + 8 * c16), sg1 = *(const f32x4_t*)(subg + 8 * c16 + 4);
#pragma unroll
        for (int it = 0; it < 4; ++it) {
            const int q = 16 * wid + 4 * it + rsub;
            const ALDS unsigned char* pa = lds + (q * 128 + 8 * c16) * 4;
            const f32x4_t a0 = *(const ALDS f32x4_t*)pa, a1 = *(const ALDS f32x4_t*)(pa + 16), b0 = *(const ALDS f32x4_t*)(pa + 65536), b1 = *(const ALDS f32x4_t*)(pa + 65536 + 16);
            const float i1 = 1.0f / lb[q], i2 = lam / lb[QU + q];
            const f32x4_t x0 = a0 * i1 - b0 * i2, x1 = a1 * i1 - b1 * i2;
            float ss = ((x0[0] * x0[0] + x0[1] * x0[1]) + (x0[2] * x0[2] + x0[3] * x0[3])) + ((x1[0] * x1[0] + x1[1] * x1[1]) + (x1[2] * x1[2] + x1[3] * x1[3]));
            ss = xadd<1>(ss); ss = xadd<2>(ss); ss = xadd<4>(ss); ss = xadd<8>(ss);
            const float rs = outscale * __builtin_amdgcn_rsqf(ss * (1.0f / 128.0f) + 1e-6f);
            const f32x4_t y0 = x0 * rs * sg0, y1 = x1 * rs * sg1;
            u32x4 w4; w4.x = cvtpk(y0[0], y0[1]); w4.y = cvtpk(y0[2], y0[3]); w4.z = cvtpk(y1[0], y1[1]); w4.w = cvtpk(y1[2], y1[3]);
            *(u32x4*)(O + (rowbase + q0 + q) * DM + h * 128 + 8 * c16) = w4;
        }
    }
    ATT_WAIT_BAR(0);
#undef ATT_DMA
}
}

#define LAS __attribute__((address_space(3)))
typedef unsigned short bf16;
typedef unsigned v4u __attribute__((ext_vector_type(4)));
typedef unsigned v2u __attribute__((ext_vector_type(2)));
typedef float f32x4 __attribute__((ext_vector_type(4)));
typedef float f32x2 __attribute__((ext_vector_type(2)));
typedef short bf16x8 __attribute__((ext_vector_type(8)));
constexpr int NWAVES = 8, NTHREADS = 512;
constexpr int M = 32768, D = 1024, F = 2816, SEQ = 8192, NB = 4, NMOD = 9 * 1024;
constexpr int LDS_BYTES = 147456;
constexpr size_t MiB = 1u << 20;
constexpr size_t WS_MOD = 0;
constexpr size_t WS_BV = 512 * 1024;
constexpr size_t WS_BAR = 960 * 1024;
constexpr size_t WS_SSQ = 1 * MiB;
constexpr size_t WS_W = 2 * MiB;
constexpr size_t W_FFN_STRIDE = 33 * MiB / 2;
constexpr size_t W_GU_BYTES = 11 * MiB;
constexpr size_t WS_WQKV = WS_W + 66 * MiB, WS_WO = WS_W + 72 * MiB, WS_WIN = WS_W + 74 * MiB, WS_WOUT = WS_W + 78 * MiB;
constexpr size_t WS_A = 83 * MiB;
constexpr size_t WS_O = 147 * MiB;
constexpr size_t WS_H = 211 * MiB;
constexpr size_t WS_Q = WS_H, WS_K = WS_H + 64 * MiB, WS_V = WS_H + 128 * MiB;
constexpr size_t WS_Z = WS_H, WS_G = WS_H + 128 * MiB;
constexpr size_t WS_END = 403 * MiB;

__device__ __forceinline__ unsigned pk2(float lo, float hi) { unsigned r; asm volatile("v_cvt_pk_bf16_f32 %0, %1, %2" : "=v"(r) : "v"(lo), "v"(hi)); return r; }
__device__ __forceinline__ float bf_lo(unsigned w) { return __uint_as_float(w << 16); }
__device__ __forceinline__ float bf_hi(unsigned w) { return __uint_as_float(w & 0xffff0000u); }
__device__ __forceinline__ void transpose_item(const float* W, int K, int N, bf16* WT, int kb, int n0, int row_base, LAS float* scr, int lane) {
    const int k0 = 64 * kb;
    f32x4 wv[8];
#pragma unroll
    for (int i = 0; i < 8; ++i) wv[i] = *(const f32x4*)(W + (size_t)(k0 + 8 * i + (lane >> 3)) * N + n0 + 4 * (lane & 7));
#pragma unroll
    for (int i = 0; i < 8; ++i) { LAS float* d = scr + (8 * i + (lane >> 3)) * 33 + 4 * (lane & 7); d[0] = wv[i].x; d[1] = wv[i].y; d[2] = wv[i].z; d[3] = wv[i].w; }
    asm volatile("s_waitcnt lgkmcnt(0)" ::: "memory");
    const int c = lane & 7;
#pragma unroll
    for (int j = 0; j < 4; ++j) { const int n = (lane >> 3) + 8 * j; const LAS float* s = scr + (8 * c) * 33 + n;
        v4u o; o.x = pk2(s[0 * 33], s[1 * 33]); o.y = pk2(s[2 * 33], s[3 * 33]); o.z = pk2(s[4 * 33], s[5 * 33]); o.w = pk2(s[6 * 33], s[7 * 33]);
        *(v4u*)(WT + (size_t)(row_base + n) * K + k0 + 8 * c) = o; }
    asm volatile("s_waitcnt lgkmcnt(0)" ::: "memory");
}

struct Params { const float* in[30]; float* out; unsigned char* ws; int ph_lo, ph_hi; };
struct PL {
    const LAS unsigned* d;
    __device__ __forceinline__ unsigned u(int i) const { return (unsigned)__builtin_amdgcn_readfirstlane((int)d[i]); }
    __device__ __forceinline__ const float* in(int i) const { const unsigned long long lo = u(2 * i), hi = u(2 * i + 1); return (const float*)(const __attribute__((address_space(1))) float*)((hi << 32) | lo); }
    __device__ __forceinline__ float* out() const { const unsigned long long lo = u(60), hi = u(61); return (float*)(__attribute__((address_space(1))) float*)((hi << 32) | lo); }
    __device__ __forceinline__ unsigned char* ws() const { const unsigned long long lo = u(62), hi = u(63); return (unsigned char*)(__attribute__((address_space(1))) unsigned char*)((hi << 32) | lo); }
};
enum { I_X = 0, I_C, I_RELB, I_ADAW, I_ADAB, I_LNF1, I_F1G, I_F1U, I_F1D, I_LNMIX, I_LNF2, I_F2G, I_F2U, I_F2D, I_LNOUT, I_WQKV, I_QN, I_KN, I_LQ1, I_LK1, I_LQ2, I_LK2, I_SUBLN, I_WO,
       I_WIN, I_SLNG, I_SLNB, I_SWS, I_SBS, I_WOUT };
constexpr int NPHASE = 17;
#ifndef PHMASK
#define PHMASK 0xff
#endif

__device__ __forceinline__ void convert_weights(const PL& P, LAS unsigned char* lds, int gw, int NGW, int wave, int lane) {
    LAS float* scr = (LAS float*)(lds + wave * 8448);
    constexpr int IT_F = 1408, IT_FFN = 12 * IT_F, IT_QKV = 1536, IT_WO = 512, IT_WIN = 1024, IT_WOUT = 512;
    constexpr int NITEMS = IT_FFN + IT_QKV + IT_WO + IT_WIN + IT_WOUT;
    for (int it = gw; it < NITEMS; it += NGW) {
        int r = it;
        if (r < IT_FFN) {
            const int mi = r / IT_F, ri = r % IT_F; const int l = mi / 6, w = mi % 6; const int f = w / 3, kind = w % 3;
            bf16* gu = (bf16*)(P.ws() + WS_W + (size_t)(l * 2 + f) * W_FFN_STRIDE); bf16* dn = (bf16*)((unsigned char*)gu + W_GU_BYTES);
            if (kind < 2) { const float* W = (f == 0 ? (kind == 0 ? P.in(I_F1G) : P.in(I_F1U)) : (kind == 0 ? P.in(I_F2G) : P.in(I_F2U))) + (size_t)l * D * F; const int nblk = F / 32, kb = ri / nblk, n0 = 32 * (ri % nblk);
                transpose_item(W, D, F, gu, kb, n0, 256 * (n0 >> 7) + (n0 & 127) + 128 * kind, scr, lane); }
            else { const float* W = (f == 0 ? P.in(I_F1D) : P.in(I_F2D)) + (size_t)l * F * D; const int nblk = D / 32, kb = ri / nblk, n0 = 32 * (ri % nblk);
                transpose_item(W, F, D, dn, kb, n0, n0, scr, lane); }
            continue;
        }
        r -= IT_FFN;
        if (r < IT_QKV) { const int nblk = 3072 / 32, kb = r / nblk, n0 = 32 * (r % nblk); const int pn = n0 >> 8, rr = n0 & 255, wc = rr >> 6, bj = (rr >> 5) & 1;
            transpose_item(P.in(I_WQKV), D, 3072, (bf16*)(P.ws() + WS_WQKV), kb, n0, 256 * pn + 128 * bj + 32 * wc, scr, lane); continue; }
        r -= IT_QKV;
        if (r < IT_WO) { const int nblk = D / 32, kb = r / nblk, n0 = 32 * (r % nblk); transpose_item(P.in(I_WO), D, D, (bf16*)(P.ws() + WS_WO), kb, n0, n0, scr, lane); continue; }
        r -= IT_WO;
        if (r < IT_WIN) { const int nblk = 2048 / 32, kb = r / nblk, n0 = 32 * (r % nblk); transpose_item(P.in(I_WIN), D, 2048, (bf16*)(P.ws() + WS_WIN), kb, n0, n0, scr, lane); continue; }
        r -= IT_WIN;
        { const int nblk = D / 32, kb = r / nblk, n0 = 32 * (r % nblk); transpose_item(P.in(I_WOUT), D, D, (bf16*)(P.ws() + WS_WOUT), kb, n0, n0, scr, lane); }
    }
}

__device__ __forceinline__ void ada_phase(const PL& P, LAS unsigned char* lds, int vcu, int G, int tid, int wave, int lane) {
    if (vcu >= 144) return;
    LAS float* cact = (LAS float*)(lds + 69632);
    LAS float* red = (LAS float*)(lds + 86016);
    const float* c = P.in(I_C);
    for (int i = tid; i < 4096; i += NTHREADS) { const float x = c[i]; cact[i] = x / (1.0f + expf(-x)); }
    __syncthreads();
    float* mod = (float*)(P.ws() + WS_MOD);
    for (int item = vcu; item < 144; item += G) {
        const int l = item / 72, jb = item % 72;
        const float* W = P.in(I_ADAW) + (size_t)l * D * NMOD + jb * 128 + 2 * lane;
        float acc[4][2];
#pragma unroll
        for (int b = 0; b < 4; ++b) { acc[b][0] = 0.f; acc[b][1] = 0.f; }
#pragma unroll 8
        for (int kk = 0; kk < 128; ++kk) { const int k = wave * 128 + kk; const f32x2 w = *(const f32x2*)(W + (size_t)k * NMOD);
#pragma unroll
            for (int b = 0; b < 4; ++b) { const float cv = cact[b * 1024 + k]; acc[b][0] += cv * w.x; acc[b][1] += cv * w.y; } }
#pragma unroll
        for (int b = 0; b < 4; ++b) { red[(wave * 4 + b) * 128 + 2 * lane] = acc[b][0]; red[(wave * 4 + b) * 128 + 2 * lane + 1] = acc[b][1]; }
        __syncthreads();
        { const int b = tid >> 7, col = tid & 127; float s = 0.f;
#pragma unroll
            for (int w = 0; w < 8; ++w) s += red[(w * 4 + b) * 128 + col];
            mod[(size_t)(l * 4 + b) * NMOD + jb * 128 + col] = s + P.in(I_ADAB)[(size_t)l * NMOD + jb * 128 + col]; }
        __syncthreads();
    }
}

__device__ __forceinline__ void norm_phase(const float* xsrc, float* xdst, const float* gout, bf16* a, const float* g, const float* sh, const float* sc, int mode, int gw, int NGW, int lane) {
    for (int row = gw; row < M; row += NGW) {
        const int b = row >> 13;
        const f32x4* xr = (const f32x4*)(xsrc + (size_t)row * D) + lane;
        f32x4 v[4];
#pragma unroll
        for (int j = 0; j < 4; ++j) v[j] = xr[64 * j];
        if (mode >= 1) {
            float ss = 0.f;
#pragma unroll
            for (int j = 0; j < 4; ++j) ss += (v[j].x * v[j].x + v[j].y * v[j].y) + (v[j].z * v[j].z + v[j].w * v[j].w);
            const float rs = 1.0f / sqrtf(wave_sum(ss) * (1.0f / D) + 1e-6f);
            f32x4* xo = (f32x4*)(xdst + (size_t)row * D) + lane;
#pragma unroll
            for (int j = 0; j < 4; ++j) { const f32x4 gg = *((const f32x4*)gout + lane + 64 * j); v[j] = v[j] * rs * gg; xo[64 * j] = v[j]; }
        }
        if (mode != 2) {
            float ss = 0.f;
#pragma unroll
            for (int j = 0; j < 4; ++j) ss += (v[j].x * v[j].x + v[j].y * v[j].y) + (v[j].z * v[j].z + v[j].w * v[j].w);
            const float rs = 1.0f / sqrtf(wave_sum(ss) * (1.0f / D) + 1e-6f);
            v2u* ao = (v2u*)(a + (size_t)row * D) + lane;
#pragma unroll
            for (int j = 0; j < 4; ++j) { const f32x4 gg = *((const f32x4*)g + lane + 64 * j), s4 = *((const f32x4*)(sh + (size_t)b * NMOD) + lane + 64 * j), c4 = *((const f32x4*)(sc + (size_t)b * NMOD) + lane + 64 * j);
                const f32x4 y = (v[j] * rs * gg) * (c4 + 1.0f) + s4; v2u w; w.x = pk2(y.x, y.y); w.y = pk2(y.z, y.w); ao[64 * j] = w; }
        }
    }
}

__device__ __forceinline__ void prep_phase(const PL& P, int gw, int NGW, int lane) {
    unsigned char* ws = P.ws(); const float* mod = (const float*)(ws + WS_MOD);
    { const float* x = P.in(I_X); bf16* a = (bf16*)(ws + WS_A); float* ssq0 = (float*)(ws + WS_SSQ); const float* g = P.in(I_LNF1); const float* sc = mod + 1024;
      for (int row0 = gw; row0 < M; row0 += 2 * NGW) {
          f32x4 v[2][4]; float ss[2];
#pragma unroll
          for (int k = 0; k < 2; ++k) { const int row = row0 + k * NGW; const f32x4* xr = (const f32x4*)(x + (size_t)row * D) + lane;
#pragma unroll
              for (int j = 0; j < 4; ++j) v[k][j] = xr[64 * j]; }
#pragma unroll
          for (int k = 0; k < 2; ++k) { ss[k] = 0.f;
#pragma unroll
              for (int j = 0; j < 4; ++j) ss[k] += (v[k][j].x * v[k][j].x + v[k][j].y * v[k][j].y) + (v[k][j].z * v[k][j].z + v[k][j].w * v[k][j].w); }
          ss[0] = xadd<1>(ss[0]); ss[1] = xadd<1>(ss[1]); ss[0] = xadd<2>(ss[0]); ss[1] = xadd<2>(ss[1]); ss[0] = xadd<4>(ss[0]); ss[1] = xadd<4>(ss[1]);
          ss[0] = xadd<8>(ss[0]); ss[1] = xadd<8>(ss[1]); ss[0] = xadd<16>(ss[0]); ss[1] = xadd<16>(ss[1]); ss[0] = xadd<32>(ss[0]); ss[1] = xadd<32>(ss[1]);
#pragma unroll
          for (int k = 0; k < 2; ++k) { const int row = row0 + k * NGW; const int b = row >> 13; if (lane == 0) ssq0[row] = ss[k];
              v2u* ao = (v2u*)(a + (size_t)row * D) + lane;
#pragma unroll
              for (int j = 0; j < 4; ++j) { const f32x4 gg = *((const f32x4*)g + lane + 64 * j), c4 = *((const f32x4*)(sc + (size_t)b * NMOD) + lane + 64 * j);
                  const f32x4 y = v[k][j] * gg * (c4 + 1.0f); v2u w; w.x = pk2(y.x, y.y); w.y = pk2(y.z, y.w); ao[64 * j] = w; } } } }
    float* bvec = (float*)(ws + WS_BV);
    for (int it = gw; it < 27648; it += NGW) {
        int n = it, N = 5632, boff = 0, shoff = 0; const bf16* W = (const bf16*)(ws + WS_W);
        if (n >= 22016) { n -= 22016; W = (const bf16*)(ws + WS_W + 3 * W_FFN_STRIDE); boff = 88064; shoff = 4 * NMOD + 6144; }
        else if (n >= 19968) { n -= 19968; W = (const bf16*)(ws + WS_WIN); N = 2048; boff = 79872; shoff = 4 * NMOD + 3072; }
        else if (n >= 14336) { n -= 14336; W = (const bf16*)(ws + WS_W + 2 * W_FFN_STRIDE); boff = 57344; shoff = 4 * NMOD; }
        else if (n >= 8704) { n -= 8704; W = (const bf16*)(ws + WS_W + 1 * W_FFN_STRIDE); boff = 34816; shoff = 6144; }
        else if (n >= 5632) { n -= 5632; W = (const bf16*)(ws + WS_WQKV); N = 3072; boff = 22528; shoff = 3072; }
        const v4u* wp = (const v4u*)(W + (size_t)n * D + lane * 16); const v4u wa = wp[0], wb = wp[1];
        const float w[16] = {bf_lo(wa.x), bf_hi(wa.x), bf_lo(wa.y), bf_hi(wa.y), bf_lo(wa.z), bf_hi(wa.z), bf_lo(wa.w), bf_hi(wa.w), bf_lo(wb.x), bf_hi(wb.x), bf_lo(wb.y), bf_hi(wb.y), bf_lo(wb.z), bf_hi(wb.z), bf_lo(wb.w), bf_hi(wb.w)};
#pragma unroll
        for (int b = 0; b < 4; ++b) { const f32x4* sp = (const f32x4*)(mod + shoff + (size_t)b * NMOD + lane * 16); float d = 0.f;
#pragma unroll
            for (int q = 0; q < 4; ++q) { const f32x4 s4 = sp[q]; d += (s4.x * w[4 * q] + s4.y * w[4 * q + 1]) + (s4.z * w[4 * q + 2] + s4.w * w[4 * q + 3]); }
            d = wave_sum(d); if (lane == 0) bvec[boff + b * N + n] = d; }
    }
}

__device__ __forceinline__ void sgu_phase(const PL& P, LAS unsigned char* lds, int vcu, int G, int tid, int wave, int lane) {
    constexpr int ST = 136;
    LAS bf16* Wt = (LAS bf16*)lds; LAS bf16* Vt = (LAS bf16*)(lds + 34816); LAS float* st = (LAS float*)(lds + 69632);
    const bf16* Z = (const bf16*)(P.ws() + WS_Z); bf16* Gt = (bf16*)(P.ws() + WS_G);
    const float* wsp = P.in(I_SWS); const float* bs = P.in(I_SBS); const float* lng = P.in(I_SLNG); const float* lnb = P.in(I_SLNB);
    const int fr = lane & 15, fq = lane >> 4;
    for (int unit = vcu; unit < 256; unit += G) {
        const size_t r0 = (size_t)unit * 128;
        {
            const int rsub = lane >> 4, c16 = lane & 15;
#pragma unroll
            for (int it = 0; it < 4; ++it) { const int row = 16 * wave + 4 * it + rsub; const v4u* p = (const v4u*)(Z + (r0 + row) * 2048 + 1024 + c16 * 64);
                float s1 = 0.f, s2 = 0.f;
#pragma unroll
                for (int j = 0; j < 8; ++j) { const v4u a = p[j];
                    const float x[8] = {bf_lo(a.x), bf_hi(a.x), bf_lo(a.y), bf_hi(a.y), bf_lo(a.z), bf_hi(a.z), bf_lo(a.w), bf_hi(a.w)};
#pragma unroll
                    for (int k = 0; k < 8; ++k) { s1 += x[k]; s2 += x[k] * x[k]; } }
                s1 = xadd<1>(s1); s2 = xadd<1>(s2); s1 = xadd<2>(s1); s2 = xadd<2>(s2); s1 = xadd<4>(s1); s2 = xadd<4>(s2); s1 = xadd<8>(s1); s2 = xadd<8>(s2);
                const float mean = s1 * (1.0f / 1024.0f); const float var = fmaxf(s2 * (1.0f / 1024.0f) - mean * mean, 0.f);
                if (c16 == 0) { st[row * 2] = mean; st[row * 2 + 1] = 1.0f / sqrtf(var + 1e-6f); } }
        }
        __syncthreads();
        for (int g = 0; g < 8; ++g) {
#pragma unroll
            for (int it = 0; it < 4; ++it) { const int idx = it * NTHREADS + tid, t = idx >> 4, s0 = (idx & 15) * 8; const float* wp = wsp + ((size_t)g * 128 + t) * 128 + s0;
                const f32x4 a = *(const f32x4*)wp, b = *(const f32x4*)(wp + 4); float w[8] = {a.x, a.y, a.z, a.w, b.x, b.y, b.z, b.w};
#pragma unroll
                for (int k = 0; k < 8; ++k) w[k] = (s0 + k <= t) ? w[k] : 0.f;
                v4u o; o.x = pk2(w[0], w[1]); o.y = pk2(w[2], w[3]); o.z = pk2(w[4], w[5]); o.w = pk2(w[6], w[7]);
                *(LAS v4u*)(Wt + t * ST + s0) = o; }
#pragma unroll
            for (int it = 0; it < 4; ++it) { const int idx = it * NTHREADS + tid, s = idx & 127, cc = idx >> 7;
                const v4u a = *(const v4u*)(Z + (r0 + s) * 2048 + 1024 + g * 128 + cc * 8);
                const float mean = st[s * 2], rstd = st[s * 2 + 1];
                float x[8] = {bf_lo(a.x), bf_hi(a.x), bf_lo(a.y), bf_hi(a.y), bf_lo(a.z), bf_hi(a.z), bf_lo(a.w), bf_hi(a.w)};
                const f32x4 g0 = *(const f32x4*)(lng + g * 128 + cc * 8), g1 = *(const f32x4*)(lng + g * 128 + cc * 8 + 4), b0 = *(const f32x4*)(lnb + g * 128 + cc * 8), b1 = *(const f32x4*)(lnb + g * 128 + cc * 8 + 4);
                const float gg[8] = {g0.x, g0.y, g0.z, g0.w, g1.x, g1.y, g1.z, g1.w}, bb[8] = {b0.x, b0.y, b0.z, b0.w, b1.x, b1.y, b1.z, b1.w};
#pragma unroll
                for (int k = 0; k < 8; k += 2) { const unsigned w = pk2((x[k] - mean) * rstd * gg[k] + bb[k], (x[k + 1] - mean) * rstd * gg[k + 1] + bb[k + 1]);
                    Vt[(cc * 8 + k) * ST + s] = (bf16)(w & 0xffffu); Vt[(cc * 8 + k + 1) * ST + s] = (bf16)(w >> 16); } }
            __syncthreads();
            f32x4 acc[8];
#pragma unroll
            for (int n = 0; n < 8; ++n) acc[n] = (f32x4){0.f, 0.f, 0.f, 0.f};
            const int nks = (16 * wave + 15) / 32 + 1;
            for (int ks = 0; ks < nks; ++ks) {
                const bf16x8 af = *(const LAS bf16x8*)(Wt + (16 * wave + fr) * ST + 32 * ks + 8 * fq);
#pragma unroll
                for (int n = 0; n < 8; ++n) { const bf16x8 bfv = *(const LAS bf16x8*)(Vt + (16 * n + fr) * ST + 32 * ks + 8 * fq);
                    acc[n] = __builtin_amdgcn_mfma_f32_16x16x32_bf16(bfv, af, acc[n], 0, 0, 0); }
            }
            const int t = 16 * wave + fr; const float bias = bs[g * 128 + t]; const size_t row = r0 + t;
#pragma unroll
            for (int n = 0; n < 8; ++n) { const int col = g * 128 + 16 * n + 4 * fq; const v2u uu = *(const v2u*)(Z + row * 2048 + col);
                v2u w; w.x = pk2(bf_lo(uu.x) * (acc[n][0] + bias), bf_hi(uu.x) * (acc[n][1] + bias)); w.y = pk2(bf_lo(uu.y) * (acc[n][2] + bias), bf_hi(uu.y) * (acc[n][3] + bias));
                *(v2u*)(Gt + row * 1024 + col) = w; }
            __syncthreads();
        }
    }
}

#define XB_TMO      128
#define XB_XCNT(j)  (256  + 64 * (j))
#define XB_XSUB(j)  (1280 + 64 * (j))
#define XB_XGEN(j)  (2304 + 64 * (j))
#define XB_TOP      3328
#define XB_TOPGEN   3392
#define XCD_BAR_WORDS 3456
#define XB_SPIN_CAP (1u << 18)

__device__ __forceinline__ unsigned xb_ld(unsigned* p)              { return __hip_atomic_load(p, __ATOMIC_RELAXED, __HIP_MEMORY_SCOPE_AGENT); }
__device__ __forceinline__ unsigned xb_add(unsigned* p, unsigned v) { return __hip_atomic_fetch_add(p, v, __ATOMIC_RELAXED, __HIP_MEMORY_SCOPE_AGENT); }
__device__ __forceinline__ unsigned xb_xcc_id() { return (unsigned)__builtin_amdgcn_s_getreg((3 << 11) | 20) & 0xFu; }
#define XB_SPIN(cond, bar) do { unsigned _sp = 0; while (cond) { __builtin_amdgcn_s_sleep(1); \
    if ((++_sp & 255u) == 0u) { if (xb_ld(&(bar)[XB_TMO])) break; if (_sp > XB_SPIN_CAP) { atomicAdd(&(bar)[XB_TMO], 1u); break; } } } } while (0)

struct XcdBarrier {
    unsigned* bar; unsigned x;
    volatile LAS unsigned* st;
};

__device__ __forceinline__ XcdBarrier xcd_barrier_post(unsigned* bar, volatile LAS unsigned* st) {
    XcdBarrier b; b.bar = bar; b.x = xb_xcc_id(); b.st = st;
    if (threadIdx.x == 0) (void)xb_add(&bar[XB_XCNT(b.x)], 1u);
    return b;
}
__device__ __forceinline__ void xcd_barrier_complete(unsigned* bar, unsigned x, unsigned& nloc, unsigned& nx) {
    const unsigned G = gridDim.x * gridDim.y * gridDim.z;
    unsigned sum, cnt, mine, sp = 0u;
    for (;;) {
        sum = 0u; cnt = 0u; mine = 0u;
#pragma unroll
        for (unsigned j = 0; j < 16; ++j) { const unsigned c = xb_ld(&bar[XB_XCNT(j)]); sum += c; cnt += (c > 0u) ? 1u : 0u; mine = (j == x) ? c : mine; }
        if (sum == G) break;
        __builtin_amdgcn_s_sleep(1);
        if ((++sp & 255u) == 0u) { if (xb_ld(&bar[XB_TMO])) break; if (sp > XB_SPIN_CAP) { atomicAdd(&bar[XB_TMO], 1u); break; } }
    }
    nloc = mine > 0u ? mine : 1u; nx = cnt > 0u ? cnt : 1u;
}

__device__ __forceinline__ void xcd_barrier(const XcdBarrier& b) {
    asm volatile("s_waitcnt vmcnt(0)" ::: "memory");
    __syncthreads();
    if (threadIdx.x == 0) {
        unsigned* bar = b.bar;
        __builtin_amdgcn_s_waitcnt(0);
        unsigned nloc = b.st[0], nx = b.st[1];
        if (nloc == 0u) { xcd_barrier_complete(bar, b.x, nloc, nx); b.st[0] = nloc; b.st[1] = nx; }
        const unsigned old = xb_add(&bar[XB_XSUB(b.x)], 1u);
        const unsigned gen = old / nloc;
        if (old + 1u == (gen + 1u) * nloc) {
            __builtin_amdgcn_fence(__ATOMIC_RELEASE, "agent");
            asm volatile("s_waitcnt vmcnt(0)" ::: "memory");
            const unsigned og = xb_add(&bar[XB_TOP], 1u);
            const unsigned tg = og / nx;
            if (og + 1u == (tg + 1u) * nx) xb_add(&bar[XB_TOPGEN], 1u);
            else XB_SPIN(xb_ld(&bar[XB_TOPGEN]) == tg, bar);
            __builtin_amdgcn_fence(__ATOMIC_ACQUIRE, "agent");
            xb_add(&bar[XB_XGEN(b.x)], 1u);
            asm volatile("s_waitcnt vmcnt(0)" ::: "memory");
        } else {
            XB_SPIN(xb_ld(&bar[XB_XGEN(b.x)]) == gen, bar);
            __builtin_amdgcn_fence(__ATOMIC_ACQUIRE, "agent");
            asm volatile("s_waitcnt vmcnt(0)" ::: "memory");
        }
    }
    __syncthreads();
}

template <class Epi> __device__ __forceinline__ void run_gemm(LAS unsigned char* lds, const bf16* A, const bf16* Bt, int N, int K, int G, const Epi& E) {
    pg8::Gemm g{A, Bt, M, N, K}; pg8::StaticOrder S; S.init(M, N, G, (int)blockIdx.x);
    pg8::gemm_phase<Epi, pg8::StaticOrder, true, true>(lds, g, S, E);
}

__global__ void __launch_bounds__(NTHREADS, 2) mega_fwd(Params KP) {
    extern __shared__ __attribute__((aligned(16))) unsigned char lds_raw[];
    LAS unsigned char* lds = (LAS unsigned char*)lds_raw;
    cg::grid_group grid = cg::this_grid();
    { LAS unsigned* pd = (LAS unsigned*)(lds + 133376);
      if (threadIdx.x == 0) { ((LAS unsigned*)(lds + 133888))[0] = 0u; ((LAS unsigned*)(lds + 133888))[1] = 0u;
#pragma unroll
          for (int i = 0; i < 30; ++i) { const unsigned long long a = (unsigned long long)(uintptr_t)KP.in[i]; pd[2 * i] = (unsigned)a; pd[2 * i + 1] = (unsigned)(a >> 32); }
          { const unsigned long long a = (unsigned long long)(uintptr_t)KP.out; pd[60] = (unsigned)a; pd[61] = (unsigned)(a >> 32); }
          { const unsigned long long a = (unsigned long long)(uintptr_t)KP.ws; pd[62] = (unsigned)a; pd[63] = (unsigned)(a >> 32); } }
      __syncthreads(); }
    const PL P{(const LAS unsigned*)(lds + 133376)};
    (void)xcd_barrier_post((unsigned*)(KP.ws + WS_BAR), (volatile LAS unsigned*)(lds + 133888));
    const int ph_lo = KP.ph_lo, ph_hi = KP.ph_hi;
    const int G0 = gridDim.x, bx = blockIdx.x;
    const int vcu0 = (G0 % 8 == 0) ? (bx % 8) * (G0 / 8) + bx / 8 : bx;
#ifndef REPEAT_PH
#define REPEAT_PH -1
#endif
    for (int pp = ph_lo; pp < ph_hi + (REPEAT_PH >= 0 ? 1 : 0); ++pp) {
        const int ph = (REPEAT_PH >= 0 && pp > REPEAT_PH) ? pp - 1 : pp;
        int vcu = vcu0, G = G0; asm volatile("" : "+s"(vcu), "+s"(G));
        const int NGW = G * NWAVES;
        const int tid = opaque_tid(), lane = tid & 63, wave = __builtin_amdgcn_readfirstlane(tid >> 6); const int gw = vcu * NWAVES + wave;
        unsigned char* ws = P.ws(); asm volatile("" : "+s"(ws));
        float* mod = (float*)(ws + WS_MOD); float* ssq = (float*)(ws + WS_SSQ); const float* bvec = (const float*)(ws + WS_BV);
        bf16* Abuf = (bf16*)(ws + WS_A); bf16* Hbuf = (bf16*)(ws + WS_H);
        float* out = P.out();
        int type = 0, l = 0, f = 0, sA = 0, sB = -1, bvo = 0, modoff = 0;
        const float* xsrc = out; const bf16* rA = Hbuf; const bf16* rB = nullptr; int rK = F; float rgs = 0.5f;
        int so = -1, sob = -1, wsc_off = 0, lazy = -1; const float* wg = nullptr; const float* wg2 = nullptr;
        switch (ph) {
            case 0: type = 0; break;
            case 1: type = 1; break;
            case 2: type = 2; l = 0; f = 0; sA = 0; bvo = 0; break;
            case 3: type = 3; l = 0; rB = (const bf16*)(ws + WS_W + 0 * W_FFN_STRIDE + W_GU_BYTES); modoff = 2048; xsrc = P.in(I_X); so = 1; wg = P.in(I_LNMIX); wsc_off = 4096; break;
            case 4: type = 4; sA = 1; bvo = 22528; break;
            case 5: type = 5; break;
            case 6: type = 3; l = 0; rA = (const bf16*)(ws + WS_O); rB = (const bf16*)(ws + WS_WO); rK = D; rgs = 1.0f; modoff = 5120; so = 2; wg = P.in(I_LNF2); wsc_off = 7168; break;
            case 7: type = 2; l = 0; f = 1; sA = 2; bvo = 34816; break;
            case 8: type = 3; l = 0; rB = (const bf16*)(ws + WS_W + 1 * W_FFN_STRIDE + W_GU_BYTES); modoff = 8192; so = 3; sob = 4; wg = P.in(I_LNF1) + D; wsc_off = 4 * NMOD + 1024; wg2 = P.in(I_LNOUT); break;
            case 9: type = 2; l = 1; f = 0; sA = 3; sB = 4; bvo = 57344; break;
            case 10: type = 3; l = 1; rB = (const bf16*)(ws + WS_W + 2 * W_FFN_STRIDE + W_GU_BYTES); modoff = 2048; lazy = 3; so = 5; wg = P.in(I_LNMIX) + D; wsc_off = 4 * NMOD + 4096; break;
            case 11: type = 6; sA = 5; bvo = 79872; break;
            case 12: type = 7; break;
            case 13: type = 3; l = 1; rA = (const bf16*)(ws + WS_G); rB = (const bf16*)(ws + WS_WOUT); rK = D; rgs = 1.0f; modoff = 5120; so = 6; wg = P.in(I_LNF2) + D; wsc_off = 4 * NMOD + 7168; break;
            case 14: type = 2; l = 1; f = 1; sA = 6; bvo = 88064; break;
            case 15: type = 3; l = 1; rB = (const bf16*)(ws + WS_W + 3 * W_FFN_STRIDE + W_GU_BYTES); modoff = 8192; break;
            default: type = 8; break;
        }
        const float* modl = mod + (size_t)l * 4 * NMOD;
        if ((PHMASK & 1) && type == 0) {
            for (int i = gw * 64 + lane; i < 7 * M; i += NGW * 64) ssq[i] = 0.f;
            convert_weights(P, lds, gw, NGW, wave, lane);
            ada_phase(P, lds, vcu, G, tid, wave, lane);
        } else if ((PHMASK & 2) && type == 1) {
            prep_phase(P, gw, NGW, lane);
        } else if ((PHMASK & 2) && type == 8) {
            norm_phase(out, out, P.in(I_LNOUT) + D, Abuf, nullptr, nullptr, nullptr, 2, gw, NGW, lane);
        } else if ((PHMASK & 32) && type == 5) {
            const float p1 = wave_sum(P.in(I_LQ1)[lane] * P.in(I_LK1)[lane]), p2 = wave_sum(P.in(I_LQ2)[lane] * P.in(I_LK2)[lane]);
            const float lam = expf(p1) - expf(p2) + 0.2f;
            const float kmaxn = wave_max(fabsf(P.in(I_KN)[lane])) * 8.0f * 1.02f;
            for (int v = vcu; v < 256; v += G) {
                const int bh = v >> 3, j = v & 7;
                const float* relb = P.in(I_RELB); const float bmax = att::attn_head_setup(lds, relb, bh & 7); const float lut31 = relb[31 * 8 + (bh & 7)] * att::LOG2E;
                for (int i = 0; i < 8; ++i) { const int s = j + 8 * (i >> 1); const int qb = (i & 1) ? 63 - s : s;
                    att::attn_unit(bh >> 3, bh & 7, qb, (const bf16*)(ws + WS_Q), (const bf16*)(ws + WS_K), (const bf16*)(ws + WS_V), (bf16*)(ws + WS_O), lds, bmax, lut31, lam, kmaxn, P.in(I_SUBLN), 0.8f); }
            }
        } else if ((PHMASK & 4) && (type == 2 || type == 3 || type == 4 || type == 6)) {
            pg8::EpiMulti E{}; const bf16* gA = Abuf; const bf16* gB = nullptr; int gN = D, gK = D;
            E.ssqA = ssq + (size_t)sA * M; E.ssqB = sB >= 0 ? ssq + (size_t)sB * M : nullptr; E.bvec = bvec + bvo;
            if (type == 2) { E.kind = 0; E.p0 = Hbuf; E.i0 = F; gB = (const bf16*)(ws + WS_W + (size_t)(l * 2 + f) * W_FFN_STRIDE); gN = 2 * F; }
            else if (type == 3) { E.kind = lazy >= 0 ? 5 : (wg2 ? 4 : 1); E.g0 = xsrc; E.p0 = out; E.g1 = modl + modoff; E.f0 = rgs; gA = rA; gB = rB; gK = rK;
                E.lazy_ssq = lazy >= 0 ? ssq + (size_t)lazy * M : nullptr; E.lazy_g = P.in(I_LNOUT);
                E.aout = so >= 0 ? (void*)Abuf : nullptr; E.wg = wg; E.wsc = mod + wsc_off; E.wg2 = wg2; E.ssq_out = ssq + (size_t)(so >= 0 ? so : 0) * M; E.ssqB_out = ssq + (size_t)(sob >= 0 ? sob : 0) * M; }
            else if (type == 4) { E.kind = 2; E.p0 = ws + WS_Q; E.p1 = ws + WS_K; E.p2 = ws + WS_V; E.g0 = P.in(I_QN); E.g1 = P.in(I_KN); E.f0 = att::C2; gB = (const bf16*)(ws + WS_WQKV); gN = 3 * D; }
            else { E.kind = 3; E.p0 = ws + WS_Z; E.i0 = 2048; gB = (const bf16*)(ws + WS_WIN); gN = 2048; }
            { LAS unsigned* dd = (LAS unsigned*)(lds + 133120);
              if (tid == 0) {
#define DW(i, v) dd[i] = (unsigned)(v)
#define DP(i, ptr) do { const unsigned long long a_ = (unsigned long long)(uintptr_t)(ptr); dd[i] = (unsigned)a_; dd[(i) + 1] = (unsigned)(a_ >> 32); } while (0)
                  DW(0, E.kind); DW(1, E.i0); DW(2, __float_as_uint(E.f0)); DP(4, E.p0); DP(6, E.p1); DP(8, E.p2); DP(10, E.g0); DP(12, E.g1); DP(14, E.ssqA); DP(16, E.ssqB); DP(18, E.bvec);
                  DP(20, E.lazy_ssq); DP(22, E.lazy_g); DP(24, E.aout); DP(26, E.wg); DP(28, E.wsc); DP(30, E.wg2); DP(32, E.ssq_out); DP(34, E.ssqB_out);
#undef DW
#undef DP
              }
              __syncthreads();
              pg8::EpiLds EL{(const LAS unsigned*)dd};
              run_gemm(lds, gA, gB, gN, gK, G, EL); }
        } else if ((PHMASK & 128) && type == 7) {
            sgu_phase(P, lds, vcu, G, tid, wave, lane);
        }
        if (pp + 1 < ph_hi + (REPEAT_PH >= 0 ? 1 : 0)) { if (ph_lo < 0) grid.sync(); else { XcdBarrier xb_; xb_.bar = (unsigned*)(ws + WS_BAR); xb_.x = xb_xcc_id(); xb_.st = (volatile LAS unsigned*)(lds + 133888); xcd_barrier(xb_); } }
    }
}

#ifndef N_LAUNCH_MODE
#define N_LAUNCH_MODE 0
#endif
extern "C" void kernel_launch(void* const* d_in, const int* in_sizes, int n_in, void* d_out, int out_size, void* d_ws, size_t ws_size, hipStream_t stream) {
    static int grid = 0;
    if (grid == 0) {
        if (n_in != 30 || out_size != M * D || ws_size < WS_END) { fprintf(stderr, "kernel_launch: unexpected problem (n_in %d out %d ws %zu)\n", n_in, out_size, ws_size); grid = -1; return; }
        int dev = 0, cus = 0, per_cu = 0;
        hipGetDevice(&dev); hipDeviceGetAttribute(&cus, hipDeviceAttributeMultiprocessorCount, dev);
        if (hipFuncSetAttribute((const void*)mega_fwd, hipFuncAttributeMaxDynamicSharedMemorySize, LDS_BYTES) != hipSuccess) { fprintf(stderr, "kernel_launch: hipFuncSetAttribute failed\n"); grid = -1; return; }
        if (hipOccupancyMaxActiveBlocksPerMultiprocessor(&per_cu, (const void*)mega_fwd, NTHREADS, LDS_BYTES) != hipSuccess || per_cu < 1) { fprintf(stderr, "kernel_launch: occupancy query gives %d\n", per_cu); per_cu = 1; }
        (void)hipGetLastError();
        grid = cus * 1;
        if (grid <= 0) grid = 256;
    }
    if (grid < 0) return;
    if (hipMemsetAsync((char*)d_ws + WS_BAR, 0, 16384, stream) != hipSuccess) { fprintf(stderr, "kernel_launch: memset of the barrier words failed\n"); return; }
    Params p{};
    for (int i = 0; i < 30; ++i) p.in[i] = (const float*)d_in[i];
    p.out = (float*)d_out; p.ws = (unsigned char*)d_ws;
#if N_LAUNCH_MODE == 1
    for (int ph = 0; ph < NPHASE; ++ph) { p.ph_lo = ph; p.ph_hi = ph + 1; hipLaunchKernelGGL(mega_fwd, dim3(grid), dim3(NTHREADS), LDS_BYTES, stream, p); }
#else
    p.ph_lo = 0; p.ph_hi = NPHASE;
    void* args[] = {&p};
    hipError_t e = hipLaunchCooperativeKernel((const void*)mega_fwd, dim3(grid), dim3(NTHREADS), args, LDS_BYTES, stream);
    if (e != hipSuccess) fprintf(stderr, "cooperative launch failed: %s (grid %d)\n", hipGetErrorString(e), grid);
#endif
}
```

```cpp
#include <hip/hip_runtime.h>
#include <hip/hip_cooperative_groups.h>
#include <cstdio>
#include <cstdint>
#include <cmath>
namespace cg = cooperative_groups;
template <int MASK> __device__ __forceinline__ float xadd(float v) {
    if constexpr (MASK == 32) { auto rr = __builtin_amdgcn_permlane32_swap(__float_as_uint(v), __float_as_uint(v), false, false); return __uint_as_float(rr[0]) + __uint_as_float(rr[1]); }
    else return v + __uint_as_float((unsigned)__builtin_amdgcn_ds_swizzle((int)__float_as_uint(v), (MASK << 10) | 0x1f));
}
template <int MASK> __device__ __forceinline__ float xmax(float v) {
    if constexpr (MASK == 32) { auto rr = __builtin_amdgcn_permlane32_swap(__float_as_uint(v), __float_as_uint(v), false, false); return fmaxf(__uint_as_float(rr[0]), __uint_as_float(rr[1])); }
    else return fmaxf(v, __uint_as_float((unsigned)__builtin_amdgcn_ds_swizzle((int)__float_as_uint(v), (MASK << 10) | 0x1f)));
}
__device__ __forceinline__ float wave_sum(float v) { v = xadd<1>(v); v = xadd<2>(v); v = xadd<4>(v); v = xadd<8>(v); v = xadd<16>(v); return xadd<32>(v); }
__device__ __forceinline__ float wave_max(float v) { v = xmax<1>(v); v = xmax<2>(v); v = xmax<4>(v); v = xmax<8>(v); v = xmax<16>(v); return xmax<32>(v); }
__device__ __forceinline__ int opaque_tid() { int t = threadIdx.x; asm volatile("" : "+v"(t)); return t; }
namespace pg8 {
#define PG8_LAS __attribute__((address_space(3)))
typedef unsigned short bf16_t;
typedef short bf16x8 __attribute__((ext_vector_type(8)));
typedef float f32x4 __attribute__((ext_vector_type(4)));
typedef unsigned u32x4 __attribute__((ext_vector_type(4)));
constexpr int BM = 256, BK = 64, HALF = 128, HTB = HALF * BK * 2  , STAGE_BYTES = 8 * HTB, NXCD = 8, WGM = 8;

__host__ __device__ __forceinline__ int lds_byte(int r, int c) { const int st = (r >> 4) * 2 + (c >> 5), rr = r & 15, cc = c & 31, ob = rr * 64 + cc * 2; return st * 1024 + (ob ^ (((ob >> 9) & 1) << 5)); }
__host__ __device__ __forceinline__ void stage_rc(int b, int& R, int& C) { const int st = b / 1024, sb = b % 1024, swz = sb ^ (((sb >> 9) & 1) << 5); R = (st >> 1) * 16 + swz / 64; C = (st & 1) * 32 + (swz % 64) / 2; }
__host__ __device__ __forceinline__ int perm32(int rho) { const int n = rho >> 4, i = rho & 15; return 8 * (i >> 2) + 4 * n + (i & 3); }

struct Unit { int pm, pn; };
struct Gemm { const bf16_t* A; const bf16_t* Bt; int M, N, K; };

struct StaticOrder {
    int nM, nN, nwg, G, c;
    __host__ __device__ void init(int M, int N, int G_, int c_) { nM = M / BM; nN = N / BM; nwg = nM * nN; G = G_; c = c_; }
    __host__ __device__ bool next(int i, Unit& u) const {
        const long L = (long)i * G + c; if (L >= nwg) return false;
        int wgid = (int)L; { const int q = nwg / NXCD, r = nwg % NXCD, xcd = wgid % NXCD, off = wgid / NXCD; wgid = (xcd < r ? xcd * (q + 1) : r * (q + 1) + (xcd - r) * q) + off; }
        const int nig = WGM * nN, gid = wgid / nig, fm = gid * WGM, gsz = (nM - fm) < WGM ? (nM - fm) : WGM;
        u.pm = fm + ((wgid % nig) % gsz); u.pn = (wgid % nig) / gsz; return true;
    }
    __device__ __forceinline__ void a_ready(const Unit&) const {}
    __device__ __forceinline__ void done(const Unit&) const {}
};

__device__ __forceinline__ unsigned cvt_pk_bf16(float lo, float hi) { unsigned r; asm volatile("v_cvt_pk_bf16_f32 %0, %1, %2" : "=v"(r) : "v"(lo), "v"(hi)); return r; }
typedef float f32x2 __attribute__((ext_vector_type(2)));
__device__ __forceinline__ f32x2 gelu_pk(f32x2 v) {
    const f32x2 av = __builtin_elementwise_abs(v), d = av * 0.2316418882f + 1.0f;
    f32x2 t; t.x = __builtin_amdgcn_rcpf(d.x); t.y = __builtin_amdgcn_rcpf(d.y);
    f32x2 q = t * 0.5307027145f + (-0.7265760135f); q = q * t + 0.7107068705f; q = q * t + (-0.142248368f); q = q * t + 0.127414796f; q = q * t;
    const f32x2 s = (v * v) * (-0.72134752044f);
    f32x2 e; e.x = __builtin_amdgcn_exp2f(s.x); e.y = __builtin_amdgcn_exp2f(s.y);
    const f32x2 m = v * (q * e), r = v - m;
    f32x2 o; o.x = v.x < 0.f ? m.x : r.x; o.y = v.y < 0.f ? m.y : r.y; return o;
}
typedef unsigned u32x2 __attribute__((ext_vector_type(2)));
__device__ __forceinline__ float silu_f(float g) { return g * __builtin_amdgcn_rcpf(1.0f + __builtin_amdgcn_exp2f(-1.4426950408889634f * g)); }
__device__ __forceinline__ float row_scale(const float* ssqA, const float* ssqB, int row) {
    float r = __builtin_amdgcn_rsqf(ssqA[row] * (1.0f / 1024.0f) + 1e-6f);
    if (ssqB) r *= __builtin_amdgcn_rsqf(r * r * ssqB[row] * (1.0f / 1024.0f) + 1e-6f);
    return r;
}

struct EpiSwiglu {
    static constexpr bool PERM = true, AFTER_DRAIN = false;
    static __device__ __forceinline__ void run(const f32x4 (&acc)[2][2][4][2], const Unit& u, int wr, int wc, int fr, int fq, bf16_t* H, int ldh, const float* ssqA, const float* ssqB, const float* bvec) {
        const int b = (u.pm * BM) >> 13; const int row0 = u.pm * BM + wr * 64 + fr; const int col0 = u.pn * 128 + wc * 32 + 8 * fq;
        const float* bp = bvec + ((unsigned)b * (unsigned)(2 * ldh) + (unsigned)(u.pn * BM + wc * 32 + 8 * fq));
        const f32x4 bg0 = *(const f32x4*)bp * 1.4426950408889634f, bg1 = *(const f32x4*)(bp + 4) * 1.4426950408889634f, bu0 = *(const f32x4*)(bp + HALF) * 0.6931471805599453f, bu1 = *(const f32x4*)(bp + HALF + 4) * 0.6931471805599453f;
#define SWG_(gv, uv) ((gv) * (uv) * __builtin_amdgcn_rcpf(1.0f + __builtin_amdgcn_exp2f(-(gv))))
#pragma unroll
        for (int ai = 0; ai < 2; ++ai)
#pragma unroll
            for (int m = 0; m < 4; ++m) {
                const int row = row0 + ai * HALF + m * 16; const float r = row_scale(ssqA, ssqB, row); const float rg = r * 1.4426950408889634f, ru = r * 0.6931471805599453f;
                bf16_t* p = H + ((unsigned)row * (unsigned)ldh + (unsigned)col0);
                const f32x4 g0 = acc[ai][0][m][0] * rg + bg0, g1 = acc[ai][0][m][1] * rg + bg1, u0 = acc[ai][1][m][0] * ru + bu0, u1 = acc[ai][1][m][1] * ru + bu1;
                u32x4 w;
                w.x = cvt_pk_bf16(SWG_(g0[0], u0[0]), SWG_(g0[1], u0[1]));
                w.y = cvt_pk_bf16(SWG_(g0[2], u0[2]), SWG_(g0[3], u0[3]));
                w.z = cvt_pk_bf16(SWG_(g1[0], u1[0]), SWG_(g1[1], u1[1]));
                w.w = cvt_pk_bf16(SWG_(g1[2], u1[2]), SWG_(g1[3], u1[3]));
                __builtin_nontemporal_store(w, (u32x4*)p);
                asm volatile("" ::: "memory");
            }
    }
};

struct EpiGelu {
    static constexpr bool PERM = true, AFTER_DRAIN = false;
    static __device__ __forceinline__ void run(const f32x4 (&acc)[2][2][4][2], const Unit& u, int wr, int wc, int fr, int fq, bf16_t* O, int ldc, const float* ssqA, const float* bvec) {
        const int b = (u.pm * BM) >> 13; const int row0 = u.pm * BM + wr * 64 + fr; const int col0 = u.pn * BM + wc * 32 + 8 * fq;
        const float* bp = bvec + ((unsigned)b * (unsigned)ldc + (unsigned)col0);
        f32x4 bv[2][2];
#pragma unroll
        for (int bj = 0; bj < 2; ++bj)
#pragma unroll
            for (int n = 0; n < 2; ++n) bv[bj][n] = *(const f32x4*)(bp + bj * HALF + 4 * n);
#pragma unroll
        for (int ai = 0; ai < 2; ++ai)
#pragma unroll
            for (int m = 0; m < 4; ++m) { const int row = row0 + ai * HALF + m * 16; const float r = row_scale(ssqA, nullptr, row); bf16_t* rowp = O + ((unsigned)row * (unsigned)ldc + (unsigned)col0);
#pragma unroll
                for (int bj = 0; bj < 2; ++bj) { const f32x4 v0 = acc[ai][bj][m][0] * r + bv[bj][0], v1 = acc[ai][bj][m][1] * r + bv[bj][1];
                    const f32x2 a = gelu_pk((f32x2){v0[0], v0[1]}), b2 = gelu_pk((f32x2){v0[2], v0[3]}), c = gelu_pk((f32x2){v1[0], v1[1]}), d = gelu_pk((f32x2){v1[2], v1[3]});
                    u32x4 w; w.x = cvt_pk_bf16(a.x, a.y); w.y = cvt_pk_bf16(b2.x, b2.y); w.z = cvt_pk_bf16(c.x, c.y); w.w = cvt_pk_bf16(d.x, d.y);
                    *(u32x4*)(rowp + bj * HALF) = w; }
                asm volatile("" ::: "memory"); }
    }
};

struct EpiQKV {
    static constexpr bool PERM = true, AFTER_DRAIN = false;
    static __device__ __forceinline__ void run(const f32x4 (&acc)[2][2][4][2], const Unit& u, int wr, int wc, int fr, int fq, bf16_t* Q, bf16_t* K, bf16_t* V, const float* qg, const float* kg, float qscale, const float* ssqA, const float* bvec) {
        const int b = (u.pm * BM) >> 13; const int sect = u.pn >> 2; const int row0 = u.pm * BM + wr * 64 + fr; const int colb = (u.pn & 3) * 256 + 64 * wc + 8 * fq;
        bf16_t* base = sect == 0 ? Q : (sect == 1 ? K : V);
        const float* gp = (sect == 0 ? qg : kg) + 8 * fq; const float sc = sect == 0 ? qscale : 1.0f;
        const float* bp = bvec + ((unsigned)b * 3072u + (unsigned)(u.pn * BM + wc * 32 + 8 * fq));
#pragma unroll
        for (int ai = 0; ai < 2; ++ai)
#pragma unroll
            for (int m = 0; m < 4; ++m) {
                const int row = row0 + ai * HALF + m * 16; const float r = row_scale(ssqA, nullptr, row);
                f32x4 v[2][2]; float ss = 0.f;
#pragma unroll
                for (int bj = 0; bj < 2; ++bj)
#pragma unroll
                    for (int n = 0; n < 2; ++n) { const f32x4 x = acc[ai][bj][m][n] * r + *(const f32x4*)(bp + bj * HALF + 4 * n); v[bj][n] = x; ss += (x[0] * x[0] + x[1] * x[1]) + (x[2] * x[2] + x[3] * x[3]); }
                ss = xadd<16>(ss); ss = xadd<32>(ss);
                const float rs = sect < 2 ? __builtin_amdgcn_rsqf(ss * (1.0f / 64.0f) + 1e-6f) * sc : 1.0f;
                bf16_t* rowp = base + ((unsigned)row * 1024u + (unsigned)colb);
#pragma unroll
                for (int bj = 0; bj < 2; ++bj) {
                    f32x4 v0 = v[bj][0] * rs, v1 = v[bj][1] * rs;
                    if (sect < 2) { v0 = v0 * *(const f32x4*)(gp + 32 * bj); v1 = v1 * *(const f32x4*)(gp + 32 * bj + 4); }
                    u32x4 w; w.x = cvt_pk_bf16(v0[0], v0[1]); w.y = cvt_pk_bf16(v0[2], v0[3]); w.z = cvt_pk_bf16(v1[0], v1[1]); w.w = cvt_pk_bf16(v1[2], v1[3]);
                    *(u32x4*)(rowp + 32 * bj) = w; }
                asm volatile("" ::: "memory");
            }
    }
};

template <bool LAZY, bool WG2> struct EpiResidT {
    static constexpr bool PERM = true, AFTER_DRAIN = false;
    static __device__ __forceinline__ void run(const f32x4 (&acc)[2][2][4][2], const Unit& u, int wr, int wc, int fr, int fq, const float* xin, float* xout, const float* gate, float gs, const float* lazy_ssq, const float* lazy_g,
                                                bf16_t* aout, const float* wg, const float* wsc, const float* wg2, float* ssq_out, float* ssqB_out) {
        const unsigned b = (unsigned)(u.pm * BM) >> 13; const unsigned row0 = u.pm * BM + wr * 64 + fr; const unsigned col0 = u.pn * BM + wc * 32 + 8 * fq;
        float rl[2][4], sq[2][4], sqb[2][4];
#pragma unroll
        for (int ai = 0; ai < 2; ++ai)
#pragma unroll
            for (int m = 0; m < 4; ++m) { rl[ai][m] = LAZY ? __builtin_amdgcn_rsqf(lazy_ssq[row0 + ai * HALF + m * 16] * (1.0f / 1024.0f) + 1e-6f) : 1.0f; sq[ai][m] = 0.f; sqb[ai][m] = 0.f; }
#pragma unroll
        for (int bj = 0; bj < 2; ++bj) {
            const unsigned col = col0 + bj * HALF;
            f32x4 gv[2], lg[2], wv[2], w2[2];
#pragma unroll
            for (int n = 0; n < 2; ++n) {
                gv[n] = *(const f32x4*)(gate + (b * 9216u + col + 4 * n)) * gs;
                lg[n] = (f32x4){1.f, 1.f, 1.f, 1.f}; if (LAZY) lg[n] = *(const f32x4*)(lazy_g + col + 4 * n);
                wv[n] = (f32x4){0.f, 0.f, 0.f, 0.f}; w2[n] = (f32x4){1.f, 1.f, 1.f, 1.f};
                if (aout) { wv[n] = *(const f32x4*)(wg + col + 4 * n) * (*(const f32x4*)(wsc + (b * 9216u + col + 4 * n)) + 1.0f); if (WG2) { w2[n] = *(const f32x4*)(wg2 + col + 4 * n); wv[n] = wv[n] * w2[n]; } }
            }
            f32x4 xq[2][2][2];
#define RES_LD(buf, pp) do { _Pragma("unroll") for (int j = 0; j < 2; ++j) { const int i_ = 2 * (pp) + j; const unsigned off_ = (row0 + (i_ >> 2) * HALF + (i_ & 3) * 16) * 1024u + col; \
                xq[buf][j][0] = *(const f32x4*)(xin + off_); xq[buf][j][1] = *(const f32x4*)(xin + off_ + 4); } } while (0)
            constexpr bool DEEP = !LAZY && !WG2;
            if (DEEP) RES_LD(0, 0);
#pragma unroll
            for (int pp = 0; pp < 4; ++pp) {
                if (DEEP) { if (pp < 3) RES_LD((pp + 1) & 1, pp + 1); } else RES_LD(pp & 1, pp);
#pragma unroll
                for (int j = 0; j < 2; ++j) { const int i_ = 2 * pp + j, ai = i_ >> 2, m = i_ & 3; const unsigned off = (row0 + ai * HALF + m * 16) * 1024u + col;
                    const f32x4 xi0 = xq[pp & 1][j][0], xi1 = xq[pp & 1][j][1];
                    f32x4 xo0 = gv[0] * acc[ai][bj][m][0], xo1 = gv[1] * acc[ai][bj][m][1];
                    if (LAZY) { xo0 = xo0 + xi0 * lg[0] * rl[ai][m]; xo1 = xo1 + xi1 * lg[1] * rl[ai][m]; } else { xo0 = xo0 + xi0; xo1 = xo1 + xi1; }
                    *(f32x4*)(xout + off) = xo0; *(f32x4*)(xout + off + 4) = xo1;
                    if (aout) { const f32x4 a0 = xo0 * wv[0], a1 = xo1 * wv[1]; u32x4 w; w.x = cvt_pk_bf16(a0[0], a0[1]); w.y = cvt_pk_bf16(a0[2], a0[3]); w.z = cvt_pk_bf16(a1[0], a1[1]); w.w = cvt_pk_bf16(a1[2], a1[3]);
                        *(u32x4*)(aout + off) = w;
                        sq[ai][m] += ((xo0[0] * xo0[0] + xo0[1] * xo0[1]) + (xo0[2] * xo0[2] + xo0[3] * xo0[3])) + ((xo1[0] * xo1[0] + xo1[1] * xo1[1]) + (xo1[2] * xo1[2] + xo1[3] * xo1[3]));
                        if (WG2) { const f32x4 b0 = xo0 * w2[0], b1 = xo1 * w2[1]; sqb[ai][m] += ((b0[0] * b0[0] + b0[1] * b0[1]) + (b0[2] * b0[2] + b0[3] * b0[3])) + ((b1[0] * b1[0] + b1[1] * b1[1]) + (b1[2] * b1[2] + b1[3] * b1[3])); } } }
                asm volatile("" ::: "memory");
            }
#undef RES_LD
        }
        if (aout) {
#pragma unroll
            for (int ai = 0; ai < 2; ++ai)
#pragma unroll
                for (int m = 0; m < 4; ++m) { float s = sq[ai][m]; s = xadd<16>(s); s = xadd<32>(s);
                    float sb = sqb[ai][m]; if (WG2) { sb = xadd<16>(sb); sb = xadd<32>(sb); }
                    if (fq == 0) { unsafeAtomicAdd(ssq_out + (row0 + ai * HALF + m * 16), s); if (WG2) unsafeAtomicAdd(ssqB_out + (row0 + ai * HALF + m * 16), sb); } }
        }
    }
};

struct EpiMulti {
    static constexpr bool PERM = true, AFTER_DRAIN = false;
    int kind; int i0; float f0;
    void* p0; void* p1; void* p2; const float* g0; const float* g1; const float* ssqA; const float* ssqB; const float* bvec;
    const float* lazy_ssq; const float* lazy_g; void* aout; const float* wg; const float* wsc; const float* wg2; float* ssq_out; float* ssqB_out;
};

#ifndef EPIMASK
#define EPIMASK 15
#endif
struct EpiLds {
    static constexpr bool PERM = true, AFTER_DRAIN = false;
    const PG8_LAS unsigned* d;
    __device__ __forceinline__ unsigned u(int i) const { return (unsigned)__builtin_amdgcn_readfirstlane((int)d[i]); }
    template <class T> __device__ __forceinline__ T* p(int i) const { const unsigned long long lo = u(i), hi = u(i + 1); return (T*)(__attribute__((address_space(1))) T*)((hi << 32) | lo); }
    __device__ __forceinline__ void operator()(const f32x4 (&acc)[2][2][4][2], const Unit& un, int wr, int wc, int fr, int fq) const {
        const int kind = (int)u(0);
        { const int t_ = opaque_tid(), w_ = __builtin_amdgcn_readfirstlane(t_ >> 6), l_ = t_ & 63; wr = w_ >> 2; wc = w_ & 3; fr = l_ & 15; fq = l_ >> 4; }
        if ((EPIMASK & 1) && kind == 0) EpiSwiglu::run(acc, un, wr, wc, fr, fq, p<bf16_t>(4), (int)u(1), p<const float>(14), p<const float>(16), p<const float>(18));
        else if ((EPIMASK & 2) && kind == 1) EpiResidT<false, false>::run(acc, un, wr, wc, fr, fq, p<const float>(10), p<float>(4), p<const float>(12), __uint_as_float(u(2)), nullptr, nullptr, p<bf16_t>(24), p<const float>(26), p<const float>(28), nullptr, p<float>(32), nullptr);
        else if ((EPIMASK & 2) && kind == 4) EpiResidT<false, true>::run(acc, un, wr, wc, fr, fq, p<const float>(10), p<float>(4), p<const float>(12), __uint_as_float(u(2)), nullptr, nullptr, p<bf16_t>(24), p<const float>(26), p<const float>(28), p<const float>(30), p<float>(32), p<float>(34));
        else if ((EPIMASK & 2) && kind == 5) EpiResidT<true, false>::run(acc, un, wr, wc, fr, fq, p<const float>(10), p<float>(4), p<const float>(12), __uint_as_float(u(2)), p<const float>(20), p<const float>(22), p<bf16_t>(24), p<const float>(26), p<const float>(28), nullptr, p<float>(32), nullptr);
        else if ((EPIMASK & 4) && kind == 2) EpiQKV::run(acc, un, wr, wc, fr, fq, p<bf16_t>(4), p<bf16_t>(6), p<bf16_t>(8), p<const float>(10), p<const float>(12), __uint_as_float(u(2)), p<const float>(14), p<const float>(18));
        else if (EPIMASK & 8) EpiGelu::run(acc, un, wr, wc, fr, fq, p<bf16_t>(4), (int)u(1), p<const float>(14), p<const float>(18));
    }
};

template <class Epi, class Sched, bool ALIGN_EPI = false, bool SP2 = false>
__device__ __forceinline__ void gemm_phase(PG8_LAS unsigned char* lds, const Gemm g, const Sched& S, const Epi& E) {
    const int tid = opaque_tid(), wid = __builtin_amdgcn_readfirstlane(tid >> 6), lane = tid & 63, wr = wid >> 2, wc = wid & 3, fr = lane & 15, fq = lane >> 4;
    const int K = g.K, nt = K / BK;
    unsigned voffA[2], voffB[2];
#pragma unroll
    for (int i = 0; i < 2; ++i) { int R, C; stage_rc(tid * 16 + i * 8192, R, C); const int Rb = Epi::PERM ? ((R & ~31) + perm32(R & 31)) : R;
        voffA[i] = (unsigned)(R * K + C) * 2u; voffB[i] = (unsigned)(Rb * K + C) * 2u; }
    const size_t kstep = (size_t)(BK * 2);
    const size_t hstep = (size_t)HALF * K * 2;
    const size_t tstep = 2 * hstep;
    const unsigned ldsw = (unsigned)wid * 1024u;
    const int aoff = lds_byte(wr * 64 + fr, fq * 8), boff = lds_byte(wc * 32 + fr, fq * 8);
#define PG8_SA(b, h) (((b) * 2 + (h)) * HTB)
#define PG8_SB(b, h) ((4 + (b) * 2 + (h)) * HTB)
#define PG8_STAGE(bufoff, gbase, voff) do { _Pragma("unroll") for (int _i = 0; _i < 2; ++_i) \
        __builtin_amdgcn_global_load_lds((const unsigned*)((const char*)(gbase) + (voff)[_i]), (PG8_LAS unsigned*)(lds + (bufoff) + ldsw + _i * 8192), 16, 0, 0); } while (0)
#define PG8_LDA(dst, b, h) do { _Pragma("unroll") for (int m = 0; m < 4; ++m) _Pragma("unroll") for (int k = 0; k < 2; ++k) dst[m][k] = *(const PG8_LAS bf16x8*)(lds + PG8_SA(b, h) + aoff + m * 2048 + k * 1024); } while (0)
#define PG8_LDB(dst, b, h) do { _Pragma("unroll") for (int n = 0; n < 2; ++n) _Pragma("unroll") for (int k = 0; k < 2; ++k) dst[n][k] = *(const PG8_LAS bf16x8*)(lds + PG8_SB(b, h) + boff + n * 2048 + k * 1024); } while (0)
#define PG8_MMA(ai, bj, At, Bt) do { __builtin_amdgcn_s_setprio(1); _Pragma("unroll") for (int m = 0; m < 4; ++m) _Pragma("unroll") for (int n = 0; n < 2; ++n) _Pragma("unroll") for (int k = 0; k < 2; ++k) \
        acc[ai][bj][m][n] = __builtin_amdgcn_mfma_f32_16x16x32_bf16(Bt[n][k], At[m][k], acc[ai][bj][m][n], 0, 0, 0); __builtin_amdgcn_s_setprio(0); } while (0)
#define PG8_WAIT_V(n) asm volatile("s_waitcnt vmcnt(" #n ")" ::: "memory")
#define PG8_WAIT_L(n) asm volatile("s_waitcnt lgkmcnt(" #n ")" ::: "memory")
#define PG8_BAR __builtin_amdgcn_s_barrier()
#define PG8_SCHED __builtin_amdgcn_sched_barrier(0)
    Unit cur, nxt; int ui = 0;
    if (!S.next(0, cur)) return;
    f32x4 acc[2][2][4][2];
#pragma unroll
    for (int a = 0; a < 2; ++a)
#pragma unroll
        for (int b = 0; b < 2; ++b)
#pragma unroll
            for (int m = 0; m < 4; ++m)
#pragma unroll
                for (int n = 0; n < 2; ++n) acc[a][b][m][n] = (f32x4){0.f, 0.f, 0.f, 0.f};
    bf16x8 At[4][2], B0[2][2], B1[2][2];
    const char* cA = (const char*)g.A + (size_t)cur.pm * tstep; const char* cB = (const char*)g.Bt + (size_t)cur.pn * tstep;
    S.a_ready(cur);
    if constexpr (SP2) {
        PG8_STAGE(PG8_SB(0, 0), cB, voffB); PG8_STAGE(PG8_SB(0, 1), cB + hstep, voffB); PG8_STAGE(PG8_SA(0, 0), cA, voffA); PG8_STAGE(PG8_SA(0, 1), cA + hstep, voffA);
        if (wr == 1) PG8_BAR;
        PG8_WAIT_V(2); PG8_BAR;
        PG8_STAGE(PG8_SB(1, 0), cB + kstep, voffB); PG8_STAGE(PG8_SA(1, 0), cA + kstep, voffA); PG8_STAGE(PG8_SB(1, 1), cB + hstep + kstep, voffB);
        PG8_WAIT_V(6); PG8_BAR;
    } else {
        PG8_STAGE(PG8_SB(0, 0), cB, voffB); PG8_STAGE(PG8_SA(0, 0), cA, voffA); PG8_STAGE(PG8_SB(0, 1), cB + hstep, voffB); PG8_STAGE(PG8_SA(0, 1), cA + hstep, voffA);
        if (wr == 1) PG8_BAR;
        PG8_WAIT_V(4); PG8_BAR;
        PG8_STAGE(PG8_SB(1, 0), cB + kstep, voffB); PG8_STAGE(PG8_SA(1, 0), cA + kstep, voffA); PG8_STAGE(PG8_SB(1, 1), cB + hstep + kstep, voffB);
        PG8_WAIT_V(6); PG8_BAR;
    }
    for (;;) {
        const bool has_next = S.next(ui + 1, nxt);
        const char* nA = has_next ? (const char*)g.A + (size_t)nxt.pm * tstep : cA; const char* nB = has_next ? (const char*)g.Bt + (size_t)nxt.pn * tstep : cB;
        for (int t = 0; t < nt; t += 2) {
            const bool last = (t == nt - 2);
            const char* a1 = cA + (size_t)(t + 1) * kstep;
            const char* a2 = last ? nA : cA + (size_t)(t + 2) * kstep; const char* b2 = last ? nB : cB + (size_t)(t + 2) * kstep;
            const char* a3 = a2 + kstep; const char* b3 = b2 + kstep;
            if (last && has_next) S.a_ready(nxt);
            if constexpr (SP2) {
            PG8_LDB(B0, 0, 0); PG8_LDB(B1, 0, 1); PG8_SCHED; PG8_LDA(At, 0, 0); PG8_STAGE(PG8_SA(1, 1), a1 + hstep, voffA);
            PG8_WAIT_V(8); PG8_WAIT_L(0); PG8_BAR; PG8_MMA(0, 0, At, B0); PG8_MMA(0, 1, At, B1); PG8_BAR; PG8_SCHED;
            PG8_LDA(At, 0, 1); PG8_STAGE(PG8_SB(0, 0), b2, voffB); PG8_STAGE(PG8_SB(0, 1), b2 + hstep, voffB); PG8_STAGE(PG8_SA(0, 0), a2, voffA);
            PG8_WAIT_V(8); PG8_WAIT_L(0); PG8_BAR; PG8_MMA(1, 0, At, B0); PG8_MMA(1, 1, At, B1); PG8_BAR; PG8_SCHED;
            PG8_LDB(B0, 1, 0); PG8_LDB(B1, 1, 1); PG8_SCHED; PG8_LDA(At, 1, 0); PG8_STAGE(PG8_SA(0, 1), a2 + hstep, voffA);
            PG8_WAIT_V(8); PG8_WAIT_L(0); PG8_BAR; PG8_MMA(0, 0, At, B0); PG8_MMA(0, 1, At, B1); PG8_BAR; PG8_SCHED;
            PG8_LDA(At, 1, 1); PG8_STAGE(PG8_SB(1, 0), b3, voffB); PG8_STAGE(PG8_SB(1, 1), b3 + hstep, voffB); PG8_STAGE(PG8_SA(1, 0), a3, voffA);
            PG8_WAIT_V(8); PG8_WAIT_L(0); PG8_BAR; PG8_MMA(1, 0, At, B0); PG8_MMA(1, 1, At, B1); PG8_BAR; PG8_SCHED;
            } else {
            PG8_LDB(B0, 0, 0); PG8_SCHED; PG8_LDA(At, 0, 0); PG8_STAGE(PG8_SA(1, 1), a1 + hstep, voffA);
            PG8_WAIT_L(8); PG8_BAR; PG8_WAIT_L(0); PG8_MMA(0, 0, At, B0); PG8_BAR; PG8_SCHED;
            PG8_LDB(B1, 0, 1); PG8_STAGE(PG8_SB(0, 0), b2, voffB);
            PG8_BAR; PG8_WAIT_L(0); PG8_MMA(0, 1, At, B1); PG8_BAR;
            PG8_LDA(At, 0, 1); PG8_STAGE(PG8_SA(0, 0), a2, voffA);
            PG8_BAR; PG8_WAIT_L(0); PG8_MMA(1, 0, At, B0); PG8_BAR; PG8_SCHED;
            PG8_STAGE(PG8_SB(0, 1), b2 + hstep, voffB);
            PG8_WAIT_V(6); PG8_BAR; PG8_MMA(1, 1, At, B1); PG8_BAR;
            PG8_LDB(B0, 1, 0); PG8_SCHED; PG8_LDA(At, 1, 0); PG8_STAGE(PG8_SA(0, 1), a2 + hstep, voffA);
            PG8_WAIT_L(8); PG8_BAR; PG8_WAIT_L(0); PG8_MMA(0, 0, At, B0); PG8_BAR; PG8_SCHED;
            PG8_LDB(B1, 1, 1); PG8_STAGE(PG8_SB(1, 0), b3, voffB);
            PG8_BAR; PG8_WAIT_L(0); PG8_MMA(0, 1, At, B1); PG8_BAR;
            PG8_LDA(At, 1, 1); PG8_STAGE(PG8_SA(1, 0), a3, voffA);
            PG8_BAR; PG8_WAIT_L(0); PG8_MMA(1, 0, At, B0); PG8_BAR; PG8_SCHED;
            PG8_STAGE(PG8_SB(1, 1), b3 + hstep, voffB);
            PG8_WAIT_V(6); PG8_BAR; PG8_MMA(1, 1, At, B1); PG8_BAR;
            }
        }
        if constexpr (ALIGN_EPI) { if (wr == 0) PG8_BAR; }
        if constexpr (!Epi::AFTER_DRAIN) { E(acc, cur, wr, wc, fr, fq); S.done(cur); }
        if (!has_next) break;
#pragma unroll
        for (int a = 0; a < 2; ++a)
#pragma unroll
            for (int b = 0; b < 2; ++b)
#pragma unroll
                for (int m = 0; m < 4; ++m)
#pragma unroll
                    for (int n = 0; n < 2; ++n) acc[a][b][m][n] = (f32x4){0.f, 0.f, 0.f, 0.f};
        cur = nxt; cA = nA; cB = nB; ++ui;
        if constexpr (ALIGN_EPI) { if (wr == 1) PG8_BAR; }
    }
    PG8_WAIT_V(0);
    if constexpr (!ALIGN_EPI) { if (wr == 0) PG8_BAR; }
    PG8_BAR;
    if constexpr (Epi::AFTER_DRAIN) { E.fused(acc, cur, wr, wc, fr, fq, lds, wid, lane); S.done(cur); }
#undef PG8_SA
#undef PG8_SB
#undef PG8_STAGE
#undef PG8_LDA
#undef PG8_LDB
#undef PG8_MMA
#undef PG8_WAIT_V
#undef PG8_WAIT_L
#undef PG8_BAR
#undef PG8_SCHED
}
}

namespace att {
#define ALDS __attribute__((address_space(3)))
typedef short bf16x8 __attribute__((ext_vector_type(8)));
typedef short s16x4 __attribute__((ext_vector_type(4)));
typedef float f32x16 __attribute__((ext_vector_type(16)));
typedef float f32x2 __attribute__((ext_vector_type(2)));
typedef unsigned u32x4 __attribute__((ext_vector_type(4)));
typedef unsigned short bf16_t;
constexpr int SEQ = 8192, DM = 1024, KVB = 64, QU = 128, NSLOT = 4, SLOT = 16384;
constexpr int L_K = 0, L_V = NSLOT * SLOT, L_LUT = 131072, L_LB = L_LUT + 512;
constexpr float LOG2E = 1.4426950408889634f, C2 = 0.125f * LOG2E;
__device__ __forceinline__ int crow(int r, int hi) { return (r & 3) + 8 * (r >> 2) + 4 * hi; }
__device__ __forceinline__ void glds16(const void* gsrc, unsigned lds_dst) { unsigned keep;
    asm volatile("s_mov_b32 %0, m0\n\ts_mov_b32 m0, %2\n\ts_nop 0\n\tglobal_load_lds_dwordx4 %1, off\n\ts_mov_b32 m0, %0" : "=&s"(keep) : "v"(gsrc), "s"(lds_dst) : "memory"); }
__device__ __forceinline__ void glds16s(unsigned voff, const void* sbase, unsigned lds_dst) { unsigned keep;
    asm volatile("s_mov_b32 %0, m0\n\ts_mov_b32 m0, %3\n\ts_nop 0\n\tglobal_load_lds_dwordx4 %1, %2\n\ts_mov_b32 m0, %0" : "=&s"(keep) : "v"(voff), "s"(sbase), "s"(lds_dst) : "memory"); }
__device__ __forceinline__ unsigned cvtpk(float lo, float hi) { typedef float f2 __attribute__((ext_vector_type(2))); typedef __bf16 b2 __attribute__((ext_vector_type(2)));
    f2 v = {lo, hi}; b2 r = __builtin_convertvector(v, b2); return __builtin_bit_cast(unsigned, r); }
__device__ __forceinline__ float bf2f(short s) { return __uint_as_float(((unsigned)(unsigned short)s) << 16); }
typedef short v4i16_t __attribute__((ext_vector_type(4)));
__device__ __forceinline__ s16x4 vtr(const ALDS unsigned char* p) { return __builtin_bit_cast(s16x4, __builtin_amdgcn_ds_read_tr16_b64_v4i16((ALDS v4i16_t*)p)); }
#define ATT_WAIT_BAR(N) asm volatile("s_waitcnt vmcnt(" #N ") lgkmcnt(0)\n\ts_barrier" ::: "memory")

__device__ __forceinline__ float attn_head_setup(ALDS unsigned char* lds, const float* relb, int h) {
    const int tid = threadIdx.x; ALDS float* lut = (ALDS float*)(lds + L_LUT);
    if (tid < 128) { const int n = tid; int bk; if (n < 16) bk = n; else { const int lg = 16 + (int)(logf((float)n / 16.0f) / logf(8.0f) * 16.0f); bk = lg < 31 ? lg : 31; }
        lut[tid] = (relb[bk * 8 + h] - relb[31 * 8 + h]) * LOG2E; }
    float bmax = -1e30f;
    for (int i = 0; i < 32; ++i) bmax = fmaxf(bmax, relb[i * 8 + h]);
    return (bmax - relb[31 * 8 + h]) * LOG2E;
}
__device__ __forceinline__ void attn_unit(int b, int h, int qb, const bf16_t* Q, const bf16_t* K, const bf16_t* V, bf16_t* O, ALDS unsigned char* lds,
                                          float bmax, float lut31, float lam, float kmaxn, const float* subg, float outscale) {
    const int tid = opaque_tid(), lane = tid & 63, r32 = lane & 31, hi = lane >> 5;
    const int wid = __builtin_amdgcn_readfirstlane(tid >> 6), comp = wid >> 2, qw = wid & 3;
    const long rowbase = (long)b * SEQ; const int q0 = qb * QU;
    const unsigned lds0 = (unsigned)(uintptr_t)lds;
    ALDS float* lut = (ALDS float*)(lds + L_LUT);
    const bf16_t* Kh = K + rowbase * DM + h * 128; const bf16_t* Vh = V + rowbase * DM + h * 128;
    const int gdma = ((lane >> 4) << 2) | (wid & 3);
    const unsigned dof0 = (unsigned)((4 * wid + (lane >> 4)) * DM + ((lane & 15) ^ gdma) * 8) * 2u, dof1 = dof0 + 32u * DM * 2u;
    const unsigned kdst = lds0 + L_K + wid * 1024, vdst = lds0 + L_V + wid * 1024;
#define ATT_DMA(t, s) do { const bf16_t* kt_ = Kh + (long)(t) * KVB * DM; const bf16_t* vt_ = Vh + (long)(t) * KVB * DM; const unsigned so_ = (unsigned)(s) * SLOT; \
        glds16s(dof0, kt_, (unsigned)__builtin_amdgcn_readfirstlane(kdst + so_)); glds16s(dof1, kt_, (unsigned)__builtin_amdgcn_readfirstlane(kdst + so_ + 8192)); \
        glds16s(dof0, vt_, (unsigned)__builtin_amdgcn_readfirstlane(vdst + so_)); glds16s(dof1, vt_, (unsigned)__builtin_amdgcn_readfirstlane(vdst + so_ + 8192)); } while (0)
    const int NT = 2 * (qb + 1);
    ATT_DMA(0, 0); ATT_DMA(1, 1); if (NT > 2) ATT_DMA(2, 2);
    const bf16_t* Qw = Q + (rowbase + q0 + qw * 32 + r32) * DM + h * 128 + comp * 64 + hi * 8;
    bf16x8 qr[4];
#pragma unroll
    for (int d0 = 0; d0 < 4; ++d0) qr[d0] = *(const bf16x8*)(Qw + d0 * 16);
    float ssq = 0.f;
#pragma unroll
    for (int d0 = 0; d0 < 4; ++d0)
#pragma unroll
        for (int i = 0; i < 8; ++i) { const float f = bf2f(qr[d0][i]); ssq += f * f; }
    ssq = xadd<32>(ssq);
    const float bound = sqrtf(ssq) * kmaxn + bmax;
    const bool needshift = __any(bound > 60.0f);
    f32x16 o[4];
#pragma unroll
    for (int d0 = 0; d0 < 4; ++d0)
#pragma unroll
        for (int r = 0; r < 16; ++r) o[d0][r] = 0.f;
    float l = 0.f;
    const int qabs = q0 + qw * 32 + r32;
    const ALDS unsigned char* kp0 = lds + L_K + 256 * r32;
    int kofs[4]; { const int gk = ((r32 & 3) << 2) | ((r32 >> 2) & 3);
#pragma unroll
        for (int d0 = 0; d0 < 4; ++d0) kofs[d0] = 16 * ((8 * comp + 2 * d0 + hi) ^ gk); }
    const ALDS unsigned char* vp0 = lds + L_V;
    int vofs[4][2]; { const int blk = (lane >> 4) & 1, q = (lane & 15) >> 2, p = lane & 3;
#pragma unroll
        for (int c = 0; c < 4; ++c)
#pragma unroll
            for (int t2 = 0; t2 < 2; ++t2) { const int gv = (q << 2) | ((hi + 2 * t2) & 3); vofs[c][t2] = 256 * (4 * hi + 8 * t2 + q) + 16 * ((4 * c + 2 * blk + (p >> 1)) ^ gv) + 8 * (p & 1); } }
    if (NT > 2) ATT_WAIT_BAR(8); else ATT_WAIT_BAR(4);
    bf16x8 kf[8];
#pragma unroll
    for (int d0 = 0; d0 < 4; ++d0) { kf[2 * d0] = *(const ALDS bf16x8*)(kp0 + kofs[d0]); kf[2 * d0 + 1] = *(const ALDS bf16x8*)(kp0 + kofs[d0] + 8192); }
    f32x16 p0, p1; u32x4 w[4]; const f32x16 zero16 = {};
#define ATT_QK(t) do { \
        p0 = __builtin_amdgcn_mfma_f32_32x32x16_bf16(kf[0], qr[0], zero16, 0, 0, 0); p1 = __builtin_amdgcn_mfma_f32_32x32x16_bf16(kf[1], qr[0], zero16, 0, 0, 0); \
        _Pragma("unroll") for (int d0 = 1; d0 < 4; ++d0) { \
            p0 = __builtin_amdgcn_mfma_f32_32x32x16_bf16(kf[2 * d0], qr[d0], p0, 0, 0, 0); \
            p1 = __builtin_amdgcn_mfma_f32_32x32x16_bf16(kf[2 * d0 + 1], qr[d0], p1, 0, 0, 0); } } while (0)
#define ATT_SYNC(t) do { if ((t) + 1 < NT) { \
            if ((t) + 2 < NT) ATT_WAIT_BAR(4); else ATT_WAIT_BAR(0);         \
            if ((t) + 3 < NT) ATT_DMA((t) + 3, ((t) + 3) & 3); \
            const ALDS unsigned char* kp_ = kp0 + (((t) + 1) & 3) * SLOT; \
            _Pragma("unroll") for (int d0 = 0; d0 < 4; ++d0) { kf[2 * d0] = *(const ALDS bf16x8*)(kp_ + kofs[d0]); kf[2 * d0 + 1] = *(const ALDS bf16x8*)(kp_ + kofs[d0] + 8192); } } } while (0)
#define ATT_EXP(t) do { if ((t) >= NT - 4) { const int relb0 = qabs - ((t) * KVB + 4 * hi); \
            _Pragma("unroll") for (int r = 0; r < 16; ++r) { \
                const int rel = relb0 - ((r & 3) + 8 * (r >> 2)); const int rel1 = rel - 32; \
                const float a0 = lut[rel < 0 ? 0 : (rel > 127 ? 127 : rel)], a1 = lut[rel1 < 0 ? 0 : (rel1 > 127 ? 127 : rel1)]; \
                p0[r] = rel < 0 ? -INFINITY : p0[r] + a0; p1[r] = rel1 < 0 ? -INFINITY : p1[r] + a1; } } \
        if (needshift) { _Pragma("unroll") for (int r = 0; r < 16; ++r) { p0[r] -= bound; p1[r] -= bound; } } \
        float sacc = 0.f; \
        _Pragma("unroll") for (int r = 0; r < 16; ++r) { p0[r] = __builtin_amdgcn_exp2f(p0[r]); p1[r] = __builtin_amdgcn_exp2f(p1[r]); sacc += p0[r] + p1[r]; } \
        l += sacc; \
        w[0] = (u32x4){cvtpk(p0[0], p0[1]), cvtpk(p0[2], p0[3]), cvtpk(p0[4], p0[5]), cvtpk(p0[6], p0[7])}; \
        w[1] = (u32x4){cvtpk(p0[8], p0[9]), cvtpk(p0[10], p0[11]), cvtpk(p0[12], p0[13]), cvtpk(p0[14], p0[15])}; \
        w[2] = (u32x4){cvtpk(p1[0], p1[1]), cvtpk(p1[2], p1[3]), cvtpk(p1[4], p1[5]), cvtpk(p1[6], p1[7])}; \
        w[3] = (u32x4){cvtpk(p1[8], p1[9]), cvtpk(p1[10], p1[11]), cvtpk(p1[12], p1[13]), cvtpk(p1[14], p1[15])}; } while (0)
#define ATT_PV(t) do { const ALDS unsigned char* vp_ = vp0 + ((t) & 3) * SLOT; \
        _Pragma("unroll") for (int ks = 0; ks < 4; ++ks) { const bf16x8 pa = __builtin_bit_cast(bf16x8, w[ks]); \
            _Pragma("unroll") for (int d0 = 0; d0 < 4; ++d0) { \
                const s16x4 vl = vtr(vp_ + vofs[d0][0] + ks * 4096), vh = vtr(vp_ + vofs[d0][1] + ks * 4096); \
                const bf16x8 vf = (bf16x8){vl[0], vl[1], vl[2], vl[3], vh[0], vh[1], vh[2], vh[3]}; \
                o[d0] = __builtin_amdgcn_mfma_f32_32x32x16_bf16(pa, vf, o[d0], 0, 0, 0); } } } while (0)
    if (comp == 0) {
        for (int t = 0; t < NT; ++t) { ATT_QK(t); ATT_SYNC(t); ATT_EXP(t); ATT_PV(t); }
    } else {
        ATT_QK(0); ATT_EXP(0);
        for (int t = 0; t < NT; ++t) { ATT_SYNC(t); ATT_PV(t); if (t + 1 < NT) { ATT_QK(t + 1); ATT_EXP(t + 1); } }
    }
#undef ATT_QK
#undef ATT_SYNC
#undef ATT_EXP
#undef ATT_PV
    l = xadd<32>(l);
    ATT_WAIT_BAR(0);
    ALDS float* ob = (ALDS float*)lds + comp * (QU * 128);
    ALDS float* lb = (ALDS float*)(lds + L_LB);
    if (hi == 0) lb[comp * QU + qw * 32 + r32] = l;
#pragma unroll
    for (int d0 = 0; d0 < 4; ++d0)
#pragma unroll
        for (int r = 0; r < 16; ++r) ob[(qw * 32 + crow(r, hi)) * 128 + d0 * 32 + r32] = o[d0][r];
    ATT_WAIT_BAR(0);
    {
        typedef float f32x4_t __attribute__((ext_vector_type(4)));
        const int rsub = lane >> 4, c16 = lane & 15;
        const f32x4_t sg0 = *(const f32x4_t*)(subg + 8 * c16), sg1 = *(const f32x4_t*)(subg + 8 * c16 + 4);
#pragma unroll
        for (int it = 0; it < 4; ++it) {
            const int q = 16 * wid + 4 * it + rsub;
            const ALDS unsigned char* pa = lds + (q * 128 + 8 * c16) * 4;
            const f32x4_t a0 = *(const ALDS f32x4_t*)pa, a1 = *(const ALDS f32x4_t*)(pa + 16), b0 = *(const ALDS f32x4_t*)(pa + 65536), b1 = *(const ALDS f32x4_t*)(pa + 65536 + 16);
            const float i1 = 1.0f / lb[q], i2 = lam / lb[QU + q];
            const f32x4_t x0 = a0 * i1 - b0 * i2, x1 = a1 * i1 - b1 * i2;
            float ss = ((x0[0] * x0[0] + x0[1] * x0[1]) + (x0[2] * x0[2] + x0[3] * x0[3])) + ((x1[0] * x1[0] + x1[1] * x1[1]) + (x1[2] * x1[2] + x1[3] * x1[3]));
            ss = xadd<1>(ss); ss = xadd<2>(ss); ss = xadd<4>(ss); ss = xadd<8>(ss);
            const float rs = outscale * __builtin_amdgcn_rsqf(ss * (1.0f / 128.0f) + 1e-6f);
            const f32x4_t y0 = x0 * rs * sg0, y1 = x1 * rs * sg1;
            u32x4 w4; w4.x = cvtpk(y0[0], y0[1]); w4.y = cvtpk(y0[2], y0[3]); w4.z = cvtpk(y1[0], y1[1]); w4.w = cvtpk(y1[2], y1[3]);
            *(u32x4*)(O + (rowbase + q0 + q) * DM + h * 128 + 8 * c16) = w4;
        }
    }
    ATT_WAIT_BAR(0);
#undef ATT_DMA
}
}

#define LAS __attribute__((address_space(3)))
typedef unsigned short bf16;
typedef unsigned v4u __attribute__((ext_vector_type(4)));
typedef unsigned v2u __attribute__((ext_vector_type(2)));
typedef float f32x4 __attribute__((ext_vector_type(4)));
typedef float f32x2 __attribute__((ext_vector_type(2)));
typedef short bf16x8 __attribute__((ext_vector_type(8)));
constexpr int NWAVES = 8, NTHREADS = 512;
constexpr int M = 32768, D = 1024, F = 2816, SEQ = 8192, NB = 4, NMOD = 9 * 1024;
constexpr int LDS_BYTES = 147456;
constexpr size_t MiB = 1u << 20;
constexpr size_t WS_MOD = 0;
constexpr size_t WS_BV = 512 * 1024;
constexpr size_t WS_BAR = 960 * 1024;
constexpr size_t WS_SSQ = 1 * MiB;
constexpr size_t WS_W = 2 * MiB;
constexpr size_t W_FFN_STRIDE = 33 * MiB / 2;
constexpr size_t W_GU_BYTES = 11 * MiB;
constexpr size_t WS_WQKV = WS_W + 66 * MiB, WS_WO = WS_W + 72 * MiB, WS_WIN = WS_W + 74 * MiB, WS_WOUT = WS_W + 78 * MiB;
constexpr size_t WS_A = 83 * MiB;
constexpr size_t WS_O = 147 * MiB;
constexpr size_t WS_H = 211 * MiB;
constexpr size_t WS_Q = WS_H, WS_K = WS_H + 64 * MiB, WS_V = WS_H + 128 * MiB;
constexpr size_t WS_Z = WS_H, WS_G = WS_H + 128 * MiB;
constexpr size_t WS_END = 403 * MiB;

__device__ __forceinline__ unsigned pk2(float lo, float hi) { unsigned r; asm volatile("v_cvt_pk_bf16_f32 %0, %1, %2" : "=v"(r) : "v"(lo), "v"(hi)); return r; }
__device__ __forceinline__ float bf_lo(unsigned w) { return __uint_as_float(w << 16); }
__device__ __forceinline__ float bf_hi(unsigned w) { return __uint_as_float(w & 0xffff0000u); }
__device__ __forceinline__ void transpose_item(const float* W, int K, int N, bf16* WT, int kb, int n0, int row_base, LAS float* scr, int lane) {
    const int k0 = 64 * kb;
    f32x4 wv[8];
#pragma unroll
    for (int i = 0; i < 8; ++i) wv[i] = *(const f32x4*)(W + (size_t)(k0 + 8 * i + (lane >> 3)) * N + n0 + 4 * (lane & 7));
#pragma unroll
    for (int i = 0; i < 8; ++i) { LAS float* d = scr + (8 * i + (lane >> 3)) * 33 + 4 * (lane & 7); d[0] = wv[i].x; d[1] = wv[i].y; d[2] = wv[i].z; d[3] = wv[i].w; }
    asm volatile("s_waitcnt lgkmcnt(0)" ::: "memory");
    const int c = lane & 7;
#pragma unroll
    for (int j = 0; j < 4; ++j) { const int n = (lane >> 3) + 8 * j; const LAS float* s = scr + (8 * c) * 33 + n;
        v4u o; o.x = pk2(s[0 * 33], s[1 * 33]); o.y = pk2(s[2 * 33], s[3 * 33]); o.z = pk2(s[4 * 33], s[5 * 33]); o.w = pk2(s[6 * 33], s[7 * 33]);
        *(v4u*)(WT + (size_t)(row_base + n) * K + k0 + 8 * c) = o; }
    asm volatile("s_waitcnt lgkmcnt(0)" ::: "memory");
}

struct Params { const float* in[30]; float* out; unsigned char* ws; int ph_lo, ph_hi; };
struct PL {
    const LAS unsigned* d;
    __device__ __forceinline__ unsigned u(int i) const { return (unsigned)__builtin_amdgcn_readfirstlane((int)d[i]); }
    __device__ __forceinline__ const float* in(int i) const { const unsigned long long lo = u(2 * i), hi = u(2 * i + 1); return (const float*)(const __attribute__((address_space(1))) float*)((hi << 32) | lo); }
    __device__ __forceinline__ float* out() const { const unsigned long long lo = u(60), hi = u(61); return (float*)(__attribute__((address_space(1))) float*)((hi << 32) | lo); }
    __device__ __forceinline__ unsigned char* ws() const { const unsigned long long lo = u(62), hi = u(63); return (unsigned char*)(__attribute__((address_space(1))) unsigned char*)((hi << 32) | lo); }
};
enum { I_X = 0, I_C, I_RELB, I_ADAW, I_ADAB, I_LNF1, I_F1G, I_F1U, I_F1D, I_LNMIX, I_LNF2, I_F2G, I_F2U, I_F2D, I_LNOUT, I_WQKV, I_QN, I_KN, I_LQ1, I_LK1, I_LQ2, I_LK2, I_SUBLN, I_WO,
       I_WIN, I_SLNG, I_SLNB, I_SWS, I_SBS, I_WOUT };
constexpr int NPHASE = 17;
#ifndef PHMASK
#define PHMASK 0xff
#endif

__device__ __forceinline__ void convert_weights(const PL& P, LAS unsigned char* lds, int gw, int NGW, int wave, int lane) {
    LAS float* scr = (LAS float*)(lds + wave * 8448);
    constexpr int IT_F = 1408, IT_FFN = 12 * IT_F, IT_QKV = 1536, IT_WO = 512, IT_WIN = 1024, IT_WOUT = 512;
    constexpr int NITEMS = IT_FFN + IT_QKV + IT_WO + IT_WIN + IT_WOUT;
    for (int it = gw; it < NITEMS; it += NGW) {
        int r = it;
        if (r < IT_FFN) {
            const int mi = r / IT_F, ri = r % IT_F; const int l = mi / 6, w = mi % 6; const int f = w / 3, kind = w % 3;
            bf16* gu = (bf16*)(P.ws() + WS_W + (size_t)(l * 2 + f) * W_FFN_STRIDE); bf16* dn = (bf16*)((unsigned char*)gu + W_GU_BYTES);
            if (kind < 2) { const float* W = (f == 0 ? (kind == 0 ? P.in(I_F1G) : P.in(I_F1U)) : (kind == 0 ? P.in(I_F2G) : P.in(I_F2U))) + (size_t)l * D * F; const int nblk = F / 32, kb = ri / nblk, n0 = 32 * (ri % nblk);
                transpose_item(W, D, F, gu, kb, n0, 256 * (n0 >> 7) + (n0 & 127) + 128 * kind, scr, lane); }
            else { const float* W = (f == 0 ? P.in(I_F1D) : P.in(I_F2D)) + (size_t)l * F * D; const int nblk = D / 32, kb = ri / nblk, n0 = 32 * (ri % nblk);
                transpose_item(W, F, D, dn, kb, n0, n0, scr, lane); }
            continue;
        }
        r -= IT_FFN;
        if (r < IT_QKV) { const int nblk = 3072 / 32, kb = r / nblk, n0 = 32 * (r % nblk); const int pn = n0 >> 8, rr = n0 & 255, wc = rr >> 6, bj = (rr >> 5) & 1;
            transpose_item(P.in(I_WQKV), D, 3072, (bf16*)(P.ws() + WS_WQKV), kb, n0, 256 * pn + 128 * bj + 32 * wc, scr, lane); continue; }
        r -= IT_QKV;
        if (r < IT_WO) { const int nblk = D / 32, kb = r / nblk, n0 = 32 * (r % nblk); transpose_item(P.in(I_WO), D, D, (bf16*)(P.ws() + WS_WO), kb, n0, n0, scr, lane); continue; }
        r -= IT_WO;
        if (r < IT_WIN) { const int nblk = 2048 / 32, kb = r / nblk, n0 = 32 * (r % nblk); transpose_item(P.in(I_WIN), D, 2048, (bf16*)(P.ws() + WS_WIN), kb, n0, n0, scr, lane); continue; }
        r -= IT_WIN;
        { const int nblk = D / 32, kb = r / nblk, n0 = 32 * (r % nblk); transpose_item(P.in(I_WOUT), D, D, (bf16*)(P.ws() + WS_WOUT), kb, n0, n0, scr, lane); }
    }
}

__device__ __forceinline__ void ada_phase(const PL& P, LAS unsigned char* lds, int vcu, int G, int tid, int wave, int lane) {
    if (vcu >= 144) return;
    LAS float* cact = (LAS float*)(lds + 69632);
    LAS float* red = (LAS float*)(lds + 86016);
    const float* c = P.in(I_C);
    for (int i = tid; i < 4096; i += NTHREADS) { const float x = c[i]; cact[i] = x / (1.0f + expf(-x)); }
    __syncthreads();
    float* mod = (float*)(P.ws() + WS_MOD);
    for (int item = vcu; item < 144; item += G) {
        const int l = item / 72, jb = item % 72;
        const float* W = P.in(I_ADAW) + (size_t)l * D * NMOD + jb * 128 + 2 * lane;
        float acc[4][2];
#pragma unroll
        for (int b = 0; b < 4; ++b) { acc[b][0] = 0.f; acc[b][1] = 0.f; }
#pragma unroll 8
        for (int kk = 0; kk < 128; ++kk) { const int k = wave * 128 + kk; const f32x2 w = *(const f32x2*)(W + (size_t)k * NMOD);
#pragma unroll
            for (int b = 0; b < 4; ++b) { const float cv = cact[b * 1024 + k]; acc[b][0] += cv * w.x; acc[b][1] += cv * w.y; } }
#pragma unroll
        for (int b = 0; b < 4; ++b) { red[(wave * 4 + b) * 128 + 2 * lane] = acc[b][0]; red[(wave * 4 + b) * 128 + 2 * lane + 1] = acc[b][1]; }
        __syncthreads();
        { const int b = tid >> 7, col = tid & 127; float s = 0.f;
#pragma unroll
            for (int w = 0; w < 8; ++w) s += red[(w * 4 + b) * 128 + col];
            mod[(size_t)(l * 4 + b) * NMOD + jb * 128 + col] = s + P.in(I_ADAB)[(size_t)l * NMOD + jb * 128 + col]; }
        __syncthreads();
    }
}

__device__ __forceinline__ void norm_phase(const float* xsrc, float* xdst, const float* gout, bf16* a, const float* g, const float* sh, const float* sc, int mode, int gw, int NGW, int lane) {
    for (int row = gw; row < M; row += NGW) {
        const int b = row >> 13;
        const f32x4* xr = (const f32x4*)(xsrc + (size_t)row * D) + lane;
        f32x4 v[4];
#pragma unroll
        for (int j = 0; j < 4; ++j) v[j] = xr[64 * j];
        if (mode >= 1) {
            float ss = 0.f;
#pragma unroll
            for (int j = 0; j < 4; ++j) ss += (v[j].x * v[j].x + v[j].y * v[j].y) + (v[j].z * v[j].z + v[j].w * v[j].w);
            const float rs = 1.0f / sqrtf(wave_sum(ss) * (1.0f / D) + 1e-6f);
            f32x4* xo = (f32x4*)(xdst + (size_t)row * D) + lane;
#pragma unroll
            for (int j = 0; j < 4; ++j) { const f32x4 gg = *((const f32x4*)gout + lane + 64 * j); v[j] = v[j] * rs * gg; xo[64 * j] = v[j]; }
        }
        if (mode != 2) {
            float ss = 0.f;
#pragma unroll
            for (int j = 0; j < 4; ++j) ss += (v[j].x * v[j].x + v[j].y * v[j].y) + (v[j].z * v[j].z + v[j].w * v[j].w);
            const float rs = 1.0f / sqrtf(wave_sum(ss) * (1.0f / D) + 1e-6f);
            v2u* ao = (v2u*)(a + (size_t)row * D) + lane;
#pragma unroll
            for (int j = 0; j < 4; ++j) { const f32x4 gg = *((const f32x4*)g + lane + 64 * j), s4 = *((const f32x4*)(sh + (size_t)b * NMOD) + lane + 64 * j), c4 = *((const f32x4*)(sc + (size_t)b * NMOD) + lane + 64 * j);
                const f32x4 y = (v[j] * rs * gg) * (c4 + 1.0f) + s4; v2u w; w.x = pk2(y.x, y.y); w.y = pk2(y.z, y.w); ao[64 * j] = w; }
        }
    }
}

__device__ __forceinline__ void prep_phase(const PL& P, int gw, int NGW, int lane) {
    unsigned char* ws = P.ws(); const float* mod = (const float*)(ws + WS_MOD);
    { const float* x = P.in(I_X); bf16* a = (bf16*)(ws + WS_A); float* ssq0 = (float*)(ws + WS_SSQ); const float* g = P.in(I_LNF1); const float* sc = mod + 1024;
      for (int row0 = gw; row0 < M; row0 += 2 * NGW) {
          f32x4 v[2][4]; float ss[2];
#pragma unroll
          for (int k = 0; k < 2; ++k) { const int row = row0 + k * NGW; const f32x4* xr = (const f32x4*)(x + (size_t)row * D) + lane;
#pragma unroll
              for (int j = 0; j < 4; ++j) v[k][j] = xr[64 * j]; }
#pragma unroll
          for (int k = 0; k < 2; ++k) { ss[k] = 0.f;
#pragma unroll
              for (int j = 0; j < 4; ++j) ss[k] += (v[k][j].x * v[k][j].x + v[k][j].y * v[k][j].y) + (v[k][j].z * v[k][j].z + v[k][j].w * v[k][j].w); }
          ss[0] = xadd<1>(ss[0]); ss[1] = xadd<1>(ss[1]); ss[0] = xadd<2>(ss[0]); ss[1] = xadd<2>(ss[1]); ss[0] = xadd<4>(ss[0]); ss[1] = xadd<4>(ss[1]);
          ss[0] = xadd<8>(ss[0]); ss[1] = xadd<8>(ss[1]); ss[0] = xadd<16>(ss[0]); ss[1] = xadd<16>(ss[1]); ss[0] = xadd<32>(ss[0]); ss[1] = xadd<32>(ss[1]);
#pragma unroll
          for (int k = 0; k < 2; ++k) { const int row = row0 + k * NGW; const int b = row >> 13; if (lane == 0) ssq0[row] = ss[k];
              v2u* ao = (v2u*)(a + (size_t)row * D) + lane;
#pragma unroll
              for (int j = 0; j < 4; ++j) { const f32x4 gg = *((const f32x4*)g + lane + 64 * j), c4 = *((const f32x4*)(sc + (size_t)b * NMOD) + lane + 64 * j);
                  const f32x4 y = v[k][j] * gg * (c4 + 1.0f); v2u w; w.x = pk2(y.x, y.y); w.y = pk2(y.z, y.w); ao[64 * j] = w; } } } }
    float* bvec = (float*)(ws + WS_BV);
    for (int it = gw; it < 27648; it += NGW) {
        int n = it, N = 5632, boff = 0, shoff = 0; const bf16* W = (const bf16*)(ws + WS_W);
        if (n >= 22016) { n -= 22016; W = (const bf16*)(ws + WS_W + 3 * W_FFN_STRIDE); boff = 88064; shoff = 4 * NMOD + 6144; }
        else if (n >= 19968) { n -= 19968; W = (const bf16*)(ws + WS_WIN); N = 2048; boff = 79872; shoff = 4 * NMOD + 3072; }
        else if (n >= 14336) { n -= 14336; W = (const bf16*)(ws + WS_W + 2 * W_FFN_STRIDE); boff = 57344; shoff = 4 * NMOD; }
        else if (n >= 8704) { n -= 8704; W = (const bf16*)(ws + WS_W + 1 * W_FFN_STRIDE); boff = 34816; shoff = 6144; }
        else if (n >= 5632) { n -= 5632; W = (const bf16*)(ws + WS_WQKV); N = 3072; boff = 22528; shoff = 3072; }
        const v4u* wp = (const v4u*)(W + (size_t)n * D + lane * 16); const v4u wa = wp[0], wb = wp[1];
        const float w[16] = {bf_lo(wa.x), bf_hi(wa.x), bf_lo(wa.y), bf_hi(wa.y), bf_lo(wa.z), bf_hi(wa.z), bf_lo(wa.w), bf_hi(wa.w), bf_lo(wb.x), bf_hi(wb.x), bf_lo(wb.y), bf_hi(wb.y), bf_lo(wb.z), bf_hi(wb.z), bf_lo(wb.w), bf_hi(wb.w)};
#pragma unroll
        for (int b = 0; b < 4; ++b) { const f32x4* sp = (const f32x4*)(mod + shoff + (size_t)b * NMOD + lane * 16); float d = 0.f;
#pragma unroll
            for (int q = 0; q < 4; ++q) { const f32x4 s4 = sp[q]; d += (s4.x * w[4 * q] + s4.y * w[4 * q + 1]) + (s4.z * w[4 * q + 2] + s4.w * w[4 * q + 3]); }
            d = wave_sum(d); if (lane == 0) bvec[boff + b * N + n] = d; }
    }
}

__device__ __forceinline__ void sgu_phase(const PL& P, LAS unsigned char* lds, int vcu, int G, int tid, int wave, int lane) {
    constexpr int ST = 136;
    LAS bf16* Wt = (LAS bf16*)lds; LAS bf16* Vt = (LAS bf16*)(lds + 34816); LAS float* st = (LAS float*)(lds + 69632);
    const bf16* Z = (const bf16*)(P.ws() + WS_Z); bf16* Gt = (bf16*)(P.ws() + WS_G);
    const float* wsp = P.in(I_SWS); const float* bs = P.in(I_SBS); const float* lng = P.in(I_SLNG); const float* lnb = P.in(I_SLNB);
    const int fr = lane & 15, fq = lane >> 4;
    for (int unit = vcu; unit < 256; unit += G) {
        const size_t r0 = (size_t)unit * 128;
        {
            const int rsub = lane >> 4, c16 = lane & 15;
#pragma unroll
            for (int it = 0; it < 4; ++it) { const int row = 16 * wave + 4 * it + rsub; const v4u* p = (const v4u*)(Z + (r0 + row) * 2048 + 1024 + c16 * 64);
                float s1 = 0.f, s2 = 0.f;
#pragma unroll
                for (int j = 0; j < 8; ++j) { const v4u a = p[j];
                    const float x[8] = {bf_lo(a.x), bf_hi(a.x), bf_lo(a.y), bf_hi(a.y), bf_lo(a.z), bf_hi(a.z), bf_lo(a.w), bf_hi(a.w)};
#pragma unroll
                    for (int k = 0; k < 8; ++k) { s1 += x[k]; s2 += x[k] * x[k]; } }
                s1 = xadd<1>(s1); s2 = xadd<1>(s2); s1 = xadd<2>(s1); s2 = xadd<2>(s2); s1 = xadd<4>(s1); s2 = xadd<4>(s2); s1 = xadd<8>(s1); s2 = xadd<8>(s2);
                const float mean = s1 * (1.0f / 1024.0f); const float var = fmaxf(s2 * (1.0f / 1024.0f) - mean * mean, 0.f);
                if (c16 == 0) { st[row * 2] = mean; st[row * 2 + 1] = 1.0f / sqrtf(var + 1e-6f); } }
        }
        __syncthreads();
        for (int g = 0; g < 8; ++g) {
#pragma unroll
            for (int it = 0; it < 4; ++it) { const int idx = it * NTHREADS + tid, t = idx >> 4, s0 = (idx & 15) * 8; const float* wp = wsp + ((size_t)g * 128 + t) * 128 + s0;
                const f32x4 a = *(const f32x4*)wp, b = *(const f32x4*)(wp + 4); float w[8] = {a.x, a.y, a.z, a.w, b.x, b.y, b.z, b.w};
#pragma unroll
                for (int k = 0; k < 8; ++k) w[k] = (s0 + k <= t) ? w[k] : 0.f;
                v4u o; o.x = pk2(w[0], w[1]); o.y = pk2(w[2], w[3]); o.z = pk2(w[4], w[5]); o.w = pk2(w[6], w[7]);
                *(LAS v4u*)(Wt + t * ST + s0) = o; }
#pragma unroll
            for (int it = 0; it < 4; ++it) { const int idx = it * NTHREADS + tid, s = idx & 127, cc = idx >> 7;
                const v4u a = *(const v4u*)(Z + (r0 + s) * 2048 + 1024 + g * 128 + cc * 8);
                const float mean = st[s * 2], rstd = st[s * 2 + 1];
                float x[8] = {bf_lo(a.x), bf_hi(a.x), bf_lo(a.y), bf_hi(a.y), bf_lo(a.z), bf_hi(a.z), bf_lo(a.w), bf_hi(a.w)};
                const f32x4 g0 = *(const f32x4*)(lng + g * 128 + cc * 8), g1 = *(const f32x4*)(lng + g * 128 + cc * 8 + 4), b0 = *(const f32x4*)(lnb + g * 128 + cc * 8), b1 = *(const f32x4*)(lnb + g * 128 + cc * 8 + 4);
                const float gg[8] = {g0.x, g0.y, g0.z, g0.w, g1.x, g1.y, g1.z, g1.w}, bb[8] = {b0.x, b0.y, b0.z, b0.w, b1.x, b1.y, b1.z, b1.w};
#pragma unroll
                for (int k = 0; k < 8; k += 2) { const unsigned w = pk2((x[k] - mean) * rstd * gg[k] + bb[k], (x[k + 1] - mean) * rstd * gg[k + 1] + bb[k + 1]);
                    Vt[(cc * 8 + k) * ST + s] = (bf16)(w & 0xffffu); Vt[(cc * 8 + k + 1) * ST + s] = (bf16)(w >> 16); } }
            __syncthreads();
            f32x4 acc[8];
#pragma unroll
            for (int n = 0; n < 8; ++n) acc[n] = (f32x4){0.f, 0.f, 0.f, 0.f};
            const int nks = (16 * wave + 15) / 32 + 1;
            for (int ks = 0; ks < nks; ++ks) {
                const bf16x8 af = *(const LAS bf16x8*)(Wt + (16 * wave + fr) * ST + 32 * ks + 8 * fq);
#pragma unroll
                for (int n = 0; n < 8; ++n) { const bf16x8 bfv = *(const LAS bf16x8*)(Vt + (16 * n + fr) * ST + 32 * ks + 8 * fq);
                    acc[n] = __builtin_amdgcn_mfma_f32_16x16x32_bf16(bfv, af, acc[n], 0, 0, 0); }
            }
            const int t = 16 * wave + fr; const float bias = bs[g * 128 + t]; const size_t row = r0 + t;
#pragma unroll
            for (int n = 0; n < 8; ++n) { const int col = g * 128 + 16 * n + 4 * fq; const v2u uu = *(const v2u*)(Z + row * 2048 + col);
                v2u w; w.x = pk2(bf_lo(uu.x) * (acc[n][0] + bias), bf_hi(uu.x) * (acc[n][1] + bias)); w.y = pk2(bf_lo(uu.y) * (acc[n][2] + bias), bf_hi(uu.y) * (acc[n][3] + bias));
                *(v2u*)(Gt + row * 1024 + col) = w; }
            __syncthreads();
        }
    }
}

#define XB_TMO      128
#define XB_XCNT(j)  (256  + 64 * (j))
#define XB_XSUB(j)  (1280 + 64 * (j))
#define XB_XGEN(j)  (2304 + 64 * (j))
#define XB_TOP      3328
#define XB_TOPGEN   3392
#define XCD_BAR_WORDS 3456
#define XB_SPIN_CAP (1u << 18)

__device__ __forceinline__ unsigned xb_ld(unsigned* p)              { return __hip_atomic_load(p, __ATOMIC_RELAXED, __HIP_MEMORY_SCOPE_AGENT); }
__device__ __forceinline__ unsigned xb_add(unsigned* p, unsigned v) { return __hip_atomic_fetch_add(p, v, __ATOMIC_RELAXED, __HIP_MEMORY_SCOPE_AGENT); }
__device__ __forceinline__ unsigned xb_xcc_id() { return (unsigned)__builtin_amdgcn_s_getreg((3 << 11) | 20) & 0xFu; }
#define XB_SPIN(cond, bar) do { unsigned _sp = 0; while (cond) { __builtin_amdgcn_s_sleep(1); \
    if ((++_sp & 255u) == 0u) { if (xb_ld(&(bar)[XB_TMO])) break; if (_sp > XB_SPIN_CAP) { atomicAdd(&(bar)[XB_TMO], 1u); break; } } } } while (0)

struct XcdBarrier {
    unsigned* bar; unsigned x;
    volatile LAS unsigned* st;
};

__device__ __forceinline__ XcdBarrier xcd_barrier_post(unsigned* bar, volatile LAS unsigned* st) {
    XcdBarrier b; b.bar = bar; b.x = xb_xcc_id(); b.st = st;
    if (threadIdx.x == 0) (void)xb_add(&bar[XB_XCNT(b.x)], 1u);
    return b;
}
__device__ __forceinline__ void xcd_barrier_complete(unsigned* bar, unsigned x, unsigned& nloc, unsigned& nx) {
    const unsigned G = gridDim.x * gridDim.y * gridDim.z;
    unsigned sum, cnt, mine, sp = 0u;
    for (;;) {
        sum = 0u; cnt = 0u; mine = 0u;
#pragma unroll
        for (unsigned j = 0; j < 16; ++j) { const unsigned c = xb_ld(&bar[XB_XCNT(j)]); sum += c; cnt += (c > 0u) ? 1u : 0u; mine = (j == x) ? c : mine; }
        if (sum == G) break;
        __builtin_amdgcn_s_sleep(1);
        if ((++sp & 255u) == 0u) { if (xb_ld(&bar[XB_TMO])) break; if (sp > XB_SPIN_CAP) { atomicAdd(&bar[XB_TMO], 1u); break; } }
    }
    nloc = mine > 0u ? mine : 1u; nx = cnt > 0u ? cnt : 1u;
}

__device__ __forceinline__ void xcd_barrier(const XcdBarrier& b) {
    asm volatile("s_waitcnt vmcnt(0)" ::: "memory");
    __syncthreads();
    if (threadIdx.x == 0) {
        unsigned* bar = b.bar;
        __builtin_amdgcn_s_waitcnt(0);
        unsigned nloc = b.st[0], nx = b.st[1];
        if (nloc == 0u) { xcd_barrier_complete(bar, b.x, nloc, nx); b.st[0] = nloc; b.st[1] = nx; }
        const unsigned old = xb_add(&bar[XB_XSUB(b.x)], 1u);
        const unsigned gen = old / nloc;
        if (old + 1u == (gen + 1u) * nloc) {
            __builtin_amdgcn_fence(__ATOMIC_RELEASE, "agent");
            asm volatile("s_waitcnt vmcnt(0)" ::: "memory");
            const unsigned og = xb_add(&bar[XB_TOP], 1u);
            const unsigned tg = og / nx;
            if (og + 1u == (tg + 1u) * nx) xb_add(&bar[XB_TOPGEN], 1u);
            else XB_SPIN(xb_ld(&bar[XB_TOPGEN]) == tg, bar);
            __builtin_amdgcn_fence(__ATOMIC_ACQUIRE, "agent");
            xb_add(&bar[XB_XGEN(b.x)], 1u);
            asm volatile("s_waitcnt vmcnt(0)" ::: "memory");
        } else {
            XB_SPIN(xb_ld(&bar[XB_XGEN(b.x)]) == gen, bar);
            __builtin_amdgcn_fence(__ATOMIC_ACQUIRE, "agent");
            asm volatile("s_waitcnt vmcnt(0)" ::: "memory");
        }
    }
    __syncthreads();
}

template <class Epi> __device__ __forceinline__ void run_gemm(LAS unsigned char* lds, const bf16* A, const bf16* Bt, int N, int K, int G, const Epi& E) {
    pg8::Gemm g{A, Bt, M, N, K}; pg8::StaticOrder S; S.init(M, N, G, (int)blockIdx.x);
    pg8::gemm_phase<Epi, pg8::StaticOrder, true, true>(lds, g, S, E);
}

__global__ void __launch_bounds__(NTHREADS, 2) mega_fwd(Params KP) {
    extern __shared__ __attribute__((aligned(16))) unsigned char lds_raw[];
    LAS unsigned char* lds = (LAS unsigned char*)lds_raw;
    cg::grid_group grid = cg::this_grid();
    { LAS unsigned* pd = (LAS unsigned*)(lds + 133376);
      if (threadIdx.x == 0) { ((LAS unsigned*)(lds + 133888))[0] = 0u; ((LAS unsigned*)(lds + 133888))[1] = 0u;
#pragma unroll
          for (int i = 0; i < 30; ++i) { const unsigned long long a = (unsigned long long)(uintptr_t)KP.in[i]; pd[2 * i] = (unsigned)a; pd[2 * i + 1] = (unsigned)(a >> 32); }
          { const unsigned long long a = (unsigned long long)(uintptr_t)KP.out; pd[60] = (unsigned)a; pd[61] = (unsigned)(a >> 32); }
          { const unsigned long long a = (unsigned long long)(uintptr_t)KP.ws; pd[62] = (unsigned)a; pd[63] = (unsigned)(a >> 32); } }
      __syncthreads(); }
    const PL P{(const LAS unsigned*)(lds + 133376)};
    (void)xcd_barrier_post((unsigned*)(KP.ws + WS_BAR), (volatile LAS unsigned*)(lds + 133888));
    const int ph_lo = KP.ph_lo, ph_hi = KP.ph_hi;
    const int G0 = gridDim.x, bx = blockIdx.x;
    const int vcu0 = (G0 % 8 == 0) ? (bx % 8) * (G0 / 8) + bx / 8 : bx;
#ifndef REPEAT_PH
#define REPEAT_PH -1
#endif
    for (int pp = ph_lo; pp < ph_hi + (REPEAT_PH >= 0 ? 1 : 0); ++pp) {
        const int ph = (REPEAT_PH >= 0 && pp > REPEAT_PH) ? pp - 1 : pp;
        int vcu = vcu0, G = G0; asm volatile("" : "+s"(vcu), "+s"(G));
        const int NGW = G * NWAVES;
        const int tid = opaque_tid(), lane = tid & 63, wave = __builtin_amdgcn_readfirstlane(tid >> 6); const int gw = vcu * NWAVES + wave;
        unsigned char* ws = P.ws(); asm volatile("" : "+s"(ws));
        float* mod = (float*)(ws + WS_MOD); float* ssq = (float*)(ws + WS_SSQ); const float* bvec = (const float*)(ws + WS_BV);
        bf16* Abuf = (bf16*)(ws + WS_A); bf16* Hbuf = (bf16*)(ws + WS_H);
        float* out = P.out();
        int type = 0, l = 0, f = 0, sA = 0, sB = -1, bvo = 0, modoff = 0;
        const float* xsrc = out; const bf16* rA = Hbuf; const bf16* rB = nullptr; int rK = F; float rgs = 0.5f;
        int so = -1, sob = -1, wsc_off = 0, lazy = -1; const float* wg = nullptr; const float* wg2 = nullptr;
        switch (ph) {
            case 0: type = 0; break;
            case 1: type = 1; break;
            case 2: type = 2; l = 0; f = 0; sA = 0; bvo = 0; break;
            case 3: type = 3; l = 0; rB = (const bf16*)(ws + WS_W + 0 * W_FFN_STRIDE + W_GU_BYTES); modoff = 2048; xsrc = P.in(I_X); so = 1; wg = P.in(I_LNMIX); wsc_off = 4096; break;
            case 4: type = 4; sA = 1; bvo = 22528; break;
            case 5: type = 5; break;
            case 6: type = 3; l = 0; rA = (const bf16*)(ws + WS_O); rB = (const bf16*)(ws + WS_WO); rK = D; rgs = 1.0f; modoff = 5120; so = 2; wg = P.in(I_LNF2); wsc_off = 7168; break;
            case 7: type = 2; l = 0; f = 1; sA = 2; bvo = 34816; break;
            case 8: type = 3; l = 0; rB = (const bf16*)(ws + WS_W + 1 * W_FFN_STRIDE + W_GU_BYTES); modoff = 8192; so = 3; sob = 4; wg = P.in(I_LNF1) + D; wsc_off = 4 * NMOD + 1024; wg2 = P.in(I_LNOUT); break;
            case 9: type = 2; l = 1; f = 0; sA = 3; sB = 4; bvo = 57344; break;
            case 10: type = 3; l = 1; rB = (const bf16*)(ws + WS_W + 2 * W_FFN_STRIDE + W_GU_BYTES); modoff = 2048; lazy = 3; so = 5; wg = P.in(I_LNMIX) + D; wsc_off = 4 * NMOD + 4096; break;
            case 11: type = 6; sA = 5; bvo = 79872; break;
            case 12: type = 7; break;
            case 13: type = 3; l = 1; rA = (const bf16*)(ws + WS_G); rB = (const bf16*)(ws + WS_WOUT); rK = D; rgs = 1.0f; modoff = 5120; so = 6; wg = P.in(I_LNF2) + D; wsc_off = 4 * NMOD + 7168; break;
            case 14: type = 2; l = 1; f = 1; sA = 6; bvo = 88064; break;
            case 15: type = 3; l = 1; rB = (const bf16*)(ws + WS_W + 3 * W_FFN_STRIDE + W_GU_BYTES); modoff = 8192; break;
            default: type = 8; break;
        }
        const float* modl = mod + (size_t)l * 4 * NMOD;
        if ((PHMASK & 1) && type == 0) {
            for (int i = gw * 64 + lane; i < 7 * M; i += NGW * 64) ssq[i] = 0.f;
            convert_weights(P, lds, gw, NGW, wave, lane);
            ada_phase(P, lds, vcu, G, tid, wave, lane);
        } else if ((PHMASK & 2) && type == 1) {
            prep_phase(P, gw, NGW, lane);
        } else if ((PHMASK & 2) && type == 8) {
            norm_phase(out, out, P.in(I_LNOUT) + D, Abuf, nullptr, nullptr, nullptr, 2, gw, NGW, lane);
        } else if ((PHMASK & 32) && type == 5) {
            const float p1 = wave_sum(P.in(I_LQ1)[lane] * P.in(I_LK1)[lane]), p2 = wave_sum(P.in(I_LQ2)[lane] * P.in(I_LK2)[lane]);
            const float lam = expf(p1) - expf(p2) + 0.2f;
            const float kmaxn = wave_max(fabsf(P.in(I_KN)[lane])) * 8.0f * 1.02f;
            for (int v = vcu; v < 256; v += G) {
                const int bh = v >> 3, j = v & 7;
                const float* relb = P.in(I_RELB); const float bmax = att::attn_head_setup(lds, relb, bh & 7); const float lut31 = relb[31 * 8 + (bh & 7)] * att::LOG2E;
                for (int i = 0; i < 8; ++i) { const int s = j + 8 * (i >> 1); const int qb = (i & 1) ? 63 - s : s;
                    att::attn_unit(bh >> 3, bh & 7, qb, (const bf16*)(ws + WS_Q), (const bf16*)(ws + WS_K), (const bf16*)(ws + WS_V), (bf16*)(ws + WS_O), lds, bmax, lut31, lam, kmaxn, P.in(I_SUBLN), 0.8f); }
            }
        } else if ((PHMASK & 4) && (type == 2 || type == 3 || type == 4 || type == 6)) {
            pg8::EpiMulti E{}; const bf16* gA = Abuf; const bf16* gB = nullptr; int gN = D, gK = D;
            E.ssqA = ssq + (size_t)sA * M; E.ssqB = sB >= 0 ? ssq + (size_t)sB * M : nullptr; E.bvec = bvec + bvo;
            if (type == 2) { E.kind = 0; E.p0 = Hbuf; E.i0 = F; gB = (const bf16*)(ws + WS_W + (size_t)(l * 2 + f) * W_FFN_STRIDE); gN = 2 * F; }
            else if (type == 3) { E.kind = lazy >= 0 ? 5 : (wg2 ? 4 : 1); E.g0 = xsrc; E.p0 = out; E.g1 = modl + modoff; E.f0 = rgs; gA = rA; gB = rB; gK = rK;
                E.lazy_ssq = lazy >= 0 ? ssq + (size_t)lazy * M : nullptr; E.lazy_g = P.in(I_LNOUT);
                E.aout = so >= 0 ? (void*)Abuf : nullptr; E.wg = wg; E.wsc = mod + wsc_off; E.wg2 = wg2; E.ssq_out = ssq + (size_t)(so >= 0 ? so : 0) * M; E.ssqB_out = ssq + (size_t)(sob >= 0 ? sob : 0) * M; }
            else if (type == 4) { E.kind = 2; E.p0 = ws + WS_Q; E.p1 = ws + WS_K; E.p2 = ws + WS_V; E.g0 = P.in(I_QN); E.g1 = P.in(I_KN); E.f0 = att::C2; gB = (const bf16*)(ws + WS_WQKV); gN = 3 * D; }
            else { E.kind = 3; E.p0 = ws + WS_Z; E.i0 = 2048; gB = (const bf16*)(ws + WS_WIN); gN = 2048; }
            { LAS unsigned* dd = (LAS unsigned*)(lds + 133120);
              if (tid == 0) {
#define DW(i, v) dd[i] = (unsigned)(v)
#define DP(i, ptr) do { const unsigned long long a_ = (unsigned long long)(uintptr_t)(ptr); dd[i] = (unsigned)a_; dd[(i) + 1] = (unsigned)(a_ >> 32); } while (0)
                  DW(0, E.kind); DW(1, E.i0); DW(2, __float_as_uint(E.f0)); DP(4, E.p0); DP(6, E.p1); DP(8, E.p2); DP(10, E.g0); DP(12, E.g1); DP(14, E.ssqA); DP(16, E.ssqB); DP(18, E.bvec);
                  DP(20, E.lazy_ssq); DP(22, E.lazy_g); DP(24, E.aout); DP(26, E.wg); DP(28, E.wsc); DP(30, E.wg2); DP(32, E.ssq_out); DP(34, E.ssqB_out);
#undef DW
#undef DP
              }
              __syncthreads();
              pg8::EpiLds EL{(const LAS unsigned*)dd};
              run_gemm(lds, gA, gB, gN, gK, G, EL); }
        } else if ((PHMASK & 128) && type == 7) {
            sgu_phase(P, lds, vcu, G, tid, wave, lane);
        }
        if (pp + 1 < ph_hi + (REPEAT_PH >= 0 ? 1 : 0)) { if (ph_lo < 0) grid.sync(); else { XcdBarrier xb_; xb_.bar = (unsigned*)(ws + WS_BAR); xb_.x = xb_xcc_id(); xb_.st = (volatile LAS unsigned*)(lds + 133888); xcd_barrier(xb_); } }
    }
}

#ifndef N_LAUNCH_MODE
#define N_LAUNCH_MODE 0
#endif
extern "C" void kernel_launch(void* const* d_in, const int* in_sizes, int n_in, void* d_out, int out_size, void* d_ws, size_t ws_size, hipStream_t stream) {
    static int grid = 0;
    if (grid == 0) {
        if (n_in != 30 || out_size != M * D || ws_size < WS_END) { fprintf(stderr, "kernel_launch: unexpected problem (n_in %d out %d ws %zu)\n", n_in, out_size, ws_size); grid = -1; return; }
        int dev = 0, cus = 0, per_cu = 0;
        hipGetDevice(&dev); hipDeviceGetAttribute(&cus, hipDeviceAttributeMultiprocessorCount, dev);
        if (hipFuncSetAttribute((const void*)mega_fwd, hipFuncAttributeMaxDynamicSharedMemorySize, LDS_BYTES) != hipSuccess) { fprintf(stderr, "kernel_launch: hipFuncSetAttribute failed\n"); grid = -1; return; }
        if (hipOccupancyMaxActiveBlocksPerMultiprocessor(&per_cu, (const void*)mega_fwd, NTHREADS, LDS_BYTES) != hipSuccess || per_cu < 1) { fprintf(stderr, "kernel_launch: occupancy query gives %d\n", per_cu); per_cu = 1; }
        (void)hipGetLastError();
        grid = cus * 1;
        if (grid <= 0) grid = 256;
    }
    if (grid < 0) return;
    if (hipMemsetAsync((char*)d_ws + WS_BAR, 0, 16384, stream) != hipSuccess) { fprintf(stderr, "kernel_launch: memset of the barrier words failed\n"); return; }
    Params p{};
    for (int i = 0; i < 30; ++i) p.in[i] = (const float*)d_in[i];
    p.out = (float*)d_out; p.ws = (unsigned char*)d_ws;
#if N_LAUNCH_MODE == 1
    for (int ph = 0; ph < NPHASE; ++ph) { p.ph_lo = ph; p.ph_hi = ph + 1; hipLaunchKernelGGL(mega_fwd, dim3(grid), dim3(NTHREADS), LDS_BYTES, stream, p); }
#else
    p.ph_lo = 0; p.ph_hi = NPHASE;
    void* args[] = {&p};
    hipError_t e = hipLaunchCooperativeKernel((const void*)mega_fwd, dim3(grid), dim3(NTHREADS), args, LDS_BYTES, stream);
    if (e != hipSuccess) fprintf(stderr, "cooperative launch failed: %s (grid %d)\n", hipGetErrorString(e), grid);
#endif
}
```

```cpp
#include <hip/hip_runtime.h>
#include <hip/hip_cooperative_groups.h>
#include <cstdio>
#include <cstdint>
#include <cmath>
namespace cg = cooperative_groups;
template <int MASK> __device__ __forceinline__ float xadd(float v) {
    if constexpr (MASK == 32) { auto rr = __builtin_amdgcn_permlane32_swap(__float_as_uint(v), __float_as_uint(v), false, false); return __uint_as_float(rr[0]) + __uint_as_float(rr[1]); }
    else return v + __uint_as_float((unsigned)__builtin_amdgcn_ds_swizzle((int)__float_as_uint(v), (MASK << 10) | 0x1f));
}
template <int MASK> __device__ __forceinline__ float xmax(float v) {
    if constexpr (MASK == 32) { auto rr = __builtin_amdgcn_permlane32_swap(__float_as_uint(v), __float_as_uint(v), false, false); return fmaxf(__uint_as_float(rr[0]), __uint_as_float(rr[1])); }
    else return fmaxf(v, __uint_as_float((unsigned)__builtin_amdgcn_ds_swizzle((int)__float_as_uint(v), (MASK << 10) | 0x1f)));
}
__device__ __forceinline__ float wave_sum(float v) { v = xadd<1>(v); v = xadd<2>(v); v = xadd<4>(v); v = xadd<8>(v); v = xadd<16>(v); return xadd<32>(v); }
__device__ __forceinline__ float wave_max(float v) { v = xmax<1>(v); v = xmax<2>(v); v = xmax<4>(v); v = xmax<8>(v); v = xmax<16>(v); return xmax<32>(v); }
__device__ __forceinline__ int opaque_tid() { int t = threadIdx.x; asm volatile("" : "+v"(t)); return t; }
namespace pg8 {
#define PG8_LAS __attribute__((address_space(3)))
typedef unsigned short bf16_t;
typedef short bf16x8 __attribute__((ext_vector_type(8)));
typedef float f32x4 __attribute__((ext_vector_type(4)));
typedef unsigned u32x4 __attribute__((ext_vector_type(4)));
constexpr int BM = 256, BK = 64, HALF = 128, HTB = HALF * BK * 2  , STAGE_BYTES = 8 * HTB, NXCD = 8, WGM = 8;

__host__ __device__ __forceinline__ int lds_byte(int r, int c) { const int st = (r >> 4) * 2 + (c >> 5), rr = r & 15, cc = c & 31, ob = rr * 64 + cc * 2; return st * 1024 + (ob ^ (((ob >> 9) & 1) << 5)); }
__host__ __device__ __forceinline__ void stage_rc(int b, int& R, int& C) { const int st = b / 1024, sb = b % 1024, swz = sb ^ (((sb >> 9) & 1) << 5); R = (st >> 1) * 16 + swz / 64; C = (st & 1) * 32 + (swz % 64) / 2; }
__host__ __device__ __forceinline__ int perm32(int rho) { const int n = rho >> 4, i = rho & 15; return 8 * (i >> 2) + 4 * n + (i & 3); }

struct Unit { int pm, pn; };
struct Gemm { const bf16_t* A; const bf16_t* Bt; int M, N, K; };

struct StaticOrder {
    int nM, nN, nwg, G, c;
    __host__ __device__ void init(int M, int N, int G_, int c_) { nM = M / BM; nN = N / BM; nwg = nM * nN; G = G_; c = c_; }
    __host__ __device__ bool next(int i, Unit& u) const {
        const long L = (long)i * G + c; if (L >= nwg) return false;
        int wgid = (int)L; { const int q = nwg / NXCD, r = nwg % NXCD, xcd = wgid % NXCD, off = wgid / NXCD; wgid = (xcd < r ? xcd * (q + 1) : r * (q + 1) + (xcd - r) * q) + off; }
        const int nig = WGM * nN, gid = wgid / nig, fm = gid * WGM, gsz = (nM - fm) < WGM ? (nM - fm) : WGM;
        u.pm = fm + ((wgid % nig) % gsz); u.pn = (wgid % nig) / gsz; return true;
    }
    __device__ __forceinline__ void a_ready(const Unit&) const {}
    __device__ __forceinline__ void done(const Unit&) const {}
};

__device__ __forceinline__ unsigned cvt_pk_bf16(float lo, float hi) { unsigned r; asm volatile("v_cvt_pk_bf16_f32 %0, %1, %2" : "=v"(r) : "v"(lo), "v"(hi)); return r; }
typedef float f32x2 __attribute__((ext_vector_type(2)));
__device__ __forceinline__ f32x2 gelu_pk(f32x2 v) {
    const f32x2 av = __builtin_elementwise_abs(v), d = av * 0.2316418882f + 1.0f;
    f32x2 t; t.x = __builtin_amdgcn_rcpf(d.x); t.y = __builtin_amdgcn_rcpf(d.y);
    f32x2 q = t * 0.5307027145f + (-0.7265760135f); q = q * t + 0.7107068705f; q = q * t + (-0.142248368f); q = q * t + 0.127414796f; q = q * t;
    const f32x2 s = (v * v) * (-0.72134752044f);
    f32x2 e; e.x = __builtin_amdgcn_exp2f(s.x); e.y = __builtin_amdgcn_exp2f(s.y);
    const f32x2 m = v * (q * e), r = v - m;
    f32x2 o; o.x = v.x < 0.f ? m.x : r.x; o.y = v.y < 0.f ? m.y : r.y; return o;
}
typedef unsigned u32x2 __attribute__((ext_vector_type(2)));
__device__ __forceinline__ float silu_f(float g) { return g * __builtin_amdgcn_rcpf(1.0f + __builtin_amdgcn_exp2f(-1.4426950408889634f * g)); }
__device__ __forceinline__ float row_scale(const float* ssqA, const float* ssqB, int row) {
    float r = __builtin_amdgcn_rsqf(ssqA[row] * (1.0f / 1024.0f) + 1e-6f);
    if (ssqB) r *= __builtin_amdgcn_rsqf(r * r * ssqB[row] * (1.0f / 1024.0f) + 1e-6f);
    return r;
}

struct EpiSwiglu {
    static constexpr bool PERM = true, AFTER_DRAIN = false;
    static __device__ __forceinline__ void run(const f32x4 (&acc)[2][2][4][2], const Unit& u, int wr, int wc, int fr, int fq, bf16_t* H, int ldh, const float* ssqA, const float* ssqB, const float* bvec) {
        const int b = (u.pm * BM) >> 13; const int row0 = u.pm * BM + wr * 64 + fr; const int col0 = u.pn * 128 + wc * 32 + 8 * fq;
        const float* bp = bvec + ((unsigned)b * (unsigned)(2 * ldh) + (unsigned)(u.pn * BM + wc * 32 + 8 * fq));
        const f32x4 bg0 = *(const f32x4*)bp * 1.4426950408889634f, bg1 = *(const f32x4*)(bp + 4) * 1.4426950408889634f, bu0 = *(const f32x4*)(bp + HALF) * 0.6931471805599453f, bu1 = *(const f32x4*)(bp + HALF + 4) * 0.6931471805599453f;
#define SWG_(gv, uv) ((gv) * (uv) * __builtin_amdgcn_rcpf(1.0f + __builtin_amdgcn_exp2f(-(gv))))
#pragma unroll
        for (int ai = 0; ai < 2; ++ai)
#pragma unroll
            for (int m = 0; m < 4; ++m) {
                const int row = row0 + ai * HALF + m * 16; const float r = row_scale(ssqA, ssqB, row); const float rg = r * 1.4426950408889634f, ru = r * 0.6931471805599453f;
                bf16_t* p = H + ((unsigned)row * (unsigned)ldh + (unsigned)col0);
                const f32x4 g0 = acc[ai][0][m][0] * rg + bg0, g1 = acc[ai][0][m][1] * rg + bg1, u0 = acc[ai][1][m][0] * ru + bu0, u1 = acc[ai][1][m][1] * ru + bu1;
                u32x4 w;
                w.x = cvt_pk_bf16(SWG_(g0[0], u0[0]), SWG_(g0[1], u0[1]));
                w.y = cvt_pk_bf16(SWG_(g0[2], u0[2]), SWG_(g0[3], u0[3]));
                w.z = cvt_pk_bf16(SWG_(g1[0], u1[0]), SWG_(g1[1], u1[1]));
                w.w = cvt_pk_bf16(SWG_(g1[2], u1[2]), SWG_(g1[3], u1[3]));
                __builtin_nontemporal_store(w, (u32x4*)p);
                asm volatile("" ::: "memory");
            }
    }
};

struct EpiGelu {
    static constexpr bool PERM = true, AFTER_DRAIN = false;
    static __device__ __forceinline__ void run(const f32x4 (&acc)[2][2][4][2], const Unit& u, int wr, int wc, int fr, int fq, bf16_t* O, int ldc, const float* ssqA, const float* bvec) {
        const int b = (u.pm * BM) >> 13; const int row0 = u.pm * BM + wr * 64 + fr; const int col0 = u.pn * BM + wc * 32 + 8 * fq;
        const float* bp = bvec + ((unsigned)b * (unsigned)ldc + (unsigned)col0);
        f32x4 bv[2][2];
#pragma unroll
        for (int bj = 0; bj < 2; ++bj)
#pragma unroll
            for (int n = 0; n < 2; ++n) bv[bj][n] = *(const f32x4*)(bp + bj * HALF + 4 * n);
#pragma unroll
        for (int ai = 0; ai < 2; ++ai)
#pragma unroll
            for (int m = 0; m < 4; ++m) { const int row = row0 + ai * HALF + m * 16; const float r = row_scale(ssqA, nullptr, row); bf16_t* rowp = O + ((unsigned)row * (unsigned)ldc + (unsigned)col0);
#pragma unroll
                for (int bj = 0; bj < 2; ++bj) { const f32x4 v0 = acc[ai][bj][m][0] * r + bv[bj][0], v1 = acc[ai][bj][m][1] * r + bv[bj][1];
                    const f32x2 a = gelu_pk((f32x2){v0[0], v0[1]}), b2 = gelu_pk((f32x2){v0[2], v0[3]}), c = gelu_pk((f32x2){v1[0], v1[1]}), d = gelu_pk((f32x2){v1[2], v1[3]});
                    u32x4 w; w.x = cvt_pk_bf16(a.x, a.y); w.y = cvt_pk_bf16(b2.x, b2.y); w.z = cvt_pk_bf16(c.x, c.y); w.w = cvt_pk_bf16(d.x, d.y);
                    *(u32x4*)(rowp + bj * HALF) = w; }
                asm volatile("" ::: "memory"); }
    }
};

struct EpiQKV {
    static constexpr bool PERM = true, AFTER_DRAIN = false;
    static __device__ __forceinline__ void run(const f32x4 (&acc)[2][2][4][2], const Unit& u, int wr, int wc, int fr, int fq, bf16_t* Q, bf16_t* K, bf16_t* V, const float* qg, const float* kg, float qscale, const float* ssqA, const float* bvec) {
        const int b = (u.pm * BM) >> 13; const int sect = u.pn >> 2; const int row0 = u.pm * BM + wr * 64 + fr; const int colb = (u.pn & 3) * 256 + 64 * wc + 8 * fq;
        bf16_t* base = sect == 0 ? Q : (sect == 1 ? K : V);
        const float* gp = (sect == 0 ? qg : kg) + 8 * fq; const float sc = sect == 0 ? qscale : 1.0f;
        const float* bp = bvec + ((unsigned)b * 3072u + (unsigned)(u.pn * BM + wc * 32 + 8 * fq));
#pragma unroll
        for (int ai = 0; ai < 2; ++ai)
#pragma unroll
            for (int m = 0; m < 4; ++m) {
                const int row = row0 + ai * HALF + m * 16; const float r = row_scale(ssqA, nullptr, row);
                f32x4 v[2][2]; float ss = 0.f;
#pragma unroll
                for (int bj = 0; bj < 2; ++bj)
#pragma unroll
                    for (int n = 0; n < 2; ++n) { const f32x4 x = acc[ai][bj][m][n] * r + *(const f32x4*)(bp + bj * HALF + 4 * n); v[bj][n] = x; ss += (x[0] * x[0] + x[1] * x[1]) + (x[2] * x[2] + x[3] * x[3]); }
                ss = xadd<16>(ss); ss = xadd<32>(ss);
                const float rs = sect < 2 ? __builtin_amdgcn_rsqf(ss * (1.0f / 64.0f) + 1e-6f) * sc : 1.0f;
                bf16_t* rowp = base + ((unsigned)row * 1024u + (unsigned)colb);
#pragma unroll
                for (int bj = 0; bj < 2; ++bj) {
                    f32x4 v0 = v[bj][0] * rs, v1 = v[bj][1] * rs;
                    if (sect < 2) { v0 = v0 * *(const f32x4*)(gp + 32 * bj); v1 = v1 * *(const f32x4*)(gp + 32 * bj + 4); }
                    u32x4 w; w.x = cvt_pk_bf16(v0[0], v0[1]); w.y = cvt_pk_bf16(v0[2], v0[3]); w.z = cvt_pk_bf16(v1[0], v1[1]); w.w = cvt_pk_bf16(v1[2], v1[3]);
                    *(u32x4*)(rowp + 32 * bj) = w; }
                asm volatile("" ::: "memory");
            }
    }
};

template <bool LAZY, bool WG2> struct EpiResidT {
    static constexpr bool PERM = true, AFTER_DRAIN = false;
    static __device__ __forceinline__ void run(const f32x4 (&acc)[2][2][4][2], const Unit& u, int wr, int wc, int fr, int fq, const float* xin, float* xout, const float* gate, float gs, const float* lazy_ssq, const float* lazy_g,
                                                bf16_t* aout, const float* wg, const float* wsc, const float* wg2, float* ssq_out, float* ssqB_out) {
        const unsigned b = (unsigned)(u.pm * BM) >> 13; const unsigned row0 = u.pm * BM + wr * 64 + fr; const unsigned col0 = u.pn * BM + wc * 32 + 8 * fq;
        float rl[2][4], sq[2][4], sqb[2][4];
#pragma unroll
        for (int ai = 0; ai < 2; ++ai)
#pragma unroll
            for (int m = 0; m < 4; ++m) { rl[ai][m] = LAZY ? __builtin_amdgcn_rsqf(lazy_ssq[row0 + ai * HALF + m * 16] * (1.0f / 1024.0f) + 1e-6f) : 1.0f; sq[ai][m] = 0.f; sqb[ai][m] = 0.f; }
#pragma unroll
        for (int bj = 0; bj < 2; ++bj) {
            const unsigned col = col0 + bj * HALF;
            f32x4 gv[2], lg[2], wv[2], w2[2];
#pragma unroll
            for (int n = 0; n < 2; ++n) {
                gv[n] = *(const f32x4*)(gate + (b * 9216u + col + 4 * n)) * gs;
                lg[n] = (f32x4){1.f, 1.f, 1.f, 1.f}; if (LAZY) lg[n] = *(const f32x4*)(lazy_g + col + 4 * n);
                wv[n] = (f32x4){0.f, 0.f, 0.f, 0.f}; w2[n] = (f32x4){1.f, 1.f, 1.f, 1.f};
                if (aout) { wv[n] = *(const f32x4*)(wg + col + 4 * n) * (*(const f32x4*)(wsc + (b * 9216u + col + 4 * n)) + 1.0f); if (WG2) { w2[n] = *(const f32x4*)(wg2 + col + 4 * n); wv[n] = wv[n] * w2[n]; } }
            }
#pragma unroll
            for (int ai = 0; ai < 2; ++ai)
#pragma unroll
                for (int m = 0; m < 4; ++m) { const unsigned off = (row0 + ai * HALF + m * 16) * 1024u + col;
                    const f32x4 xi0 = *(const f32x4*)(xin + off), xi1 = *(const f32x4*)(xin + off + 4);
                    f32x4 xo0 = gv[0] * acc[ai][bj][m][0], xo1 = gv[1] * acc[ai][bj][m][1];
                    if (LAZY) { xo0 = xo0 + xi0 * lg[0] * rl[ai][m]; xo1 = xo1 + xi1 * lg[1] * rl[ai][m]; } else { xo0 = xo0 + xi0; xo1 = xo1 + xi1; }
                    *(f32x4*)(xout + off) = xo0; *(f32x4*)(xout + off + 4) = xo1;
                    if (aout) { const f32x4 a0 = xo0 * wv[0], a1 = xo1 * wv[1]; u32x4 w; w.x = cvt_pk_bf16(a0[0], a0[1]); w.y = cvt_pk_bf16(a0[2], a0[3]); w.z = cvt_pk_bf16(a1[0], a1[1]); w.w = cvt_pk_bf16(a1[2], a1[3]);
                        *(u32x4*)(aout + off) = w;
                        sq[ai][m] += ((xo0[0] * xo0[0] + xo0[1] * xo0[1]) + (xo0[2] * xo0[2] + xo0[3] * xo0[3])) + ((xo1[0] * xo1[0] + xo1[1] * xo1[1]) + (xo1[2] * xo1[2] + xo1[3] * xo1[3]));
                        if (WG2) { const f32x4 b0 = xo0 * w2[0], b1 = xo1 * w2[1]; sqb[ai][m] += ((b0[0] * b0[0] + b0[1] * b0[1]) + (b0[2] * b0[2] + b0[3] * b0[3])) + ((b1[0] * b1[0] + b1[1] * b1[1]) + (b1[2] * b1[2] + b1[3] * b1[3])); } }
                    if (m & 1) asm volatile("" ::: "memory"); }
        }
        if (aout) {
#pragma unroll
            for (int ai = 0; ai < 2; ++ai)
#pragma unroll
                for (int m = 0; m < 4; ++m) { float s = sq[ai][m]; s = xadd<16>(s); s = xadd<32>(s);
                    float sb = sqb[ai][m]; if (WG2) { sb = xadd<16>(sb); sb = xadd<32>(sb); }
                    if (fq == 0) { unsafeAtomicAdd(ssq_out + (row0 + ai * HALF + m * 16), s); if (WG2) unsafeAtomicAdd(ssqB_out + (row0 + ai * HALF + m * 16), sb); } }
        }
    }
};

struct EpiMulti {
    static constexpr bool PERM = true, AFTER_DRAIN = false;
    int kind; int i0; float f0;
    void* p0; void* p1; void* p2; const float* g0; const float* g1; const float* ssqA; const float* ssqB; const float* bvec;
    const float* lazy_ssq; const float* lazy_g; void* aout; const float* wg; const float* wsc; const float* wg2; float* ssq_out; float* ssqB_out;
};

#ifndef EPIMASK
#define EPIMASK 15
#endif
struct EpiLds {
    static constexpr bool PERM = true, AFTER_DRAIN = false;
    const PG8_LAS unsigned* d;
    __device__ __forceinline__ unsigned u(int i) const { return (unsigned)__builtin_amdgcn_readfirstlane((int)d[i]); }
    template <class T> __device__ __forceinline__ T* p(int i) const { const unsigned long long lo = u(i), hi = u(i + 1); return (T*)(__attribute__((address_space(1))) T*)((hi << 32) | lo); }
    __device__ __forceinline__ void operator()(const f32x4 (&acc)[2][2][4][2], const Unit& un, int wr, int wc, int fr, int fq) const {
        const int kind = (int)u(0);
        { const int t_ = opaque_tid(), w_ = __builtin_amdgcn_readfirstlane(t_ >> 6), l_ = t_ & 63; wr = w_ >> 2; wc = w_ & 3; fr = l_ & 15; fq = l_ >> 4; }
        if ((EPIMASK & 1) && kind == 0) EpiSwiglu::run(acc, un, wr, wc, fr, fq, p<bf16_t>(4), (int)u(1), p<const float>(14), p<const float>(16), p<const float>(18));
        else if ((EPIMASK & 2) && kind == 1) EpiResidT<false, false>::run(acc, un, wr, wc, fr, fq, p<const float>(10), p<float>(4), p<const float>(12), __uint_as_float(u(2)), nullptr, nullptr, p<bf16_t>(24), p<const float>(26), p<const float>(28), nullptr, p<float>(32), nullptr);
        else if ((EPIMASK & 2) && kind == 4) EpiResidT<false, true>::run(acc, un, wr, wc, fr, fq, p<const float>(10), p<float>(4), p<const float>(12), __uint_as_float(u(2)), nullptr, nullptr, p<bf16_t>(24), p<const float>(26), p<const float>(28), p<const float>(30), p<float>(32), p<float>(34));
        else if ((EPIMASK & 2) && kind == 5) EpiResidT<true, false>::run(acc, un, wr, wc, fr, fq, p<const float>(10), p<float>(4), p<const float>(12), __uint_as_float(u(2)), p<const float>(20), p<const float>(22), p<bf16_t>(24), p<const float>(26), p<const float>(28), nullptr, p<float>(32), nullptr);
        else if ((EPIMASK & 4) && kind == 2) EpiQKV::run(acc, un, wr, wc, fr, fq, p<bf16_t>(4), p<bf16_t>(6), p<bf16_t>(8), p<const float>(10), p<const float>(12), __uint_as_float(u(2)), p<const float>(14), p<const float>(18));
        else if (EPIMASK & 8) EpiGelu::run(acc, un, wr, wc, fr, fq, p<bf16_t>(4), (int)u(1), p<const float>(14), p<const float>(18));
    }
};

template <class Epi, class Sched, bool ALIGN_EPI = false, bool SP2 = false>
__device__ __forceinline__ void gemm_phase(PG8_LAS unsigned char* lds, const Gemm g, const Sched& S, const Epi& E) {
    const int tid = opaque_tid(), wid = __builtin_amdgcn_readfirstlane(tid >> 6), lane = tid & 63, wr = wid >> 2, wc = wid & 3, fr = lane & 15, fq = lane >> 4;
    const int K = g.K, nt = K / BK;
    unsigned voffA[2], voffB[2];
#pragma unroll
    for (int i = 0; i < 2; ++i) { int R, C; stage_rc(tid * 16 + i * 8192, R, C); const int Rb = Epi::PERM ? ((R & ~31) + perm32(R & 31)) : R;
        voffA[i] = (unsigned)(R * K + C) * 2u; voffB[i] = (unsigned)(Rb * K + C) * 2u; }
    const size_t kstep = (size_t)(BK * 2);
    const size_t hstep = (size_t)HALF * K * 2;
    const size_t tstep = 2 * hstep;
    const unsigned ldsw = (unsigned)wid * 1024u;
    const int aoff = lds_byte(wr * 64 + fr, fq * 8), boff = lds_byte(wc * 32 + fr, fq * 8);
#define PG8_SA(b, h) (((b) * 2 + (h)) * HTB)
#define PG8_SB(b, h) ((4 + (b) * 2 + (h)) * HTB)
#define PG8_STAGE(bufoff, gbase, voff) do { _Pragma("unroll") for (int _i = 0; _i < 2; ++_i) \
        __builtin_amdgcn_global_load_lds((const unsigned*)((const char*)(gbase) + (voff)[_i]), (PG8_LAS unsigned*)(lds + (bufoff) + ldsw + _i * 8192), 16, 0, 0); } while (0)
#define PG8_LDA(dst, b, h) do { _Pragma("unroll") for (int m = 0; m < 4; ++m) _Pragma("unroll") for (int k = 0; k < 2; ++k) dst[m][k] = *(const PG8_LAS bf16x8*)(lds + PG8_SA(b, h) + aoff + m * 2048 + k * 1024); } while (0)
#define PG8_LDB(dst, b, h) do { _Pragma("unroll") for (int n = 0; n < 2; ++n) _Pragma("unroll") for (int k = 0; k < 2; ++k) dst[n][k] = *(const PG8_LAS bf16x8*)(lds + PG8_SB(b, h) + boff + n * 2048 + k * 1024); } while (0)
#define PG8_MMA(ai, bj, At, Bt) do { __builtin_amdgcn_s_setprio(1); _Pragma("unroll") for (int m = 0; m < 4; ++m) _Pragma("unroll") for (int n = 0; n < 2; ++n) _Pragma("unroll") for (int k = 0; k < 2; ++k) \
        acc[ai][bj][m][n] = __builtin_amdgcn_mfma_f32_16x16x32_bf16(Bt[n][k], At[m][k], acc[ai][bj][m][n], 0, 0, 0); __builtin_amdgcn_s_setprio(0); } while (0)
#define PG8_WAIT_V(n) asm volatile("s_waitcnt vmcnt(" #n ")" ::: "memory")
#define PG8_WAIT_L(n) asm volatile("s_waitcnt lgkmcnt(" #n ")" ::: "memory")
#define PG8_BAR __builtin_amdgcn_s_barrier()
#define PG8_SCHED __builtin_amdgcn_sched_barrier(0)
    Unit cur, nxt; int ui = 0;
    if (!S.next(0, cur)) return;
    f32x4 acc[2][2][4][2];
#pragma unroll
    for (int a = 0; a < 2; ++a)
#pragma unroll
        for (int b = 0; b < 2; ++b)
#pragma unroll
            for (int m = 0; m < 4; ++m)
#pragma unroll
                for (int n = 0; n < 2; ++n) acc[a][b][m][n] = (f32x4){0.f, 0.f, 0.f, 0.f};
    bf16x8 At[4][2], B0[2][2], B1[2][2];
    const char* cA = (const char*)g.A + (size_t)cur.pm * tstep; const char* cB = (const char*)g.Bt + (size_t)cur.pn * tstep;
    S.a_ready(cur);
    if constexpr (SP2) {
        PG8_STAGE(PG8_SB(0, 0), cB, voffB); PG8_STAGE(PG8_SB(0, 1), cB + hstep, voffB); PG8_STAGE(PG8_SA(0, 0), cA, voffA); PG8_STAGE(PG8_SA(0, 1), cA + hstep, voffA);
        if (wr == 1) PG8_BAR;
        PG8_WAIT_V(2); PG8_BAR;
        PG8_STAGE(PG8_SB(1, 0), cB + kstep, voffB); PG8_STAGE(PG8_SA(1, 0), cA + kstep, voffA); PG8_STAGE(PG8_SB(1, 1), cB + hstep + kstep, voffB);
        PG8_WAIT_V(6); PG8_BAR;
    } else {
        PG8_STAGE(PG8_SB(0, 0), cB, voffB); PG8_STAGE(PG8_SA(0, 0), cA, voffA); PG8_STAGE(PG8_SB(0, 1), cB + hstep, voffB); PG8_STAGE(PG8_SA(0, 1), cA + hstep, voffA);
        if (wr == 1) PG8_BAR;
        PG8_WAIT_V(4); PG8_BAR;
        PG8_STAGE(PG8_SB(1, 0), cB + kstep, voffB); PG8_STAGE(PG8_SA(1, 0), cA + kstep, voffA); PG8_STAGE(PG8_SB(1, 1), cB + hstep + kstep, voffB);
        PG8_WAIT_V(6); PG8_BAR;
    }
    for (;;) {
        const bool has_next = S.next(ui + 1, nxt);
        const char* nA = has_next ? (const char*)g.A + (size_t)nxt.pm * tstep : cA; const char* nB = has_next ? (const char*)g.Bt + (size_t)nxt.pn * tstep : cB;
        for (int t = 0; t < nt; t += 2) {
            const bool last = (t == nt - 2);
            const char* a1 = cA + (size_t)(t + 1) * kstep;
            const char* a2 = last ? nA : cA + (size_t)(t + 2) * kstep; const char* b2 = last ? nB : cB + (size_t)(t + 2) * kstep;
            const char* a3 = a2 + kstep; const char* b3 = b2 + kstep;
            if (last && has_next) S.a_ready(nxt);
            if constexpr (SP2) {
            PG8_LDB(B0, 0, 0); PG8_LDB(B1, 0, 1); PG8_SCHED; PG8_LDA(At, 0, 0); PG8_STAGE(PG8_SA(1, 1), a1 + hstep, voffA);
            PG8_WAIT_V(8); PG8_WAIT_L(0); PG8_BAR; PG8_MMA(0, 0, At, B0); PG8_MMA(0, 1, At, B1); PG8_BAR; PG8_SCHED;
            PG8_LDA(At, 0, 1); PG8_STAGE(PG8_SB(0, 0), b2, voffB); PG8_STAGE(PG8_SB(0, 1), b2 + hstep, voffB); PG8_STAGE(PG8_SA(0, 0), a2, voffA);
            PG8_WAIT_V(8); PG8_WAIT_L(0); PG8_BAR; PG8_MMA(1, 0, At, B0); PG8_MMA(1, 1, At, B1); PG8_BAR; PG8_SCHED;
            PG8_LDB(B0, 1, 0); PG8_LDB(B1, 1, 1); PG8_SCHED; PG8_LDA(At, 1, 0); PG8_STAGE(PG8_SA(0, 1), a2 + hstep, voffA);
            PG8_WAIT_V(8); PG8_WAIT_L(0); PG8_BAR; PG8_MMA(0, 0, At, B0); PG8_MMA(0, 1, At, B1); PG8_BAR; PG8_SCHED;
            PG8_LDA(At, 1, 1); PG8_STAGE(PG8_SB(1, 0), b3, voffB); PG8_STAGE(PG8_SB(1, 1), b3 + hstep, voffB); PG8_STAGE(PG8_SA(1, 0), a3, voffA);
            PG8_WAIT_V(8); PG8_WAIT_L(0); PG8_BAR; PG8_MMA(1, 0, At, B0); PG8_MMA(1, 1, At, B1); PG8_BAR; PG8_SCHED;
            } else {
            PG8_LDB(B0, 0, 0); PG8_SCHED; PG8_LDA(At, 0, 0); PG8_STAGE(PG8_SA(1, 1), a1 + hstep, voffA);
            PG8_WAIT_L(8); PG8_BAR; PG8_WAIT_L(0); PG8_MMA(0, 0, At, B0); PG8_BAR; PG8_SCHED;
            PG8_LDB(B1, 0, 1); PG8_STAGE(PG8_SB(0, 0), b2, voffB);
            PG8_BAR; PG8_WAIT_L(0); PG8_MMA(0, 1, At, B1); PG8_BAR;
            PG8_LDA(At, 0, 1); PG8_STAGE(PG8_SA(0, 0), a2, voffA);
            PG8_BAR; PG8_WAIT_L(0); PG8_MMA(1, 0, At, B0); PG8_BAR; PG8_SCHED;
            PG8_STAGE(PG8_SB(0, 1), b2 + hstep, voffB);
            PG8_WAIT_V(6); PG8_BAR; PG8_MMA(1, 1, At, B1); PG8_BAR;
            PG8_LDB(B0, 1, 0); PG8_SCHED; PG8_LDA(At, 1, 0); PG8_STAGE(PG8_SA(0, 1), a2 + hstep, voffA);
            PG8_WAIT_L(8); PG8_BAR; PG8_WAIT_L(0); PG8_MMA(0, 0, At, B0); PG8_BAR; PG8_SCHED;
            PG8_LDB(B1, 1, 1); PG8_STAGE(PG8_SB(1, 0), b3, voffB);
            PG8_BAR; PG8_WAIT_L(0); PG8_MMA(0, 1, At, B1); PG8_BAR;
            PG8_LDA(At, 1, 1); PG8_STAGE(PG8_SA(1, 0), a3, voffA);
            PG8_BAR; PG8_WAIT_L(0); PG8_MMA(1, 0, At, B0); PG8_BAR; PG8_SCHED;
            PG8_STAGE(PG8_SB(1, 1), b3 + hstep, voffB);
            PG8_WAIT_V(6); PG8_BAR; PG8_MMA(1, 1, At, B1); PG8_BAR;
            }
        }
        if constexpr (ALIGN_EPI) { if (wr == 0) PG8_BAR; }
        if constexpr (!Epi::AFTER_DRAIN) { E(acc, cur, wr, wc, fr, fq); S.done(cur); }
        if (!has_next) break;
#pragma unroll
        for (int a = 0; a < 2; ++a)
#pragma unroll
            for (int b = 0; b < 2; ++b)
#pragma unroll
                for (int m = 0; m < 4; ++m)
#pragma unroll
                    for (int n = 0; n < 2; ++n) acc[a][b][m][n] = (f32x4){0.f, 0.f, 0.f, 0.f};
        cur = nxt; cA = nA; cB = nB; ++ui;
        if constexpr (ALIGN_EPI) { if (wr == 1) PG8_BAR; }
    }
    PG8_WAIT_V(0);
    if constexpr (!ALIGN_EPI) { if (wr == 0) PG8_BAR; }
    PG8_BAR;
    if constexpr (Epi::AFTER_DRAIN) { E.fused(acc, cur, wr, wc, fr, fq, lds, wid, lane); S.done(cur); }
#undef PG8_SA
#undef PG8_SB
#undef PG8_STAGE
#undef PG8_LDA
#undef PG8_LDB
#undef PG8_MMA
#undef PG8_WAIT_V
#undef PG8_WAIT_L
#undef PG8_BAR
#undef PG8_SCHED
}
}

namespace att {
#define ALDS __attribute__((address_space(3)))
typedef short bf16x8 __attribute__((ext_vector_type(8)));
typedef short s16x4 __attribute__((ext_vector_type(4)));
typedef float f32x16 __attribute__((ext_vector_type(16)));
typedef float f32x2 __attribute__((ext_vector_type(2)));
typedef unsigned u32x4 __attribute__((ext_vector_type(4)));
typedef unsigned short bf16_t;
constexpr int SEQ = 8192, DM = 1024, KVB = 64, QU = 128, NSLOT = 4, SLOT = 16384;
constexpr int L_K = 0, L_V = NSLOT * SLOT, L_LUT = 131072, L_LB = L_LUT + 512;
constexpr float LOG2E = 1.4426950408889634f, C2 = 0.125f * LOG2E;
__device__ __forceinline__ int crow(int r, int hi) { return (r & 3) + 8 * (r >> 2) + 4 * hi; }
__device__ __forceinline__ void glds16(const void* gsrc, unsigned lds_dst) { unsigned keep;
    asm volatile("s_mov_b32 %0, m0\n\ts_mov_b32 m0, %2\n\ts_nop 0\n\tglobal_load_lds_dwordx4 %1, off\n\ts_mov_b32 m0, %0" : "=&s"(keep) : "v"(gsrc), "s"(lds_dst) : "memory"); }
__device__ __forceinline__ void glds16s(unsigned voff, const void* sbase, unsigned lds_dst) { unsigned keep;
    asm volatile("s_mov_b32 %0, m0\n\ts_mov_b32 m0, %3\n\ts_nop 0\n\tglobal_load_lds_dwordx4 %1, %2\n\ts_mov_b32 m0, %0" : "=&s"(keep) : "v"(voff), "s"(sbase), "s"(lds_dst) : "memory"); }
__device__ __forceinline__ unsigned cvtpk(float lo, float hi) { typedef float f2 __attribute__((ext_vector_type(2))); typedef __bf16 b2 __attribute__((ext_vector_type(2)));
    f2 v = {lo, hi}; b2 r = __builtin_convertvector(v, b2); return __builtin_bit_cast(unsigned, r); }
__device__ __forceinline__ float bf2f(short s) { return __uint_as_float(((unsigned)(unsigned short)s) << 16); }
typedef short v4i16_t __attribute__((ext_vector_type(4)));
__device__ __forceinline__ s16x4 vtr(const ALDS unsigned char* p) { return __builtin_bit_cast(s16x4, __builtin_amdgcn_ds_read_tr16_b64_v4i16((ALDS v4i16_t*)p)); }
#define ATT_WAIT_BAR(N) asm volatile("s_waitcnt vmcnt(" #N ") lgkmcnt(0)\n\ts_barrier" ::: "memory")

__device__ __forceinline__ float attn_head_setup(ALDS unsigned char* lds, const float* relb, int h) {
    const int tid = threadIdx.x; ALDS float* lut = (ALDS float*)(lds + L_LUT);
    if (tid < 128) { const int n = tid; int bk; if (n < 16) bk = n; else { const int lg = 16 + (int)(logf((float)n / 16.0f) / logf(8.0f) * 16.0f); bk = lg < 31 ? lg : 31; }
        lut[tid] = (relb[bk * 8 + h] - relb[31 * 8 + h]) * LOG2E; }
    float bmax = -1e30f;
    for (int i = 0; i < 32; ++i) bmax = fmaxf(bmax, relb[i * 8 + h]);
    return (bmax - relb[31 * 8 + h]) * LOG2E;
}
__device__ __forceinline__ void attn_unit(int b, int h, int qb, const bf16_t* Q, const bf16_t* K, const bf16_t* V, bf16_t* O, ALDS unsigned char* lds,
                                          float bmax, float lut31, float lam, float kmaxn, const float* subg, float outscale) {
    const int tid = opaque_tid(), lane = tid & 63, r32 = lane & 31, hi = lane >> 5;
    const int wid = __builtin_amdgcn_readfirstlane(tid >> 6), comp = wid >> 2, qw = wid & 3;
    const long rowbase = (long)b * SEQ; const int q0 = qb * QU;
    const unsigned lds0 = (unsigned)(uintptr_t)lds;
    ALDS float* lut = (ALDS float*)(lds + L_LUT);
    const bf16_t* Kh = K + rowbase * DM + h * 128; const bf16_t* Vh = V + rowbase * DM + h * 128;
    const int gdma = ((lane >> 4) << 2) | (wid & 3);
    const unsigned dof0 = (unsigned)((4 * wid + (lane >> 4)) * DM + ((lane & 15) ^ gdma) * 8) * 2u, dof1 = dof0 + 32u * DM * 2u;
    const unsigned kdst = lds0 + L_K + wid * 1024, vdst = lds0 + L_V + wid * 1024;
#define ATT_DMA(t, s) do { const bf16_t* kt_ = Kh + (long)(t) * KVB * DM; const bf16_t* vt_ = Vh + (long)(t) * KVB * DM; const unsigned so_ = (unsigned)(s) * SLOT; \
        glds16s(dof0, kt_, (unsigned)__builtin_amdgcn_readfirstlane(kdst + so_)); glds16s(dof1, kt_, (unsigned)__builtin_amdgcn_readfirstlane(kdst + so_ + 8192)); \
        glds16s(dof0, vt_, (unsigned)__builtin_amdgcn_readfirstlane(vdst + so_)); glds16s(dof1, vt_, (unsigned)__builtin_amdgcn_readfirstlane(vdst + so_ + 8192)); } while (0)
    const int NT = 2 * (qb + 1);
    ATT_DMA(0, 0); ATT_DMA(1, 1); if (NT > 2) ATT_DMA(2, 2);
    const bf16_t* Qw = Q + (rowbase + q0 + qw * 32 + r32) * DM + h * 128 + comp * 64 + hi * 8;
    bf16x8 qr[4];
#pragma unroll
    for (int d0 = 0; d0 < 4; ++d0) qr[d0] = *(const bf16x8*)(Qw + d0 * 16);
    float ssq = 0.f;
#pragma unroll
    for (int d0 = 0; d0 < 4; ++d0)
#pragma unroll
        for (int i = 0; i < 8; ++i) { const float f = bf2f(qr[d0][i]); ssq += f * f; }
    ssq = xadd<32>(ssq);
    const float bound = sqrtf(ssq) * kmaxn + bmax;
    const bool needshift = __any(bound > 60.0f);
    f32x16 o[4];
#pragma unroll
    for (int d0 = 0; d0 < 4; ++d0)
#pragma unroll
        for (int r = 0; r < 16; ++r) o[d0][r] = 0.f;
    float l = 0.f;
    const int qabs = q0 + qw * 32 + r32;
    const ALDS unsigned char* kp0 = lds + L_K + 256 * r32;
    int kofs[4]; { const int gk = ((r32 & 3) << 2) | ((r32 >> 2) & 3);
#pragma unroll
        for (int d0 = 0; d0 < 4; ++d0) kofs[d0] = 16 * ((8 * comp + 2 * d0 + hi) ^ gk); }
    const ALDS unsigned char* vp0 = lds + L_V;
    int vofs[4][2]; { const int blk = (lane >> 4) & 1, q = (lane & 15) >> 2, p = lane & 3;
#pragma unroll
        for (int c = 0; c < 4; ++c)
#pragma unroll
            for (int t2 = 0; t2 < 2; ++t2) { const int gv = (q << 2) | ((hi + 2 * t2) & 3); vofs[c][t2] = 256 * (4 * hi + 8 * t2 + q) + 16 * ((4 * c + 2 * blk + (p >> 1)) ^ gv) + 8 * (p & 1); } }
    if (NT > 2) ATT_WAIT_BAR(8); else ATT_WAIT_BAR(4);
    f32x16 pA0, pA1, pB0, pB1; u32x4 w[4]; const f32x16 zero16 = {};
#define ATT_QKP(P0, P1, t) do { const ALDS unsigned char* kp_ = kp0 + ((t) & 3) * SLOT; \
        { const bf16x8 k0_ = *(const ALDS bf16x8*)(kp_ + kofs[0]), k1_ = *(const ALDS bf16x8*)(kp_ + kofs[0] + 8192); \
          P0 = __builtin_amdgcn_mfma_f32_32x32x16_bf16(k0_, qr[0], zero16, 0, 0, 0); P1 = __builtin_amdgcn_mfma_f32_32x32x16_bf16(k1_, qr[0], zero16, 0, 0, 0); } \
        _Pragma("unroll") for (int d0 = 1; d0 < 4; ++d0) { const bf16x8 k0_ = *(const ALDS bf16x8*)(kp_ + kofs[d0]), k1_ = *(const ALDS bf16x8*)(kp_ + kofs[d0] + 8192); \
            P0 = __builtin_amdgcn_mfma_f32_32x32x16_bf16(k0_, qr[d0], P0, 0, 0, 0); P1 = __builtin_amdgcn_mfma_f32_32x32x16_bf16(k1_, qr[d0], P1, 0, 0, 0); } } while (0)
#define ATT_BARX(t) do { if ((t) + 1 < NT) { \
            if ((t) + 2 < NT) ATT_WAIT_BAR(4); else ATT_WAIT_BAR(0);         \
            if ((t) + 3 < NT) ATT_DMA((t) + 3, ((t) + 3) & 3); } } while (0)
#define ATT_EXPP(P0, P1, t) do { if ((t) >= NT - 4) { const int relb0 = qabs - ((t) * KVB + 4 * hi); \
            _Pragma("unroll") for (int r = 0; r < 16; ++r) { \
                const int rel = relb0 - ((r & 3) + 8 * (r >> 2)); const int rel1 = rel - 32; \
                const float a0 = lut[rel < 0 ? 0 : (rel > 127 ? 127 : rel)], a1 = lut[rel1 < 0 ? 0 : (rel1 > 127 ? 127 : rel1)]; \
                P0[r] = rel < 0 ? -INFINITY : P0[r] + a0; P1[r] = rel1 < 0 ? -INFINITY : P1[r] + a1; } } \
        if (needshift) { _Pragma("unroll") for (int r = 0; r < 16; ++r) { P0[r] -= bound; P1[r] -= bound; } } \
        float sacc = 0.f; \
        _Pragma("unroll") for (int r = 0; r < 16; ++r) { P0[r] = __builtin_amdgcn_exp2f(P0[r]); P1[r] = __builtin_amdgcn_exp2f(P1[r]); sacc += P0[r] + P1[r]; } \
        l += sacc; \
        w[0] = (u32x4){cvtpk(P0[0], P0[1]), cvtpk(P0[2], P0[3]), cvtpk(P0[4], P0[5]), cvtpk(P0[6], P0[7])}; \
        w[1] = (u32x4){cvtpk(P0[8], P0[9]), cvtpk(P0[10], P0[11]), cvtpk(P0[12], P0[13]), cvtpk(P0[14], P0[15])}; \
        w[2] = (u32x4){cvtpk(P1[0], P1[1]), cvtpk(P1[2], P1[3]), cvtpk(P1[4], P1[5]), cvtpk(P1[6], P1[7])}; \
        w[3] = (u32x4){cvtpk(P1[8], P1[9]), cvtpk(P1[10], P1[11]), cvtpk(P1[12], P1[13]), cvtpk(P1[14], P1[15])}; } while (0)
#define ATT_PV(t) do { const ALDS unsigned char* vp_ = vp0 + ((t) & 3) * SLOT; \
        _Pragma("unroll") for (int ks = 0; ks < 4; ++ks) { const bf16x8 pa = __builtin_bit_cast(bf16x8, w[ks]); \
            _Pragma("unroll") for (int d0 = 0; d0 < 4; ++d0) { \
                const s16x4 vl = vtr(vp_ + vofs[d0][0] + ks * 4096), vh = vtr(vp_ + vofs[d0][1] + ks * 4096); \
                const bf16x8 vf = (bf16x8){vl[0], vl[1], vl[2], vl[3], vh[0], vh[1], vh[2], vh[3]}; \
                o[d0] = __builtin_amdgcn_mfma_f32_32x32x16_bf16(pa, vf, o[d0], 0, 0, 0); } } } while (0)
    ATT_QKP(pA0, pA1, 0);
    for (int t = 0; t < NT; t += 2) {
        ATT_BARX(t); ATT_QKP(pB0, pB1, t + 1); ATT_EXPP(pA0, pA1, t); ATT_PV(t);
        ATT_BARX(t + 1); if (t + 2 < NT) ATT_QKP(pA0, pA1, t + 2); ATT_EXPP(pB0, pB1, t + 1); ATT_PV(t + 1);
    }
#undef ATT_QKP
#undef ATT_BARX
#undef ATT_EXPP
#undef ATT_PV
    l = xadd<32>(l);
    ATT_WAIT_BAR(0);
    ALDS float* ob = (ALDS float*)lds + comp * (QU * 128);
    ALDS float* lb = (ALDS float*)(lds + L_LB);
    if (hi == 0) lb[comp * QU + qw * 32 + r32] = l;
#pragma unroll
    for (int d0 = 0; d0 < 4; ++d0)
#pragma unroll
        for (int r = 0; r < 16; ++r) ob[(qw * 32 + crow(r, hi)) * 128 + d0 * 32 + r32] = o[d0][r];
    ATT_WAIT_BAR(0);
    {
        typedef float f32x4_t __attribute__((ext_vector_type(4)));
        const int rsub = lane >> 4, c16 = lane & 15;
        const f32x4_t sg0 = *(const f32x4_t*)(subg + 8 * c16), sg1 = *(const f32x4_t*)(subg + 8 * c16 + 4);
#pragma unroll
        for (int it = 0; it < 4; ++it) {
            const int q = 16 * wid + 4 * it + rsub;
            const ALDS unsigned char* pa = lds + (q * 128 + 8 * c16) * 4;
            const f32x4_t a0 = *(const ALDS f32x4_t*)pa, a1 = *(const ALDS f32x4_t*)(pa + 16), b0 = *(const ALDS f32x4_t*)(pa + 65536), b1 = *(const ALDS f32x4_t*)(pa + 65536 + 16);
            const float i1 = 1.0f / lb[q], i2 = lam / lb[QU + q];
            const f32x4_t x0 = a0 * i1 - b0 * i2, x1 = a1 * i1 - b1 * i2;
            float ss = ((x0[0] * x0[0] + x0[1] * x0[1]) + (x0[2] * x0[2] + x0[3] * x0[3])) + ((x1[0] * x1[0] + x1[1] * x1[1]) + (x1[2] * x1[2] + x1[3] * x1[3]));
            ss = xadd<1>(ss); ss = xadd<2>(ss); ss = xadd<4>(ss); ss = xadd<8>(ss);
            const float rs = outscale * __builtin_amdgcn_rsqf(ss * (1.0f / 128.0f) + 1e-6f);
            const f32x4_t y0 = x0 * rs * sg0, y1 = x1 * rs * sg1;
            u32x4 w4; w4.x = cvtpk(y0[0], y0[1]); w4.y = cvtpk(y0[2], y0[3]); w4.z = cvtpk(y1[0], y1[1]); w4.w = cvtpk(y1[2], y1[3]);
            *(u32x4*)(O + (rowbase + q0 + q) * DM + h * 128 + 8 * c16) = w4;
        }
    }
    ATT_WAIT_BAR(0);
#undef ATT_DMA
}
}

#define LAS __attribute__((address_space(3)))
typedef unsigned short bf16;
typedef unsigned v4u __attribute__((ext_vector_type(4)));
typedef unsigned v2u __attribute__((ext_vector_type(2)));
typedef float f32x4 __attribute__((ext_vector_type(4)));
typedef float f32x2 __attribute__((ext_vector_type(2)));
typedef short bf16x8 __attribute__((ext_vector_type(8)));
constexpr int NWAVES = 8, NTHREADS = 512;
constexpr int M = 32768, D = 1024, F = 2816, SEQ = 8192, NB = 4, NMOD = 9 * 1024;
constexpr int LDS_BYTES = 147456;
constexpr size_t MiB = 1u << 20;
constexpr size_t WS_MOD = 0;
constexpr size_t WS_BV = 512 * 1024;
constexpr size_t WS_BAR = 960 * 1024;
constexpr size_t WS_SSQ = 1 * MiB;
constexpr size_t WS_W = 2 * MiB;
constexpr size_t W_FFN_STRIDE = 33 * MiB / 2;
constexpr size_t W_GU_BYTES = 11 * MiB;
constexpr size_t WS_WQKV = WS_W + 66 * MiB, WS_WO = WS_W + 72 * MiB, WS_WIN = WS_W + 74 * MiB, WS_WOUT = WS_W + 78 * MiB;
constexpr size_t WS_A = 83 * MiB;
constexpr size_t WS_O = 147 * MiB;
constexpr size_t WS_H = 211 * MiB;
constexpr size_t WS_Q = WS_H, WS_K = WS_H + 64 * MiB, WS_V = WS_H + 128 * MiB;
constexpr size_t WS_Z = WS_H, WS_G = WS_H + 128 * MiB;
constexpr size_t WS_END = 403 * MiB;

__device__ __forceinline__ unsigned pk2(float lo, float hi) { unsigned r; asm volatile("v_cvt_pk_bf16_f32 %0, %1, %2" : "=v"(r) : "v"(lo), "v"(hi)); return r; }
__device__ __forceinline__ float bf_lo(unsigned w) { return __uint_as_float(w << 16); }
__device__ __forceinline__ float bf_hi(unsigned w) { return __uint_as_float(w & 0xffff0000u); }
__device__ __forceinline__ void transpose_item(const float* W, int K, int N, bf16* WT, int kb, int n0, int row_base, LAS float* scr, int lane) {
    const int k0 = 64 * kb;
    f32x4 wv[8];
#pragma unroll
    for (int i = 0; i < 8; ++i) wv[i] = *(const f32x4*)(W + (size_t)(k0 + 8 * i + (lane >> 3)) * N + n0 + 4 * (lane & 7));
#pragma unroll
    for (int i = 0; i < 8; ++i) { LAS float* d = scr + (8 * i + (lane >> 3)) * 33 + 4 * (lane & 7); d[0] = wv[i].x; d[1] = wv[i].y; d[2] = wv[i].z; d[3] = wv[i].w; }
    asm volatile("s_waitcnt lgkmcnt(0)" ::: "memory");
    const int c = lane & 7;
#pragma unroll
    for (int j = 0; j < 4; ++j) { const int n = (lane >> 3) + 8 * j; const LAS float* s = scr + (8 * c) * 33 + n;
        v4u o; o.x = pk2(s[0 * 33], s[1 * 33]); o.y = pk2(s[2 * 33], s[3 * 33]); o.z = pk2(s[4 * 33], s[5 * 33]); o.w = pk2(s[6 * 33], s[7 * 33]);
        *(v4u*)(WT + (size_t)(row_base + n) * K + k0 + 8 * c) = o; }
    asm volatile("s_waitcnt lgkmcnt(0)" ::: "memory");
}

struct Params { const float* in[30]; float* out; unsigned char* ws; int ph_lo, ph_hi; };
struct PL {
    const LAS unsigned* d;
    __device__ __forceinline__ unsigned u(int i) const { return (unsigned)__builtin_amdgcn_readfirstlane((int)d[i]); }
    __device__ __forceinline__ const float* in(int i) const { const unsigned long long lo = u(2 * i), hi = u(2 * i + 1); return (const float*)(const __attribute__((address_space(1))) float*)((hi << 32) | lo); }
    __device__ __forceinline__ float* out() const { const unsigned long long lo = u(60), hi = u(61); return (float*)(__attribute__((address_space(1))) float*)((hi << 32) | lo); }
    __device__ __forceinline__ unsigned char* ws() const { const unsigned long long lo = u(62), hi = u(63); return (unsigned char*)(__attribute__((address_space(1))) unsigned char*)((hi << 32) | lo); }
};
enum { I_X = 0, I_C, I_RELB, I_ADAW, I_ADAB, I_LNF1, I_F1G, I_F1U, I_F1D, I_LNMIX, I_LNF2, I_F2G, I_F2U, I_F2D, I_LNOUT, I_WQKV, I_QN, I_KN, I_LQ1, I_LK1, I_LQ2, I_LK2, I_SUBLN, I_WO,
       I_WIN, I_SLNG, I_SLNB, I_SWS, I_SBS, I_WOUT };
constexpr int NPHASE = 17;
#ifndef PHMASK
#define PHMASK 0xff
#endif

__device__ __forceinline__ void convert_weights(const PL& P, LAS unsigned char* lds, int gw, int NGW, int wave, int lane) {
    LAS float* scr = (LAS float*)(lds + wave * 8448);
    constexpr int IT_F = 1408, IT_FFN = 12 * IT_F, IT_QKV = 1536, IT_WO = 512, IT_WIN = 1024, IT_WOUT = 512;
    constexpr int NITEMS = IT_FFN + IT_QKV + IT_WO + IT_WIN + IT_WOUT;
    for (int it = gw; it < NITEMS; it += NGW) {
        int r = it;
        if (r < IT_FFN) {
            const int mi = r / IT_F, ri = r % IT_F; const int l = mi / 6, w = mi % 6; const int f = w / 3, kind = w % 3;
            bf16* gu = (bf16*)(P.ws() + WS_W + (size_t)(l * 2 + f) * W_FFN_STRIDE); bf16* dn = (bf16*)((unsigned char*)gu + W_GU_BYTES);
            if (kind < 2) { const float* W = (f == 0 ? (kind == 0 ? P.in(I_F1G) : P.in(I_F1U)) : (kind == 0 ? P.in(I_F2G) : P.in(I_F2U))) + (size_t)l * D * F; const int nblk = F / 32, kb = ri / nblk, n0 = 32 * (ri % nblk);
                transpose_item(W, D, F, gu, kb, n0, 256 * (n0 >> 7) + (n0 & 127) + 128 * kind, scr, lane); }
            else { const float* W = (f == 0 ? P.in(I_F1D) : P.in(I_F2D)) + (size_t)l * F * D; const int nblk = D / 32, kb = ri / nblk, n0 = 32 * (ri % nblk);
                transpose_item(W, F, D, dn, kb, n0, n0, scr, lane); }
            continue;
        }
        r -= IT_FFN;
        if (r < IT_QKV) { const int nblk = 3072 / 32, kb = r / nblk, n0 = 32 * (r % nblk); const int pn = n0 >> 8, rr = n0 & 255, wc = rr >> 6, bj = (rr >> 5) & 1;
            transpose_item(P.in(I_WQKV), D, 3072, (bf16*)(P.ws() + WS_WQKV), kb, n0, 256 * pn + 128 * bj + 32 * wc, scr, lane); continue; }
        r -= IT_QKV;
        if (r < IT_WO) { const int nblk = D / 32, kb = r / nblk, n0 = 32 * (r % nblk); transpose_item(P.in(I_WO), D, D, (bf16*)(P.ws() + WS_WO), kb, n0, n0, scr, lane); continue; }
        r -= IT_WO;
        if (r < IT_WIN) { const int nblk = 2048 / 32, kb = r / nblk, n0 = 32 * (r % nblk); transpose_item(P.in(I_WIN), D, 2048, (bf16*)(P.ws() + WS_WIN), kb, n0, n0, scr, lane); continue; }
        r -= IT_WIN;
        { const int nblk = D / 32, kb = r / nblk, n0 = 32 * (r % nblk); transpose_item(P.in(I_WOUT), D, D, (bf16*)(P.ws() + WS_WOUT), kb, n0, n0, scr, lane); }
    }
}

__device__ __forceinline__ void ada_phase(const PL& P, LAS unsigned char* lds, int vcu, int G, int tid, int wave, int lane) {
    if (vcu >= 144) return;
    LAS float* cact = (LAS float*)(lds + 69632);
    LAS float* red = (LAS float*)(lds + 86016);
    const float* c = P.in(I_C);
    for (int i = tid; i < 4096; i += NTHREADS) { const float x = c[i]; cact[i] = x / (1.0f + expf(-x)); }
    __syncthreads();
    float* mod = (float*)(P.ws() + WS_MOD);
    for (int item = vcu; item < 144; item += G) {
        const int l = item / 72, jb = item % 72;
        const float* W = P.in(I_ADAW) + (size_t)l * D * NMOD + jb * 128 + 2 * lane;
        float acc[4][2];
#pragma unroll
        for (int b = 0; b < 4; ++b) { acc[b][0] = 0.f; acc[b][1] = 0.f; }
#pragma unroll 8
        for (int kk = 0; kk < 128; ++kk) { const int k = wave * 128 + kk; const f32x2 w = *(const f32x2*)(W + (size_t)k * NMOD);
#pragma unroll
            for (int b = 0; b < 4; ++b) { const float cv = cact[b * 1024 + k]; acc[b][0] += cv * w.x; acc[b][1] += cv * w.y; } }
#pragma unroll
        for (int b = 0; b < 4; ++b) { red[(wave * 4 + b) * 128 + 2 * lane] = acc[b][0]; red[(wave * 4 + b) * 128 + 2 * lane + 1] = acc[b][1]; }
        __syncthreads();
        { const int b = tid >> 7, col = tid & 127; float s = 0.f;
#pragma unroll
            for (int w = 0; w < 8; ++w) s += red[(w * 4 + b) * 128 + col];
            mod[(size_t)(l * 4 + b) * NMOD + jb * 128 + col] = s + P.in(I_ADAB)[(size_t)l * NMOD + jb * 128 + col]; }
        __syncthreads();
    }
}

__device__ __forceinline__ void norm_phase(const float* xsrc, float* xdst, const float* gout, bf16* a, const float* g, const float* sh, const float* sc, int mode, int gw, int NGW, int lane) {
    for (int row = gw; row < M; row += NGW) {
        const int b = row >> 13;
        const f32x4* xr = (const f32x4*)(xsrc + (size_t)row * D) + lane;
        f32x4 v[4];
#pragma unroll
        for (int j = 0; j < 4; ++j) v[j] = xr[64 * j];
        if (mode >= 1) {
            float ss = 0.f;
#pragma unroll
            for (int j = 0; j < 4; ++j) ss += (v[j].x * v[j].x + v[j].y * v[j].y) + (v[j].z * v[j].z + v[j].w * v[j].w);
            const float rs = 1.0f / sqrtf(wave_sum(ss) * (1.0f / D) + 1e-6f);
            f32x4* xo = (f32x4*)(xdst + (size_t)row * D) + lane;
#pragma unroll
            for (int j = 0; j < 4; ++j) { const f32x4 gg = *((const f32x4*)gout + lane + 64 * j); v[j] = v[j] * rs * gg; xo[64 * j] = v[j]; }
        }
        if (mode != 2) {
            float ss = 0.f;
#pragma unroll
            for (int j = 0; j < 4; ++j) ss += (v[j].x * v[j].x + v[j].y * v[j].y) + (v[j].z * v[j].z + v[j].w * v[j].w);
            const float rs = 1.0f / sqrtf(wave_sum(ss) * (1.0f / D) + 1e-6f);
            v2u* ao = (v2u*)(a + (size_t)row * D) + lane;
#pragma unroll
            for (int j = 0; j < 4; ++j) { const f32x4 gg = *((const f32x4*)g + lane + 64 * j), s4 = *((const f32x4*)(sh + (size_t)b * NMOD) + lane + 64 * j), c4 = *((const f32x4*)(sc + (size_t)b * NMOD) + lane + 64 * j);
                const f32x4 y = (v[j] * rs * gg) * (c4 + 1.0f) + s4; v2u w; w.x = pk2(y.x, y.y); w.y = pk2(y.z, y.w); ao[64 * j] = w; }
        }
    }
}

__device__ __forceinline__ void prep_phase(const PL& P, int gw, int NGW, int lane) {
    unsigned char* ws = P.ws(); const float* mod = (const float*)(ws + WS_MOD);
    { const float* x = P.in(I_X); bf16* a = (bf16*)(ws + WS_A); float* ssq0 = (float*)(ws + WS_SSQ); const float* g = P.in(I_LNF1); const float* sc = mod + 1024;
      for (int row0 = gw; row0 < M; row0 += 2 * NGW) {
          f32x4 v[2][4]; float ss[2];
#pragma unroll
          for (int k = 0; k < 2; ++k) { const int row = row0 + k * NGW; const f32x4* xr = (const f32x4*)(x + (size_t)row * D) + lane;
#pragma unroll
              for (int j = 0; j < 4; ++j) v[k][j] = xr[64 * j]; }
#pragma unroll
          for (int k = 0; k < 2; ++k) { ss[k] = 0.f;
#pragma unroll
              for (int j = 0; j < 4; ++j) ss[k] += (v[k][j].x * v[k][j].x + v[k][j].y * v[k][j].y) + (v[k][j].z * v[k][j].z + v[k][j].w * v[k][j].w); }
          ss[0] = xadd<1>(ss[0]); ss[1] = xadd<1>(ss[1]); ss[0] = xadd<2>(ss[0]); ss[1] = xadd<2>(ss[1]); ss[0] = xadd<4>(ss[0]); ss[1] = xadd<4>(ss[1]);
          ss[0] = xadd<8>(ss[0]); ss[1] = xadd<8>(ss[1]); ss[0] = xadd<16>(ss[0]); ss[1] = xadd<16>(ss[1]); ss[0] = xadd<32>(ss[0]); ss[1] = xadd<32>(ss[1]);
#pragma unroll
          for (int k = 0; k < 2; ++k) { const int row = row0 + k * NGW; const int b = row >> 13; if (lane == 0) ssq0[row] = ss[k];
              v2u* ao = (v2u*)(a + (size_t)row * D) + lane;
#pragma unroll
              for (int j = 0; j < 4; ++j) { const f32x4 gg = *((const f32x4*)g + lane + 64 * j), c4 = *((const f32x4*)(sc + (size_t)b * NMOD) + lane + 64 * j);
                  const f32x4 y = v[k][j] * gg * (c4 + 1.0f); v2u w; w.x = pk2(y.x, y.y); w.y = pk2(y.z, y.w); ao[64 * j] = w; } } } }
    float* bvec = (float*)(ws + WS_BV);
    for (int it = gw; it < 27648; it += NGW) {
        int n = it, N = 5632, boff = 0, shoff = 0; const bf16* W = (const bf16*)(ws + WS_W);
        if (n >= 22016) { n -= 22016; W = (const bf16*)(ws + WS_W + 3 * W_FFN_STRIDE); boff = 88064; shoff = 4 * NMOD + 6144; }
        else if (n >= 19968) { n -= 19968; W = (const bf16*)(ws + WS_WIN); N = 2048; boff = 79872; shoff = 4 * NMOD + 3072; }
        else if (n >= 14336) { n -= 14336; W = (const bf16*)(ws + WS_W + 2 * W_FFN_STRIDE); boff = 57344; shoff = 4 * NMOD; }
        else if (n >= 8704) { n -= 8704; W = (const bf16*)(ws + WS_W + 1 * W_FFN_STRIDE); boff = 34816; shoff = 6144; }
        else if (n >= 5632) { n -= 5632; W = (const bf16*)(ws + WS_WQKV); N = 3072; boff = 22528; shoff = 3072; }
        const v4u* wp = (const v4u*)(W + (size_t)n * D + lane * 16); const v4u wa = wp[0], wb = wp[1];
        const float w[16] = {bf_lo(wa.x), bf_hi(wa.x), bf_lo(wa.y), bf_hi(wa.y), bf_lo(wa.z), bf_hi(wa.z), bf_lo(wa.w), bf_hi(wa.w), bf_lo(wb.x), bf_hi(wb.x), bf_lo(wb.y), bf_hi(wb.y), bf_lo(wb.z), bf_hi(wb.z), bf_lo(wb.w), bf_hi(wb.w)};
#pragma unroll
        for (int b = 0; b < 4; ++b) { const f32x4* sp = (const f32x4*)(mod + shoff + (size_t)b * NMOD + lane * 16); float d = 0.f;
#pragma unroll
            for (int q = 0; q < 4; ++q) { const f32x4 s4 = sp[q]; d += (s4.x * w[4 * q] + s4.y * w[4 * q + 1]) + (s4.z * w[4 * q + 2] + s4.w * w[4 * q + 3]); }
            d = wave_sum(d); if (lane == 0) bvec[boff + b * N + n] = d; }
    }
}

__device__ __forceinline__ void sgu_phase(const PL& P, LAS unsigned char* lds, int vcu, int G, int tid, int wave, int lane) {
    constexpr int ST = 136;
    LAS bf16* Wt = (LAS bf16*)lds; LAS bf16* Vt = (LAS bf16*)(lds + 34816); LAS float* st = (LAS float*)(lds + 69632);
    const bf16* Z = (const bf16*)(P.ws() + WS_Z); bf16* Gt = (bf16*)(P.ws() + WS_G);
    const float* wsp = P.in(I_SWS); const float* bs = P.in(I_SBS); const float* lng = P.in(I_SLNG); const float* lnb = P.in(I_SLNB);
    const int fr = lane & 15, fq = lane >> 4;
    for (int unit = vcu; unit < 256; unit += G) {
        const size_t r0 = (size_t)unit * 128;
        {
            const int rsub = lane >> 4, c16 = lane & 15;
#pragma unroll
            for (int it = 0; it < 4; ++it) { const int row = 16 * wave + 4 * it + rsub; const v4u* p = (const v4u*)(Z + (r0 + row) * 2048 + 1024 + c16 * 64);
                float s1 = 0.f, s2 = 0.f;
#pragma unroll
                for (int j = 0; j < 8; ++j) { const v4u a = p[j];
                    const float x[8] = {bf_lo(a.x), bf_hi(a.x), bf_lo(a.y), bf_hi(a.y), bf_lo(a.z), bf_hi(a.z), bf_lo(a.w), bf_hi(a.w)};
#pragma unroll
                    for (int k = 0; k < 8; ++k) { s1 += x[k]; s2 += x[k] * x[k]; } }
                s1 = xadd<1>(s1); s2 = xadd<1>(s2); s1 = xadd<2>(s1); s2 = xadd<2>(s2); s1 = xadd<4>(s1); s2 = xadd<4>(s2); s1 = xadd<8>(s1); s2 = xadd<8>(s2);
                const float mean = s1 * (1.0f / 1024.0f); const float var = fmaxf(s2 * (1.0f / 1024.0f) - mean * mean, 0.f);
                if (c16 == 0) { st[row * 2] = mean; st[row * 2 + 1] = 1.0f / sqrtf(var + 1e-6f); } }
        }
        __syncthreads();
        for (int g = 0; g < 8; ++g) {
#pragma unroll
            for (int it = 0; it < 4; ++it) { const int idx = it * NTHREADS + tid, t = idx >> 4, s0 = (idx & 15) * 8; const float* wp = wsp + ((size_t)g * 128 + t) * 128 + s0;
                const f32x4 a = *(const f32x4*)wp, b = *(const f32x4*)(wp + 4); float w[8] = {a.x, a.y, a.z, a.w, b.x, b.y, b.z, b.w};
#pragma unroll
                for (int k = 0; k < 8; ++k) w[k] = (s0 + k <= t) ? w[k] : 0.f;
                v4u o; o.x = pk2(w[0], w[1]); o.y = pk2(w[2], w[3]); o.z = pk2(w[4], w[5]); o.w = pk2(w[6], w[7]);
                *(LAS v4u*)(Wt + t * ST + s0) = o; }
#pragma unroll
            for (int it = 0; it < 4; ++it) { const int idx = it * NTHREADS + tid, s = idx & 127, cc = idx >> 7;
                const v4u a = *(const v4u*)(Z + (r0 + s) * 2048 + 1024 + g * 128 + cc * 8);
                const float mean = st[s * 2], rstd = st[s * 2 + 1];
                float x[8] = {bf_lo(a.x), bf_hi(a.x), bf_lo(a.y), bf_hi(a.y), bf_lo(a.z), bf_hi(a.z), bf_lo(a.w), bf_hi(a.w)};
                const f32x4 g0 = *(const f32x4*)(lng + g * 128 + cc * 8), g1 = *(const f32x4*)(lng + g * 128 + cc * 8 + 4), b0 = *(const f32x4*)(lnb + g * 128 + cc * 8), b1 = *(const f32x4*)(lnb + g * 128 + cc * 8 + 4);
                const float gg[8] = {g0.x, g0.y, g0.z, g0.w, g1.x, g1.y, g1.z, g1.w}, bb[8] = {b0.x, b0.y, b0.z, b0.w, b1.x, b1.y, b1.z, b1.w};
#pragma unroll
                for (int k = 0; k < 8; k += 2) { const unsigned w = pk2((x[k] - mean) * rstd * gg[k] + bb[k], (x[k + 1] - mean) * rstd * gg[k + 1] + bb[k + 1]);
                    Vt[(cc * 8 + k) * ST + s] = (bf16)(w & 0xffffu); Vt[(cc * 8 + k + 1) * ST + s] = (bf16)(w >> 16); } }
            __syncthreads();
            f32x4 acc[8];
#pragma unroll
            for (int n = 0; n < 8; ++n) acc[n] = (f32x4){0.f, 0.f, 0.f, 0.f};
            const int nks = (16 * wave + 15) / 32 + 1;
            for (int ks = 0; ks < nks; ++ks) {
                const bf16x8 af = *(const LAS bf16x8*)(Wt + (16 * wave + fr) * ST + 32 * ks + 8 * fq);
#pragma unroll
                for (int n = 0; n < 8; ++n) { const bf16x8 bfv = *(const LAS bf16x8*)(Vt + (16 * n + fr) * ST + 32 * ks + 8 * fq);
                    acc[n] = __builtin_amdgcn_mfma_f32_16x16x32_bf16(bfv, af, acc[n], 0, 0, 0); }
            }
            const int t = 16 * wave + fr; const float bias = bs[g * 128 + t]; const size_t row = r0 + t;
#pragma unroll
            for (int n = 0; n < 8; ++n) { const int col = g * 128 + 16 * n + 4 * fq; const v2u uu = *(const v2u*)(Z + row * 2048 + col);
                v2u w; w.x = pk2(bf_lo(uu.x) * (acc[n][0] + bias), bf_hi(uu.x) * (acc[n][1] + bias)); w.y = pk2(bf_lo(uu.y) * (acc[n][2] + bias), bf_hi(uu.y) * (acc[n][3] + bias));
                *(v2u*)(Gt + row * 1024 + col) = w; }
            __syncthreads();
        }
    }
}

#define XB_TMO      128
#define XB_XCNT(j)  (256  + 64 * (j))
#define XB_XSUB(j)  (1280 + 64 * (j))
#define XB_XGEN(j)  (2304 + 64 * (j))
#define XB_TOP      3328
#define XB_TOPGEN   3392
#define XCD_BAR_WORDS 3456
#define XB_SPIN_CAP (1u << 18)

__device__ __forceinline__ unsigned xb_ld(unsigned* p)              { return __hip_atomic_load(p, __ATOMIC_RELAXED, __HIP_MEMORY_SCOPE_AGENT); }
__device__ __forceinline__ unsigned xb_add(unsigned* p, unsigned v) { return __hip_atomic_fetch_add(p, v, __ATOMIC_RELAXED, __HIP_MEMORY_SCOPE_AGENT); }
__device__ __forceinline__ unsigned xb_xcc_id() { return (unsigned)__builtin_amdgcn_s_getreg((3 << 11) | 20) & 0xFu; }
#define XB_SPIN(cond, bar) do { unsigned _sp = 0; while (cond) { __builtin_amdgcn_s_sleep(1); \
    if ((++_sp & 255u) == 0u) { if (xb_ld(&(bar)[XB_TMO])) break; if (_sp > XB_SPIN_CAP) { atomicAdd(&(bar)[XB_TMO], 1u); break; } } } } while (0)

struct XcdBarrier {
    unsigned* bar; unsigned x;
    volatile LAS unsigned* st;
};

__device__ __forceinline__ XcdBarrier xcd_barrier_post(unsigned* bar, volatile LAS unsigned* st) {
    XcdBarrier b; b.bar = bar; b.x = xb_xcc_id(); b.st = st;
    if (threadIdx.x == 0) (void)xb_add(&bar[XB_XCNT(b.x)], 1u);
    return b;
}
__device__ __forceinline__ void xcd_barrier_complete(unsigned* bar, unsigned x, unsigned& nloc, unsigned& nx) {
    const unsigned G = gridDim.x * gridDim.y * gridDim.z;
    unsigned sum, cnt, mine, sp = 0u;
    for (;;) {
        sum = 0u; cnt = 0u; mine = 0u;
#pragma unroll
        for (unsigned j = 0; j < 16; ++j) { const unsigned c = xb_ld(&bar[XB_XCNT(j)]); sum += c; cnt += (c > 0u) ? 1u : 0u; mine = (j == x) ? c : mine; }
        if (sum == G) break;
        __builtin_amdgcn_s_sleep(1);
        if ((++sp & 255u) == 0u) { if (xb_ld(&bar[XB_TMO])) break; if (sp > XB_SPIN_CAP) { atomicAdd(&bar[XB_TMO], 1u); break; } }
    }
    nloc = mine > 0u ? mine : 1u; nx = cnt > 0u ? cnt : 1u;
}

__device__ __forceinline__ void xcd_barrier(const XcdBarrier& b) {
    asm volatile("s_waitcnt vmcnt(0)" ::: "memory");
    __syncthreads();
    if (threadIdx.x == 0) {
        unsigned* bar = b.bar;
        __builtin_amdgcn_s_waitcnt(0);
        unsigned nloc = b.st[0], nx = b.st[1];
        if (nloc == 0u) { xcd_barrier_complete(bar, b.x, nloc, nx); b.st[0] = nloc; b.st[1] = nx; }
        const unsigned old = xb_add(&bar[XB_XSUB(b.x)], 1u);
        const unsigned gen = old / nloc;
        if (old + 1u == (gen + 1u) * nloc) {
            __builtin_amdgcn_fence(__ATOMIC_RELEASE, "agent");
            asm volatile("s_waitcnt vmcnt(0)" ::: "memory");
            const unsigned og = xb_add(&bar[XB_TOP], 1u);
            const unsigned tg = og / nx;
            if (og + 1u == (tg + 1u) * nx) xb_add(&bar[XB_TOPGEN], 1u);
            else XB_SPIN(xb_ld(&bar[XB_TOPGEN]) == tg, bar);
            __builtin_amdgcn_fence(__ATOMIC_ACQUIRE, "agent");
            xb_add(&bar[XB_XGEN(b.x)], 1u);
            asm volatile("s_waitcnt vmcnt(0)" ::: "memory");
        } else {
            XB_SPIN(xb_ld(&bar[XB_XGEN(b.x)]) == gen, bar);
            __builtin_amdgcn_fence(__ATOMIC_ACQUIRE, "agent");
            asm volatile("s_waitcnt vmcnt(0)" ::: "memory");
        }
    }
    __syncthreads();
}

template <class Epi> __device__ __forceinline__ void run_gemm(LAS unsigned char* lds, const bf16* A, const bf16* Bt, int N, int K, int G, const Epi& E) {
    pg8::Gemm g{A, Bt, M, N, K}; pg8::StaticOrder S; S.init(M, N, G, (int)blockIdx.x);
    pg8::gemm_phase<Epi, pg8::StaticOrder, true, true>(lds, g, S, E);
}

__global__ void __launch_bounds__(NTHREADS, 2) mega_fwd(Params KP) {
    extern __shared__ __attribute__((aligned(16))) unsigned char lds_raw[];
    LAS unsigned char* lds = (LAS unsigned char*)lds_raw;
    cg::grid_group grid = cg::this_grid();
    { LAS unsigned* pd = (LAS unsigned*)(lds + 133376);
      if (threadIdx.x == 0) { ((LAS unsigned*)(lds + 133888))[0] = 0u; ((LAS unsigned*)(lds + 133888))[1] = 0u;
#pragma unroll
          for (int i = 0; i < 30; ++i) { const unsigned long long a = (unsigned long long)(uintptr_t)KP.in[i]; pd[2 * i] = (unsigned)a; pd[2 * i + 1] = (unsigned)(a >> 32); }
          { const unsigned long long a = (unsigned long long)(uintptr_t)KP.out; pd[60] = (unsigned)a; pd[61] = (unsigned)(a >> 32); }
          { const unsigned long long a = (unsigned long long)(uintptr_t)KP.ws; pd[62] = (unsigned)a; pd[63] = (unsigned)(a >> 32); } }
      __syncthreads(); }
    const PL P{(const LAS unsigned*)(lds + 133376)};
    (void)xcd_barrier_post((unsigned*)(KP.ws + WS_BAR), (volatile LAS unsigned*)(lds + 133888));
    const int ph_lo = KP.ph_lo, ph_hi = KP.ph_hi;
    const int G0 = gridDim.x, bx = blockIdx.x;
    const int vcu0 = (G0 % 8 == 0) ? (bx % 8) * (G0 / 8) + bx / 8 : bx;
#ifndef REPEAT_PH
#define REPEAT_PH -1
#endif
    for (int pp = ph_lo; pp < ph_hi + (REPEAT_PH >= 0 ? 1 : 0); ++pp) {
        const int ph = (REPEAT_PH >= 0 && pp > REPEAT_PH) ? pp - 1 : pp;
        int vcu = vcu0, G = G0; asm volatile("" : "+s"(vcu), "+s"(G));
        const int NGW = G * NWAVES;
        const int tid = opaque_tid(), lane = tid & 63, wave = __builtin_amdgcn_readfirstlane(tid >> 6); const int gw = vcu * NWAVES + wave;
        unsigned char* ws = P.ws(); asm volatile("" : "+s"(ws));
        float* mod = (float*)(ws + WS_MOD); float* ssq = (float*)(ws + WS_SSQ); const float* bvec = (const float*)(ws + WS_BV);
        bf16* Abuf = (bf16*)(ws + WS_A); bf16* Hbuf = (bf16*)(ws + WS_H);
        float* out = P.out();
        int type = 0, l = 0, f = 0, sA = 0, sB = -1, bvo = 0, modoff = 0;
        const float* xsrc = out; const bf16* rA = Hbuf; const bf16* rB = nullptr; int rK = F; float rgs = 0.5f;
        int so = -1, sob = -1, wsc_off = 0, lazy = -1; const float* wg = nullptr; const float* wg2 = nullptr;
        switch (ph) {
            case 0: type = 0; break;
            case 1: type = 1; break;
            case 2: type = 2; l = 0; f = 0; sA = 0; bvo = 0; break;
            case 3: type = 3; l = 0; rB = (const bf16*)(ws + WS_W + 0 * W_FFN_STRIDE + W_GU_BYTES); modoff = 2048; xsrc = P.in(I_X); so = 1; wg = P.in(I_LNMIX); wsc_off = 4096; break;
            case 4: type = 4; sA = 1; bvo = 22528; break;
            case 5: type = 5; break;
            case 6: type = 3; l = 0; rA = (const bf16*)(ws + WS_O); rB = (const bf16*)(ws + WS_WO); rK = D; rgs = 1.0f; modoff = 5120; so = 2; wg = P.in(I_LNF2); wsc_off = 7168; break;
            case 7: type = 2; l = 0; f = 1; sA = 2; bvo = 34816; break;
            case 8: type = 3; l = 0; rB = (const bf16*)(ws + WS_W + 1 * W_FFN_STRIDE + W_GU_BYTES); modoff = 8192; so = 3; sob = 4; wg = P.in(I_LNF1) + D; wsc_off = 4 * NMOD + 1024; wg2 = P.in(I_LNOUT); break;
            case 9: type = 2; l = 1; f = 0; sA = 3; sB = 4; bvo = 57344; break;
            case 10: type = 3; l = 1; rB = (const bf16*)(ws + WS_W + 2 * W_FFN_STRIDE + W_GU_BYTES); modoff = 2048; lazy = 3; so = 5; wg = P.in(I_LNMIX) + D; wsc_off = 4 * NMOD + 4096; break;
            case 11: type = 6; sA = 5; bvo = 79872; break;
            case 12: type = 7; break;
            case 13: type = 3; l = 1; rA = (const bf16*)(ws + WS_G); rB = (const bf16*)(ws + WS_WOUT); rK = D; rgs = 1.0f; modoff = 5120; so = 6; wg = P.in(I_LNF2) + D; wsc_off = 4 * NMOD + 7168; break;
            case 14: type = 2; l = 1; f = 1; sA = 6; bvo = 88064; break;
            case 15: type = 3; l = 1; rB = (const bf16*)(ws + WS_W + 3 * W_FFN_STRIDE + W_GU_BYTES); modoff = 8192; break;
            default: type = 8; break;
        }
        const float* modl = mod + (size_t)l * 4 * NMOD;
        if ((PHMASK & 1) && type == 0) {
            for (int i = gw * 64 + lane; i < 7 * M; i += NGW * 64) ssq[i] = 0.f;
            convert_weights(P, lds, gw, NGW, wave, lane);
            ada_phase(P, lds, vcu, G, tid, wave, lane);
        } else if ((PHMASK & 2) && type == 1) {
            prep_phase(P, gw, NGW, lane);
        } else if ((PHMASK & 2) && type == 8) {
            norm_phase(out, out, P.in(I_LNOUT) + D, Abuf, nullptr, nullptr, nullptr, 2, gw, NGW, lane);
        } else if ((PHMASK & 32) && type == 5) {
            const float p1 = wave_sum(P.in(I_LQ1)[lane] * P.in(I_LK1)[lane]), p2 = wave_sum(P.in(I_LQ2)[lane] * P.in(I_LK2)[lane]);
            const float lam = expf(p1) - expf(p2) + 0.2f;
            const float kmaxn = wave_max(fabsf(P.in(I_KN)[lane])) * 8.0f * 1.02f;
            for (int v = vcu; v < 256; v += G) {
                const int bh = v >> 3, j = v & 7;
                const float* relb = P.in(I_RELB); const float bmax = att::attn_head_setup(lds, relb, bh & 7); const float lut31 = relb[31 * 8 + (bh & 7)] * att::LOG2E;
                for (int i = 0; i < 8; ++i) { const int s = j + 8 * (i >> 1); const int qb = (i & 1) ? 63 - s : s;
                    att::attn_unit(bh >> 3, bh & 7, qb, (const bf16*)(ws + WS_Q), (const bf16*)(ws + WS_K), (const bf16*)(ws + WS_V), (bf16*)(ws + WS_O), lds, bmax, lut31, lam, kmaxn, P.in(I_SUBLN), 0.8f); }
            }
        } else if ((PHMASK & 4) && (type == 2 || type == 3 || type == 4 || type == 6)) {
            pg8::EpiMulti E{}; const bf16* gA = Abuf; const bf16* gB = nullptr; int gN = D, gK = D;
            E.ssqA = ssq + (size_t)sA * M; E.ssqB = sB >= 0 ? ssq + (size_t)sB * M : nullptr; E.bvec = bvec + bvo;
            if (type == 2) { E.kind = 0; E.p0 = Hbuf; E.i0 = F; gB = (const bf16*)(ws + WS_W + (size_t)(l * 2 + f) * W_FFN_STRIDE); gN = 2 * F; }
            else if (type == 3) { E.kind = lazy >= 0 ? 5 : (wg2 ? 4 : 1); E.g0 = xsrc; E.p0 = out; E.g1 = modl + modoff; E.f0 = rgs; gA = rA; gB = rB; gK = rK;
                E.lazy_ssq = lazy >= 0 ? ssq + (size_t)lazy * M : nullptr; E.lazy_g = P.in(I_LNOUT);
                E.aout = so >= 0 ? (void*)Abuf : nullptr; E.wg = wg; E.wsc = mod + wsc_off; E.wg2 = wg2; E.ssq_out = ssq + (size_t)(so >= 0 ? so : 0) * M; E.ssqB_out = ssq + (size_t)(sob >= 0 ? sob : 0) * M; }
            else if (type == 4) { E.kind = 2; E.p0 = ws + WS_Q; E.p1 = ws + WS_K; E.p2 = ws + WS_V; E.g0 = P.in(I_QN); E.g1 = P.in(I_KN); E.f0 = att::C2; gB = (const bf16*)(ws + WS_WQKV); gN = 3 * D; }
            else { E.kind = 3; E.p0 = ws + WS_Z; E.i0 = 2048; gB = (const bf16*)(ws + WS_WIN); gN = 2048; }
            { LAS unsigned* dd = (LAS unsigned*)(lds + 133120);
              if (tid == 0) {
#define DW(i, v) dd[i] = (unsigned)(v)
#define DP(i, ptr) do { const unsigned long long a_ = (unsigned long long)(uintptr_t)(ptr); dd[i] = (unsigned)a_; dd[(i) + 1] = (unsigned)(a_ >> 32); } while (0)
                  DW(0, E.kind); DW(1, E.i0); DW(2, __float_as_uint(E.f0)); DP(4, E.p0); DP(6, E.p1); DP(8, E.p2); DP(10, E.g0); DP(12, E.g1); DP(14, E.ssqA); DP(16, E.ssqB); DP(18, E.bvec);
                  DP(20, E.lazy_ssq); DP(22, E.lazy_g); DP(24, E.aout); DP(26, E.wg); DP(28, E.wsc); DP(30, E.wg2); DP(32, E.ssq_out); DP(34, E.ssqB_out);
#undef DW
#undef DP
              }
              __syncthreads();
              pg8::EpiLds EL{(const LAS unsigned*)dd};
              run_gemm(lds, gA, gB, gN, gK, G, EL); }
        } else if ((PHMASK & 128) && type == 7) {
            sgu_phase(P, lds, vcu, G, tid, wave, lane);
        }
        if (pp + 1 < ph_hi + (REPEAT_PH >= 0 ? 1 : 0)) { if (ph_lo < 0) grid.sync(); else { XcdBarrier xb_; xb_.bar = (unsigned*)(ws + WS_BAR); xb_.x = xb_xcc_id(); xb_.st = (volatile LAS unsigned*)(lds + 133888); xcd_barrier(xb_); } }
    }
}

#ifndef N_LAUNCH_MODE
#define N_LAUNCH_MODE 0
#endif
extern "C" void kernel_launch(void* const* d_in, const int* in_sizes, int n_in, void* d_out, int out_size, void* d_ws, size_t ws_size, hipStream_t stream) {
    static int grid = 0;
    if (grid == 0) {
        if (n_in != 30 || out_size != M * D || ws_size < WS_END) { fprintf(stderr, "kernel_launch: unexpected problem (n_in %d out %d ws %zu)\n", n_in, out_size, ws_size); grid = -1; return; }
        int dev = 0, cus = 0, per_cu = 0;
        hipGetDevice(&dev); hipDeviceGetAttribute(&cus, hipDeviceAttributeMultiprocessorCount, dev);
        if (hipFuncSetAttribute((const void*)mega_fwd, hipFuncAttributeMaxDynamicSharedMemorySize, LDS_BYTES) != hipSuccess) { fprintf(stderr, "kernel_launch: hipFuncSetAttribute failed\n"); grid = -1; return; }
        if (hipOccupancyMaxActiveBlocksPerMultiprocessor(&per_cu, (const void*)mega_fwd, NTHREADS, LDS_BYTES) != hipSuccess || per_cu < 1) { fprintf(stderr, "kernel_launch: occupancy query gives %d\n", per_cu); per_cu = 1; }
        (void)hipGetLastError();
        grid = cus * 1;
        if (grid <= 0) grid = 256;
    }
    if (grid < 0) return;
    if (hipMemsetAsync((char*)d_ws + WS_BAR, 0, 16384, stream) != hipSuccess) { fprintf(stderr, "kernel_launch: memset of the barrier words failed\n"); return; }
    Params p{};
    for (int i = 0; i < 30; ++i) p.in[i] = (const float*)d_in[i];
    p.out = (float*)d_out; p.ws = (unsigned char*)d_ws;
#if N_LAUNCH_MODE == 1
    for (int ph = 0; ph < NPHASE; ++ph) { p.ph_lo = ph; p.ph_hi = ph + 1; hipLaunchKernelGGL(mega_fwd, dim3(grid), dim3(NTHREADS), LDS_BYTES, stream, p); }
#else
    p.ph_lo = 0; p.ph_hi = NPHASE;
    void* args[] = {&p};
    hipError_t e = hipLaunchCooperativeKernel((const void*)mega_fwd, dim3(grid), dim3(NTHREADS), args, LDS_BYTES, stream);
    if (e != hipSuccess) fprintf(stderr, "cooperative launch failed: %s (grid %d)\n", hipGetErrorString(e), grid);
#endif
}
```

```cpp
#include <hip/hip_runtime.h>
#include <hip/hip_cooperative_groups.h>
#include <cstdio>
#include <cstdint>
#include <cmath>
namespace cg = cooperative_groups;
template <int MASK> __device__ __forceinline__ float xadd(float v) {
    if constexpr (MASK == 32) { auto rr = __builtin_amdgcn_permlane32_swap(__float_as_uint(v), __float_as_uint(v), false, false); return __uint_as_float(rr[0]) + __uint_as_float(rr[1]); }
    else return v + __uint_as_float((unsigned)__builtin_amdgcn_ds_swizzle((int)__float_as_uint(v), (MASK << 10) | 0x1f));
}
template <int MASK> __device__ __forceinline__ float xmax(float v) {
    if constexpr (MASK == 32) { auto rr = __builtin_amdgcn_permlane32_swap(__float_as_uint(v), __float_as_uint(v), false, false); return fmaxf(__uint_as_float(rr[0]), __uint_as_float(rr[1])); }
    else return fmaxf(v, __uint_as_float((unsigned)__builtin_amdgcn_ds_swizzle((int)__float_as_uint(v), (MASK << 10) | 0x1f)));
}
__device__ __forceinline__ float wave_sum(float v) { v = xadd<1>(v); v = xadd<2>(v); v = xadd<4>(v); v = xadd<8>(v); v = xadd<16>(v); return xadd<32>(v); }
__device__ __forceinline__ float wave_max(float v) { v = xmax<1>(v); v = xmax<2>(v); v = xmax<4>(v); v = xmax<8>(v); v = xmax<16>(v); return xmax<32>(v); }
__device__ __forceinline__ int opaque_tid() { int t = threadIdx.x; asm volatile("" : "+v"(t)); return t; }
namespace pg8 {
#define PG8_LAS __attribute__((address_space(3)))
typedef unsigned short bf16_t;
typedef short bf16x8 __attribute__((ext_vector_type(8)));
typedef float f32x4 __attribute__((ext_vector_type(4)));
typedef unsigned u32x4 __attribute__((ext_vector_type(4)));
constexpr int BM = 256, BK = 64, HALF = 128, HTB = HALF * BK * 2  , STAGE_BYTES = 8 * HTB, NXCD = 8, WGM = 8;

__host__ __device__ __forceinline__ int lds_byte(int r, int c) { const int st = (r >> 4) * 2 + (c >> 5), rr = r & 15, cc = c & 31, ob = rr * 64 + cc * 2; return st * 1024 + (ob ^ (((ob >> 9) & 1) << 5)); }
__host__ __device__ __forceinline__ void stage_rc(int b, int& R, int& C) { const int st = b / 1024, sb = b % 1024, swz = sb ^ (((sb >> 9) & 1) << 5); R = (st >> 1) * 16 + swz / 64; C = (st & 1) * 32 + (swz % 64) / 2; }
__host__ __device__ __forceinline__ int perm32(int rho) { const int n = rho >> 4, i = rho & 15; return 8 * (i >> 2) + 4 * n + (i & 3); }

struct Unit { int pm, pn; };
struct Gemm { const bf16_t* A; const bf16_t* Bt; int M, N, K; };

struct StaticOrder {
    int nM, nN, nwg, G, c;
    __host__ __device__ void init(int M, int N, int G_, int c_) { nM = M / BM; nN = N / BM; nwg = nM * nN; G = G_; c = c_; }
    __host__ __device__ bool next(int i, Unit& u) const {
        const long L = (long)i * G + c; if (L >= nwg) return false;
        int wgid = (int)L; { const int q = nwg / NXCD, r = nwg % NXCD, xcd = wgid % NXCD, off = wgid / NXCD; wgid = (xcd < r ? xcd * (q + 1) : r * (q + 1) + (xcd - r) * q) + off; }
        const int nig = WGM * nN, gid = wgid / nig, fm = gid * WGM, gsz = (nM - fm) < WGM ? (nM - fm) : WGM;
        u.pm = fm + ((wgid % nig) % gsz); u.pn = (wgid % nig) / gsz; return true;
    }
    __device__ __forceinline__ void a_ready(const Unit&) const {}
    __device__ __forceinline__ void done(const Unit&) const {}
};

__device__ __forceinline__ unsigned cvt_pk_bf16(float lo, float hi) { unsigned r; asm volatile("v_cvt_pk_bf16_f32 %0, %1, %2" : "=v"(r) : "v"(lo), "v"(hi)); return r; }
typedef float f32x2 __attribute__((ext_vector_type(2)));
__device__ __forceinline__ f32x2 gelu_pk(f32x2 v) {
    const f32x2 av = __builtin_elementwise_abs(v), d = av * 0.2316418882f + 1.0f;
    f32x2 t; t.x = __builtin_amdgcn_rcpf(d.x); t.y = __builtin_amdgcn_rcpf(d.y);
    f32x2 q = t * 0.5307027145f + (-0.7265760135f); q = q * t + 0.7107068705f; q = q * t + (-0.142248368f); q = q * t + 0.127414796f; q = q * t;
    const f32x2 s = (v * v) * (-0.72134752044f);
    f32x2 e; e.x = __builtin_amdgcn_exp2f(s.x); e.y = __builtin_amdgcn_exp2f(s.y);
    const f32x2 m = v * (q * e), r = v - m;
    f32x2 o; o.x = v.x < 0.f ? m.x : r.x; o.y = v.y < 0.f ? m.y : r.y; return o;
}
typedef unsigned u32x2 __attribute__((ext_vector_type(2)));
__device__ __forceinline__ float silu_f(float g) { return g * __builtin_amdgcn_rcpf(1.0f + __builtin_amdgcn_exp2f(-1.4426950408889634f * g)); }
__device__ __forceinline__ float row_scale(const float* ssqA, const float* ssqB, int row) {
    float r = __builtin_amdgcn_rsqf(ssqA[row] * (1.0f / 1024.0f) + 1e-6f);
    if (ssqB) r *= __builtin_amdgcn_rsqf(r * r * ssqB[row] * (1.0f / 1024.0f) + 1e-6f);
    return r;
}

struct EpiSwiglu {
    static constexpr bool PERM = true, AFTER_DRAIN = false;
    static __device__ __forceinline__ void run(const f32x4 (&acc)[2][2][4][2], const Unit& u, int wr, int wc, int fr, int fq, bf16_t* H, int ldh, const float* ssqA, const float* ssqB, const float* bvec) {
        const int b = (u.pm * BM) >> 13; const int row0 = u.pm * BM + wr * 64 + fr; const int col0 = u.pn * 128 + wc * 32 + 8 * fq;
        const float* bp = bvec + ((unsigned)b * (unsigned)(2 * ldh) + (unsigned)(u.pn * BM + wc * 32 + 8 * fq));
        const f32x4 bg0 = *(const f32x4*)bp * 1.4426950408889634f, bg1 = *(const f32x4*)(bp + 4) * 1.4426950408889634f, bu0 = *(const f32x4*)(bp + HALF) * 0.6931471805599453f, bu1 = *(const f32x4*)(bp + HALF + 4) * 0.6931471805599453f;
#define SWG_(gv, uv) ((gv) * (uv) * __builtin_amdgcn_rcpf(1.0f + __builtin_amdgcn_exp2f(-(gv))))
#pragma unroll
        for (int ai = 0; ai < 2; ++ai)
#pragma unroll
            for (int m = 0; m < 4; ++m) {
                const int row = row0 + ai * HALF + m * 16; const float r = row_scale(ssqA, ssqB, row); const float rg = r * 1.4426950408889634f, ru = r * 0.6931471805599453f;
                bf16_t* p = H + ((unsigned)row * (unsigned)ldh + (unsigned)col0);
                const f32x4 g0 = acc[ai][0][m][0] * rg + bg0, g1 = acc[ai][0][m][1] * rg + bg1, u0 = acc[ai][1][m][0] * ru + bu0, u1 = acc[ai][1][m][1] * ru + bu1;
                u32x4 w;
                w.x = cvt_pk_bf16(SWG_(g0[0], u0[0]), SWG_(g0[1], u0[1]));
                w.y = cvt_pk_bf16(SWG_(g0[2], u0[2]), SWG_(g0[3], u0[3]));
                w.z = cvt_pk_bf16(SWG_(g1[0], u1[0]), SWG_(g1[1], u1[1]));
                w.w = cvt_pk_bf16(SWG_(g1[2], u1[2]), SWG_(g1[3], u1[3]));
                __builtin_nontemporal_store(w, (u32x4*)p);
                asm volatile("" ::: "memory");
            }
    }
};

struct EpiGelu {
    static constexpr bool PERM = true, AFTER_DRAIN = false;
    static __device__ __forceinline__ void run(const f32x4 (&acc)[2][2][4][2], const Unit& u, int wr, int wc, int fr, int fq, bf16_t* O, int ldc, const float* ssqA, const float* bvec) {
        const int b = (u.pm * BM) >> 13; const int row0 = u.pm * BM + wr * 64 + fr; const int col0 = u.pn * BM + wc * 32 + 8 * fq;
        const float* bp = bvec + ((unsigned)b * (unsigned)ldc + (unsigned)col0);
        f32x4 bv[2][2];
#pragma unroll
        for (int bj = 0; bj < 2; ++bj)
#pragma unroll
            for (int n = 0; n < 2; ++n) bv[bj][n] = *(const f32x4*)(bp + bj * HALF + 4 * n);
#pragma unroll
        for (int ai = 0; ai < 2; ++ai)
#pragma unroll
            for (int m = 0; m < 4; ++m) { const int row = row0 + ai * HALF + m * 16; const float r = row_scale(ssqA, nullptr, row); bf16_t* rowp = O + ((unsigned)row * (unsigned)ldc + (unsigned)col0);
#pragma unroll
                for (int bj = 0; bj < 2; ++bj) { const f32x4 v0 = acc[ai][bj][m][0] * r + bv[bj][0], v1 = acc[ai][bj][m][1] * r + bv[bj][1];
                    const f32x2 a = gelu_pk((f32x2){v0[0], v0[1]}), b2 = gelu_pk((f32x2){v0[2], v0[3]}), c = gelu_pk((f32x2){v1[0], v1[1]}), d = gelu_pk((f32x2){v1[2], v1[3]});
                    u32x4 w; w.x = cvt_pk_bf16(a.x, a.y); w.y = cvt_pk_bf16(b2.x, b2.y); w.z = cvt_pk_bf16(c.x, c.y); w.w = cvt_pk_bf16(d.x, d.y);
                    *(u32x4*)(rowp + bj * HALF) = w; }
                asm volatile("" ::: "memory"); }
    }
};

struct EpiQKV {
    static constexpr bool PERM = true, AFTER_DRAIN = false;
    static __device__ __forceinline__ void run(const f32x4 (&acc)[2][2][4][2], const Unit& u, int wr, int wc, int fr, int fq, bf16_t* Q, bf16_t* K, bf16_t* V, const float* qg, const float* kg, float qscale, const float* ssqA, const float* bvec) {
        const int b = (u.pm * BM) >> 13; const int sect = u.pn >> 2; const int row0 = u.pm * BM + wr * 64 + fr; const int colb = (u.pn & 3) * 256 + 64 * wc + 8 * fq;
        bf16_t* base = sect == 0 ? Q : (sect == 1 ? K : V);
        const float* gp = (sect == 0 ? qg : kg) + 8 * fq; const float sc = sect == 0 ? qscale : 1.0f;
        const float* bp = bvec + ((unsigned)b * 3072u + (unsigned)(u.pn * BM + wc * 32 + 8 * fq));
#pragma unroll
        for (int ai = 0; ai < 2; ++ai)
#pragma unroll
            for (int m = 0; m < 4; ++m) {
                const int row = row0 + ai * HALF + m * 16; const float r = row_scale(ssqA, nullptr, row);
                f32x4 v[2][2]; float ss = 0.f;
#pragma unroll
                for (int bj = 0; bj < 2; ++bj)
#pragma unroll
                    for (int n = 0; n < 2; ++n) { const f32x4 x = acc[ai][bj][m][n] * r + *(const f32x4*)(bp + bj * HALF + 4 * n); v[bj][n] = x; ss += (x[0] * x[0] + x[1] * x[1]) + (x[2] * x[2] + x[3] * x[3]); }
                ss = xadd<16>(ss); ss = xadd<32>(ss);
                const float rs = sect < 2 ? __builtin_amdgcn_rsqf(ss * (1.0f / 64.0f) + 1e-6f) * sc : 1.0f;
                bf16_t* rowp = base + ((unsigned)row * 1024u + (unsigned)colb);
#pragma unroll
                for (int bj = 0; bj < 2; ++bj) {
                    f32x4 v0 = v[bj][0] * rs, v1 = v[bj][1] * rs;
                    if (sect < 2) { v0 = v0 * *(const f32x4*)(gp + 32 * bj); v1 = v1 * *(const f32x4*)(gp + 32 * bj + 4); }
                    u32x4 w; w.x = cvt_pk_bf16(v0[0], v0[1]); w.y = cvt_pk_bf16(v0[2], v0[3]); w.z = cvt_pk_bf16(v1[0], v1[1]); w.w = cvt_pk_bf16(v1[2], v1[3]);
                    *(u32x4*)(rowp + 32 * bj) = w; }
                asm volatile("" ::: "memory");
            }
    }
};

template <bool LAZY, bool WG2> struct EpiResidT {
    static constexpr bool PERM = true, AFTER_DRAIN = false;
    static __device__ __forceinline__ void run(const f32x4 (&acc)[2][2][4][2], const Unit& u, int wr, int wc, int fr, int fq, const float* xin, float* xout, const float* gate, float gs, const float* lazy_ssq, const float* lazy_g,
                                                bf16_t* aout, const float* wg, const float* wsc, const float* wg2, float* ssq_out, float* ssqB_out) {
        const unsigned b = (unsigned)(u.pm * BM) >> 13; const unsigned row0 = u.pm * BM + wr * 64 + fr; const unsigned col0 = u.pn * BM + wc * 32 + 8 * fq;
        float rl[2][4], sq[2][4], sqb[2][4];
#pragma unroll
        for (int ai = 0; ai < 2; ++ai)
#pragma unroll
            for (int m = 0; m < 4; ++m) { rl[ai][m] = LAZY ? __builtin_amdgcn_rsqf(lazy_ssq[row0 + ai * HALF + m * 16] * (1.0f / 1024.0f) + 1e-6f) : 1.0f; sq[ai][m] = 0.f; sqb[ai][m] = 0.f; }
#pragma unroll
        for (int bj = 0; bj < 2; ++bj) {
            const unsigned col = col0 + bj * HALF;
            f32x4 gv[2], lg[2], wv[2], w2[2];
#pragma unroll
            for (int n = 0; n < 2; ++n) {
                gv[n] = *(const f32x4*)(gate + (b * 9216u + col + 4 * n)) * gs;
                lg[n] = (f32x4){1.f, 1.f, 1.f, 1.f}; if (LAZY) lg[n] = *(const f32x4*)(lazy_g + col + 4 * n);
                wv[n] = (f32x4){0.f, 0.f, 0.f, 0.f}; w2[n] = (f32x4){1.f, 1.f, 1.f, 1.f};
                if (aout) { wv[n] = *(const f32x4*)(wg + col + 4 * n) * (*(const f32x4*)(wsc + (b * 9216u + col + 4 * n)) + 1.0f); if (WG2) { w2[n] = *(const f32x4*)(wg2 + col + 4 * n); wv[n] = wv[n] * w2[n]; } }
            }
#pragma unroll
            for (int ai = 0; ai < 2; ++ai)
#pragma unroll
                for (int m = 0; m < 4; ++m) { const unsigned off = (row0 + ai * HALF + m * 16) * 1024u + col;
                    const f32x4 xi0 = *(const f32x4*)(xin + off), xi1 = *(const f32x4*)(xin + off + 4);
                    f32x4 xo0 = gv[0] * acc[ai][bj][m][0], xo1 = gv[1] * acc[ai][bj][m][1];
                    if (LAZY) { xo0 = xo0 + xi0 * lg[0] * rl[ai][m]; xo1 = xo1 + xi1 * lg[1] * rl[ai][m]; } else { xo0 = xo0 + xi0; xo1 = xo1 + xi1; }
                    *(f32x4*)(xout + off) = xo0; *(f32x4*)(xout + off + 4) = xo1;
                    if (aout) { const f32x4 a0 = xo0 * wv[0], a1 = xo1 * wv[1]; u32x4 w; w.x = cvt_pk_bf16(a0[0], a0[1]); w.y = cvt_pk_bf16(a0[2], a0[3]); w.z = cvt_pk_bf16(a1[0], a1[1]); w.w = cvt_pk_bf16(a1[2], a1[3]);
                        *(u32x4*)(aout + off) = w;
                        sq[ai][m] += ((xo0[0] * xo0[0] + xo0[1] * xo0[1]) + (xo0[2] * xo0[2] + xo0[3] * xo0[3])) + ((xo1[0] * xo1[0] + xo1[1] * xo1[1]) + (xo1[2] * xo1[2] + xo1[3] * xo1[3]));
                        if (WG2) { const f32x4 b0 = xo0 * w2[0], b1 = xo1 * w2[1]; sqb[ai][m] += ((b0[0] * b0[0] + b0[1] * b0[1]) + (b0[2] * b0[2] + b0[3] * b0[3])) + ((b1[0] * b1[0] + b1[1] * b1[1]) + (b1[2] * b1[2] + b1[3] * b1[3])); } }
                    if (m & 1) asm volatile("" ::: "memory"); }
        }
        if (aout) {
#pragma unroll
            for (int ai = 0; ai < 2; ++ai)
#pragma unroll
                for (int m = 0; m < 4; ++m) { float s = sq[ai][m]; s = xadd<16>(s); s = xadd<32>(s);
                    float sb = sqb[ai][m]; if (WG2) { sb = xadd<16>(sb); sb = xadd<32>(sb); }
                    if (fq == 0) { unsafeAtomicAdd(ssq_out + (row0 + ai * HALF + m * 16), s); if (WG2) unsafeAtomicAdd(ssqB_out + (row0 + ai * HALF + m * 16), sb); } }
        }
    }
};

struct EpiMulti {
    static constexpr bool PERM = true, AFTER_DRAIN = false;
    int kind; int i0; float f0;
    void* p0; void* p1; void* p2; const float* g0; const float* g1; const float* ssqA; const float* ssqB; const float* bvec;
    const float* lazy_ssq; const float* lazy_g; void* aout; const float* wg; const float* wsc; const float* wg2; float* ssq_out; float* ssqB_out;
};

#ifndef EPIMASK
#define EPIMASK 15
#endif
struct EpiLds {
    static constexpr bool PERM = true, AFTER_DRAIN = false;
    const PG8_LAS unsigned* d;
    __device__ __forceinline__ unsigned u(int i) const { return (unsigned)__builtin_amdgcn_readfirstlane((int)d[i]); }
    template <class T> __device__ __forceinline__ T* p(int i) const { const unsigned long long lo = u(i), hi = u(i + 1); return (T*)(__attribute__((address_space(1))) T*)((hi << 32) | lo); }
    __device__ __forceinline__ void operator()(const f32x4 (&acc)[2][2][4][2], const Unit& un, int wr, int wc, int fr, int fq) const {
        const int kind = (int)u(0);
        { const int t_ = opaque_tid(), w_ = __builtin_amdgcn_readfirstlane(t_ >> 6), l_ = t_ & 63; wr = w_ >> 2; wc = w_ & 3; fr = l_ & 15; fq = l_ >> 4; }
        if ((EPIMASK & 1) && kind == 0) EpiSwiglu::run(acc, un, wr, wc, fr, fq, p<bf16_t>(4), (int)u(1), p<const float>(14), p<const float>(16), p<const float>(18));
        else if ((EPIMASK & 2) && kind == 1) EpiResidT<false, false>::run(acc, un, wr, wc, fr, fq, p<const float>(10), p<float>(4), p<const float>(12), __uint_as_float(u(2)), nullptr, nullptr, p<bf16_t>(24), p<const float>(26), p<const float>(28), nullptr, p<float>(32), nullptr);
        else if ((EPIMASK & 2) && kind == 4) EpiResidT<false, true>::run(acc, un, wr, wc, fr, fq, p<const float>(10), p<float>(4), p<const float>(12), __uint_as_float(u(2)), nullptr, nullptr, p<bf16_t>(24), p<const float>(26), p<const float>(28), p<const float>(30), p<float>(32), p<float>(34));
        else if ((EPIMASK & 2) && kind == 5) EpiResidT<true, false>::run(acc, un, wr, wc, fr, fq, p<const float>(10), p<float>(4), p<const float>(12), __uint_as_float(u(2)), p<const float>(20), p<const float>(22), p<bf16_t>(24), p<const float>(26), p<const float>(28), nullptr, p<float>(32), nullptr);
        else if ((EPIMASK & 4) && kind == 2) EpiQKV::run(acc, un, wr, wc, fr, fq, p<bf16_t>(4), p<bf16_t>(6), p<bf16_t>(8), p<const float>(10), p<const float>(12), __uint_as_float(u(2)), p<const float>(14), p<const float>(18));
        else if (EPIMASK & 8) EpiGelu::run(acc, un, wr, wc, fr, fq, p<bf16_t>(4), (int)u(1), p<const float>(14), p<const float>(18));
    }
};

template <class Epi, class Sched, bool ALIGN_EPI = false, bool SP2 = false>
__device__ __forceinline__ void gemm_phase(PG8_LAS unsigned char* lds, const Gemm g, const Sched& S, const Epi& E) {
    const int tid = opaque_tid(), wid = __builtin_amdgcn_readfirstlane(tid >> 6), lane = tid & 63, wr = wid >> 2, wc = wid & 3, fr = lane & 15, fq = lane >> 4;
    const int K = g.K, nt = K / BK;
    unsigned voffA[2], voffB[2];
#pragma unroll
    for (int i = 0; i < 2; ++i) { int R, C; stage_rc(tid * 16 + i * 8192, R, C); const int Rb = Epi::PERM ? ((R & ~31) + perm32(R & 31)) : R;
        voffA[i] = (unsigned)(R * K + C) * 2u; voffB[i] = (unsigned)(Rb * K + C) * 2u; }
    const size_t kstep = (size_t)(BK * 2);
    const size_t hstep = (size_t)HALF * K * 2;
    const size_t tstep = 2 * hstep;
    const unsigned ldsw = (unsigned)wid * 1024u;
    const int aoff = lds_byte(wr * 64 + fr, fq * 8), boff = lds_byte(wc * 32 + fr, fq * 8);
#define PG8_SA(b, h) (((b) * 2 + (h)) * HTB)
#define PG8_SB(b, h) ((4 + (b) * 2 + (h)) * HTB)
#define PG8_STAGE(bufoff, gbase, voff) do { _Pragma("unroll") for (int _i = 0; _i < 2; ++_i) \
        __builtin_amdgcn_global_load_lds((const unsigned*)((const char*)(gbase) + (voff)[_i]), (PG8_LAS unsigned*)(lds + (bufoff) + ldsw + _i * 8192), 16, 0, 0); } while (0)
#define PG8_LDA(dst, b, h) do { _Pragma("unroll") for (int m = 0; m < 4; ++m) _Pragma("unroll") for (int k = 0; k < 2; ++k) dst[m][k] = *(const PG8_LAS bf16x8*)(lds + PG8_SA(b, h) + aoff + m * 2048 + k * 1024); } while (0)
#define PG8_LDB(dst, b, h) do { _Pragma("unroll") for (int n = 0; n < 2; ++n) _Pragma("unroll") for (int k = 0; k < 2; ++k) dst[n][k] = *(const PG8_LAS bf16x8*)(lds + PG8_SB(b, h) + boff + n * 2048 + k * 1024); } while (0)
#define PG8_MMA(ai, bj, At, Bt) do { __builtin_amdgcn_s_setprio(1); _Pragma("unroll") for (int m = 0; m < 4; ++m) _Pragma("unroll") for (int n = 0; n < 2; ++n) _Pragma("unroll") for (int k = 0; k < 2; ++k) \
        acc[ai][bj][m][n] = __builtin_amdgcn_mfma_f32_16x16x32_bf16(Bt[n][k], At[m][k], acc[ai][bj][m][n], 0, 0, 0); __builtin_amdgcn_s_setprio(0); } while (0)
#define PG8_WAIT_V(n) asm volatile("s_waitcnt vmcnt(" #n ")" ::: "memory")
#define PG8_WAIT_L(n) asm volatile("s_waitcnt lgkmcnt(" #n ")" ::: "memory")
#define PG8_BAR __builtin_amdgcn_s_barrier()
#define PG8_SCHED __builtin_amdgcn_sched_barrier(0)
    Unit cur, nxt; int ui = 0;
    if (!S.next(0, cur)) return;
    f32x4 acc[2][2][4][2];
#pragma unroll
    for (int a = 0; a < 2; ++a)
#pragma unroll
        for (int b = 0; b < 2; ++b)
#pragma unroll
            for (int m = 0; m < 4; ++m)
#pragma unroll
                for (int n = 0; n < 2; ++n) acc[a][b][m][n] = (f32x4){0.f, 0.f, 0.f, 0.f};
    bf16x8 At[4][2], B0[2][2], B1[2][2];
    const char* cA = (const char*)g.A + (size_t)cur.pm * tstep; const char* cB = (const char*)g.Bt + (size_t)cur.pn * tstep;
    S.a_ready(cur);
    if constexpr (SP2) {
        PG8_STAGE(PG8_SB(0, 0), cB, voffB); PG8_STAGE(PG8_SB(0, 1), cB + hstep, voffB); PG8_STAGE(PG8_SA(0, 0), cA, voffA); PG8_STAGE(PG8_SA(0, 1), cA + hstep, voffA);
        if (wr == 1) PG8_BAR;
        PG8_WAIT_V(2); PG8_BAR;
        PG8_STAGE(PG8_SB(1, 0), cB + kstep, voffB); PG8_STAGE(PG8_SA(1, 0), cA + kstep, voffA); PG8_STAGE(PG8_SB(1, 1), cB + hstep + kstep, voffB);
        PG8_WAIT_V(6); PG8_BAR;
    } else {
        PG8_STAGE(PG8_SB(0, 0), cB, voffB); PG8_STAGE(PG8_SA(0, 0), cA, voffA); PG8_STAGE(PG8_SB(0, 1), cB + hstep, voffB); PG8_STAGE(PG8_SA(0, 1), cA + hstep, voffA);
        if (wr == 1) PG8_BAR;
        PG8_WAIT_V(4); PG8_BAR;
        PG8_STAGE(PG8_SB(1, 0), cB + kstep, voffB); PG8_STAGE(PG8_SA(1, 0), cA + kstep, voffA); PG8_STAGE(PG8_SB(1, 1), cB + hstep + kstep, voffB);
        PG8_WAIT_V(6); PG8_BAR;
    }
    for (;;) {
        const bool has_next = S.next(ui + 1, nxt);
        const char* nA = has_next ? (const char*)g.A + (size_t)nxt.pm * tstep : cA; const char* nB = has_next ? (const char*)g.Bt + (size_t)nxt.pn * tstep : cB;
        for (int t = 0; t < nt; t += 2) {
            const bool last = (t == nt - 2);
            const char* a1 = cA + (size_t)(t + 1) * kstep;
            const char* a2 = last ? nA : cA + (size_t)(t + 2) * kstep; const char* b2 = last ? nB : cB + (size_t)(t + 2) * kstep;
            const char* a3 = a2 + kstep; const char* b3 = b2 + kstep;
            if (last && has_next) S.a_ready(nxt);
            if constexpr (SP2) {
            PG8_LDB(B0, 0, 0); PG8_LDB(B1, 0, 1); PG8_SCHED; PG8_LDA(At, 0, 0); PG8_STAGE(PG8_SA(1, 1), a1 + hstep, voffA);
            PG8_WAIT_V(8); PG8_WAIT_L(0); PG8_BAR; PG8_MMA(0, 0, At, B0); PG8_MMA(0, 1, At, B1); PG8_BAR; PG8_SCHED;
            PG8_LDA(At, 0, 1); PG8_STAGE(PG8_SB(0, 0), b2, voffB); PG8_STAGE(PG8_SB(0, 1), b2 + hstep, voffB); PG8_STAGE(PG8_SA(0, 0), a2, voffA);
            PG8_WAIT_V(8); PG8_WAIT_L(0); PG8_BAR; PG8_MMA(1, 0, At, B0); PG8_MMA(1, 1, At, B1); PG8_BAR; PG8_SCHED;
            PG8_LDB(B0, 1, 0); PG8_LDB(B1, 1, 1); PG8_SCHED; PG8_LDA(At, 1, 0); PG8_STAGE(PG8_SA(0, 1), a2 + hstep, voffA);
            PG8_WAIT_V(8); PG8_WAIT_L(0); PG8_BAR; PG8_MMA(0, 0, At, B0); PG8_MMA(0, 1, At, B1); PG8_BAR; PG8_SCHED;
            PG8_LDA(At, 1, 1); PG8_STAGE(PG8_SB(1, 0), b3, voffB); PG8_STAGE(PG8_SB(1, 1), b3 + hstep, voffB); PG8_STAGE(PG8_SA(1, 0), a3, voffA);
            PG8_WAIT_V(8); PG8_WAIT_L(0); PG8_BAR; PG8_MMA(1, 0, At, B0); PG8_MMA(1, 1, At, B1); PG8_BAR; PG8_SCHED;
            } else {
            PG8_LDB(B0, 0, 0); PG8_SCHED; PG8_LDA(At, 0, 0); PG8_STAGE(PG8_SA(1, 1), a1 + hstep, voffA);
            PG8_WAIT_L(8); PG8_BAR; PG8_WAIT_L(0); PG8_MMA(0, 0, At, B0); PG8_BAR; PG8_SCHED;
            PG8_LDB(B1, 0, 1); PG8_STAGE(PG8_SB(0, 0), b2, voffB);
            PG8_BAR; PG8_WAIT_L(0); PG8_MMA(0, 1, At, B1); PG8_BAR;
            PG8_LDA(At, 0, 1); PG8_STAGE(PG8_SA(0, 0), a2, voffA);
            PG8_BAR; PG8_WAIT_L(0); PG8_MMA(1, 0, At, B0); PG8_BAR; PG8_SCHED;
            PG8_STAGE(PG8_SB(0, 1), b2 + hstep, voffB);
            PG8_WAIT_V(6); PG8_BAR; PG8_MMA(1, 1, At, B1); PG8_BAR;
            PG8_LDB(B0, 1, 0); PG8_SCHED; PG8_LDA(At, 1, 0); PG8_STAGE(PG8_SA(0, 1), a2 + hstep, voffA);
            PG8_WAIT_L(8); PG8_BAR; PG8_WAIT_L(0); PG8_MMA(0, 0, At, B0); PG8_BAR; PG8_SCHED;
            PG8_LDB(B1, 1, 1); PG8_STAGE(PG8_SB(1, 0), b3, voffB);
            PG8_BAR; PG8_WAIT_L(0); PG8_MMA(0, 1, At, B1); PG8_BAR;
            PG8_LDA(At, 1, 1); PG8_STAGE(PG8_SA(1, 0), a3, voffA);
            PG8_BAR; PG8_WAIT_L(0); PG8_MMA(1, 0, At, B0); PG8_BAR; PG8_SCHED;
            PG8_STAGE(PG8_SB(1, 1), b3 + hstep, voffB);
            PG8_WAIT_V(6); PG8_BAR; PG8_MMA(1, 1, At, B1); PG8_BAR;
            }
        }
        if constexpr (ALIGN_EPI) { if (wr == 0) PG8_BAR; }
        if constexpr (!Epi::AFTER_DRAIN) { E(acc, cur, wr, wc, fr, fq); S.done(cur); }
        if (!has_next) break;
#pragma unroll
        for (int a = 0; a < 2; ++a)
#pragma unroll
            for (int b = 0; b < 2; ++b)
#pragma unroll
                for (int m = 0; m < 4; ++m)
#pragma unroll
                    for (int n = 0; n < 2; ++n) acc[a][b][m][n] = (f32x4){0.f, 0.f, 0.f, 0.f};
        cur = nxt; cA = nA; cB = nB; ++ui;
        if constexpr (ALIGN_EPI) { if (wr == 1) PG8_BAR; }
    }
    PG8_WAIT_V(0);
    if constexpr (!ALIGN_EPI) { if (wr == 0) PG8_BAR; }
    PG8_BAR;
    if constexpr (Epi::AFTER_DRAIN) { E.fused(acc, cur, wr, wc, fr, fq, lds, wid, lane); S.done(cur); }
#undef PG8_SA
#undef PG8_SB
#undef PG8_STAGE
#undef PG8_LDA
#undef PG8_LDB
#undef PG8_MMA
#undef PG8_WAIT_V
#undef PG8_WAIT_L
#undef PG8_BAR
#undef PG8_SCHED
}
}

namespace att {
#define ALDS __attribute__((address_space(3)))
typedef short bf16x8 __attribute__((ext_vector_type(8)));
typedef short s16x4 __attribute__((ext_vector_type(4)));
typedef float f32x16 __attribute__((ext_vector_type(16)));
typedef float f32x2 __attribute__((ext_vector_type(2)));
typedef unsigned u32x4 __attribute__((ext_vector_type(4)));
typedef unsigned short bf16_t;
constexpr int SEQ = 8192, DM = 1024, KVB = 64, QU = 128, NSLOT = 4, SLOT = 16384;
constexpr int L_K = 0, L_V = NSLOT * SLOT, L_LUT = 131072, L_LB = L_LUT + 512;
constexpr float LOG2E = 1.4426950408889634f, C2 = 0.125f * LOG2E;
__device__ __forceinline__ int crow(int r, int hi) { return (r & 3) + 8 * (r >> 2) + 4 * hi; }
__device__ __forceinline__ void glds16(const void* gsrc, unsigned lds_dst) { unsigned keep;
    asm volatile("s_mov_b32 %0, m0\n\ts_mov_b32 m0, %2\n\ts_nop 0\n\tglobal_load_lds_dwordx4 %1, off\n\ts_mov_b32 m0, %0" : "=&s"(keep) : "v"(gsrc), "s"(lds_dst) : "memory"); }
__device__ __forceinline__ void glds16s(unsigned voff, const void* sbase, unsigned lds_dst) { unsigned keep;
    asm volatile("s_mov_b32 %0, m0\n\ts_mov_b32 m0, %3\n\ts_nop 0\n\tglobal_load_lds_dwordx4 %1, %2\n\ts_mov_b32 m0, %0" : "=&s"(keep) : "v"(voff), "s"(sbase), "s"(lds_dst) : "memory"); }
__device__ __forceinline__ unsigned cvtpk(float lo, float hi) { typedef float f2 __attribute__((ext_vector_type(2))); typedef __bf16 b2 __attribute__((ext_vector_type(2)));
    f2 v = {lo, hi}; b2 r = __builtin_convertvector(v, b2); return __builtin_bit_cast(unsigned, r); }
__device__ __forceinline__ float bf2f(short s) { return __uint_as_float(((unsigned)(unsigned short)s) << 16); }
typedef short v4i16_t __attribute__((ext_vector_type(4)));
__device__ __forceinline__ s16x4 vtr(const ALDS unsigned char* p) { return __builtin_bit_cast(s16x4, __builtin_amdgcn_ds_read_tr16_b64_v4i16((ALDS v4i16_t*)p)); }
#define ATT_WAIT_BAR(N) asm volatile("s_waitcnt vmcnt(" #N ") lgkmcnt(0)\n\ts_barrier" ::: "memory")

__device__ __forceinline__ float attn_head_setup(ALDS unsigned char* lds, const float* relb, int h) {
    const int tid = threadIdx.x; ALDS float* lut = (ALDS float*)(lds + L_LUT);
    if (tid < 128) { const int n = tid; int bk; if (n < 16) bk = n; else { const int lg = 16 + (int)(logf((float)n / 16.0f) / logf(8.0f) * 16.0f); bk = lg < 31 ? lg : 31; }
        lut[tid] = (relb[bk * 8 + h] - relb[31 * 8 + h]) * LOG2E; }
    float bmax = -1e30f;
    for (int i = 0; i < 32; ++i) bmax = fmaxf(bmax, relb[i * 8 + h]);
    return (bmax - relb[31 * 8 + h]) * LOG2E;
}
__device__ __forceinline__ void attn_unit(int b, int h, int qb, const bf16_t* Q, const bf16_t* K, const bf16_t* V, bf16_t* O, ALDS unsigned char* lds,
                                          float bmax, float lut31, float lam, float kmaxn, const float* subg, float outscale) {
    const int tid = opaque_tid(), lane = tid & 63, r32 = lane & 31, hi = lane >> 5;
    const int wid = __builtin_amdgcn_readfirstlane(tid >> 6), comp = wid >> 2, qw = wid & 3;
    const long rowbase = (long)b * SEQ; const int q0 = qb * QU;
    const unsigned lds0 = (unsigned)(uintptr_t)lds;
    ALDS float* lut = (ALDS float*)(lds + L_LUT);
    const bf16_t* Kh = K + rowbase * DM + h * 128; const bf16_t* Vh = V + rowbase * DM + h * 128;
    const int gdma = ((lane >> 4) << 2) | (wid & 3);
    const unsigned dof0 = (unsigned)((4 * wid + (lane >> 4)) * DM + ((lane & 15) ^ gdma) * 8) * 2u, dof1 = dof0 + 32u * DM * 2u;
    const unsigned kdst = lds0 + L_K + wid * 1024, vdst = lds0 + L_V + wid * 1024;
#define ATT_DMA(t, s) do { const bf16_t* kt_ = Kh + (long)(t) * KVB * DM; const bf16_t* vt_ = Vh + (long)(t) * KVB * DM; const unsigned so_ = (unsigned)(s) * SLOT; \
        glds16s(dof0, kt_, (unsigned)__builtin_amdgcn_readfirstlane(kdst + so_)); glds16s(dof1, kt_, (unsigned)__builtin_amdgcn_readfirstlane(kdst + so_ + 8192)); \
        glds16s(dof0, vt_, (unsigned)__builtin_amdgcn_readfirstlane(vdst + so_)); glds16s(dof1, vt_, (unsigned)__builtin_amdgcn_readfirstlane(vdst + so_ + 8192)); } while (0)
    const int NT = 2 * (qb + 1);
    ATT_DMA(0, 0); ATT_DMA(1, 1); if (NT > 2) ATT_DMA(2, 2);
    const bf16_t* Qw = Q + (rowbase + q0 + qw * 32 + r32) * DM + h * 128 + comp * 64 + hi * 8;
    bf16x8 qr[4];
#pragma unroll
    for (int d0 = 0; d0 < 4; ++d0) qr[d0] = *(const bf16x8*)(Qw + d0 * 16);
    float ssq = 0.f;
#pragma unroll
    for (int d0 = 0; d0 < 4; ++d0)
#pragma unroll
        for (int i = 0; i < 8; ++i) { const float f = bf2f(qr[d0][i]); ssq += f * f; }
    ssq = xadd<32>(ssq);
    const float bound = sqrtf(ssq) * kmaxn + bmax;
    const bool needshift = __any(bound > 60.0f);
    f32x16 o[4];
#pragma unroll
    for (int d0 = 0; d0 < 4; ++d0)
#pragma unroll
        for (int r = 0; r < 16; ++r) o[d0][r] = 0.f;
    float l = 0.f;
    const int qabs = q0 + qw * 32 + r32;
    const ALDS unsigned char* kp0 = lds + L_K + 256 * r32;
    int kofs[4]; { const int gk = ((r32 & 3) << 2) | ((r32 >> 2) & 3);
#pragma unroll
        for (int d0 = 0; d0 < 4; ++d0) kofs[d0] = 16 * ((8 * comp + 2 * d0 + hi) ^ gk); }
    const ALDS unsigned char* vp0 = lds + L_V;
    int vofs[4][2]; { const int blk = (lane >> 4) & 1, q = (lane & 15) >> 2, p = lane & 3;
#pragma unroll
        for (int c = 0; c < 4; ++c)
#pragma unroll
            for (int t2 = 0; t2 < 2; ++t2) { const int gv = (q << 2) | ((hi + 2 * t2) & 3); vofs[c][t2] = 256 * (4 * hi + 8 * t2 + q) + 16 * ((4 * c + 2 * blk + (p >> 1)) ^ gv) + 8 * (p & 1); } }
    if (NT > 2) ATT_WAIT_BAR(8); else ATT_WAIT_BAR(4);
    bf16x8 kf[8];
#pragma unroll
    for (int d0 = 0; d0 < 4; ++d0) { kf[2 * d0] = *(const ALDS bf16x8*)(kp0 + kofs[d0]); kf[2 * d0 + 1] = *(const ALDS bf16x8*)(kp0 + kofs[d0] + 8192); }
    f32x16 p0, p1; u32x4 w[4]; const f32x16 zero16 = {};
#define ATT_QK(t) do { \
        p0 = __builtin_amdgcn_mfma_f32_32x32x16_bf16(kf[0], qr[0], zero16, 0, 0, 0); p1 = __builtin_amdgcn_mfma_f32_32x32x16_bf16(kf[1], qr[0], zero16, 0, 0, 0); \
        _Pragma("unroll") for (int d0 = 1; d0 < 4; ++d0) { \
            p0 = __builtin_amdgcn_mfma_f32_32x32x16_bf16(kf[2 * d0], qr[d0], p0, 0, 0, 0); \
            p1 = __builtin_amdgcn_mfma_f32_32x32x16_bf16(kf[2 * d0 + 1], qr[d0], p1, 0, 0, 0); } } while (0)
#define ATT_SYNC(t) do { if ((t) + 1 < NT) { \
            if ((t) + 2 < NT) ATT_WAIT_BAR(4); else ATT_WAIT_BAR(0);         \
            if ((t) + 3 < NT) ATT_DMA((t) + 3, ((t) + 3) & 3); \
            const ALDS unsigned char* kp_ = kp0 + (((t) + 1) & 3) * SLOT; \
            _Pragma("unroll") for (int d0 = 0; d0 < 4; ++d0) { kf[2 * d0] = *(const ALDS bf16x8*)(kp_ + kofs[d0]); kf[2 * d0 + 1] = *(const ALDS bf16x8*)(kp_ + kofs[d0] + 8192); } } } while (0)
#define ATT_EXP(t) do { if ((t) >= NT - 4) { const int relb0 = qabs - ((t) * KVB + 4 * hi); \
            _Pragma("unroll") for (int r = 0; r < 16; ++r) { \
                const int rel = relb0 - ((r & 3) + 8 * (r >> 2)); const int rel1 = rel - 32; \
                const float a0 = lut[rel < 0 ? 0 : (rel > 127 ? 127 : rel)], a1 = lut[rel1 < 0 ? 0 : (rel1 > 127 ? 127 : rel1)]; \
                p0[r] = rel < 0 ? -INFINITY : p0[r] + a0; p1[r] = rel1 < 0 ? -INFINITY : p1[r] + a1; } } \
        if (needshift) { _Pragma("unroll") for (int r = 0; r < 16; ++r) { p0[r] -= bound; p1[r] -= bound; } } \
        float sacc = 0.f; \
        _Pragma("unroll") for (int r = 0; r < 16; ++r) { p0[r] = __builtin_amdgcn_exp2f(p0[r]); p1[r] = __builtin_amdgcn_exp2f(p1[r]); sacc += p0[r] + p1[r]; } \
        l += sacc; \
        w[0] = (u32x4){cvtpk(p0[0], p0[1]), cvtpk(p0[2], p0[3]), cvtpk(p0[4], p0[5]), cvtpk(p0[6], p0[7])}; \
        w[1] = (u32x4){cvtpk(p0[8], p0[9]), cvtpk(p0[10], p0[11]), cvtpk(p0[12], p0[13]), cvtpk(p0[14], p0[15])}; \
        w[2] = (u32x4){cvtpk(p1[0], p1[1]), cvtpk(p1[2], p1[3]), cvtpk(p1[4], p1[5]), cvtpk(p1[6], p1[7])}; \
        w[3] = (u32x4){cvtpk(p1[8], p1[9]), cvtpk(p1[10], p1[11]), cvtpk(p1[12], p1[13]), cvtpk(p1[14], p1[15])}; } while (0)
#define ATT_PV(t) do { const ALDS unsigned char* vp_ = vp0 + ((t) & 3) * SLOT; \
        _Pragma("unroll") for (int ks = 0; ks < 4; ++ks) { const bf16x8 pa = __builtin_bit_cast(bf16x8, w[ks]); \
            _Pragma("unroll") for (int d0 = 0; d0 < 4; ++d0) { \
                const s16x4 vl = vtr(vp_ + vofs[d0][0] + ks * 4096), vh = vtr(vp_ + vofs[d0][1] + ks * 4096); \
                const bf16x8 vf = (bf16x8){vl[0], vl[1], vl[2], vl[3], vh[0], vh[1], vh[2], vh[3]}; \
                o[d0] = __builtin_amdgcn_mfma_f32_32x32x16_bf16(pa, vf, o[d0], 0, 0, 0); } } } while (0)
    if (wid >= 4) __builtin_amdgcn_s_setprio(1);
    if (comp == 0) {
        for (int t = 0; t < NT; ++t) { ATT_QK(t); ATT_SYNC(t); ATT_EXP(t); ATT_PV(t); }
    } else {
        ATT_QK(0); ATT_EXP(0);
        for (int t = 0; t < NT; ++t) { ATT_SYNC(t); ATT_PV(t); if (t + 1 < NT) { ATT_QK(t + 1); ATT_EXP(t + 1); } }
    }
    __builtin_amdgcn_s_setprio(0);
#undef ATT_QK
#undef ATT_SYNC
#undef ATT_EXP
#undef ATT_PV
    l = xadd<32>(l);
    ATT_WAIT_BAR(0);
    ALDS float* ob = (ALDS float*)lds + comp * (QU * 128);
    ALDS float* lb = (ALDS float*)(lds + L_LB);
    if (hi == 0) lb[comp * QU + qw * 32 + r32] = l;
#pragma unroll
    for (int d0 = 0; d0 < 4; ++d0)
#pragma unroll
        for (int r = 0; r < 16; ++r) ob[(qw * 32 + crow(r, hi)) * 128 + d0 * 32 + r32] = o[d0][r];
    ATT_WAIT_BAR(0);
    {
        typedef float f32x4_t __attribute__((ext_vector_type(4)));
        const int rsub = lane >> 4, c16 = lane & 15;
        const f32x4_t sg0 = *(const f32x4_t*)(subg + 8 * c16), sg1 = *(const f32x4_t*)(subg + 8 * c16 + 4);
#pragma unroll
        for (int it = 0; it < 4; ++it) {
            const int q = 16 * wid + 4 * it + rsub;
            const ALDS unsigned char* pa = lds + (q * 128 + 8 * c16) * 4;
            const f32x4_t a0 = *(const ALDS f32x4_t*)pa, a1 = *(const ALDS f32x4_t*)(pa + 16), b0 = *(const ALDS f32x4_t*)(pa + 65536), b1 = *(const ALDS f32x4_t*)(pa + 65536 + 16);
            const float i1 = 1.0f / lb[q], i2 = lam / lb[QU + q];
            const f32x4_t x0 = a0 * i1 - b0 * i2, x1 = a1 * i1 - b1 * i2;
            float ss = ((x0[0] * x0[0] + x0[1] * x0[1]) + (x0[2] * x0[2] + x0[3] * x0[3])) + ((x1[0] * x1[0] + x1[1] * x1[1]) + (x1[2] * x1[2] + x1[3] * x1[3]));
            ss = xadd<1>(ss); ss = xadd<2>(ss); ss = xadd<4>(ss); ss = xadd<8>(ss);
            const float rs = outscale * __builtin_amdgcn_rsqf(ss * (1.0f / 128.0f) + 1e-6f);
            const f32x4_t y0 = x0 * rs * sg0, y1 = x1 * rs * sg1;
            u32x4 w4; w4.x = cvtpk(y0[0], y0[1]); w4.y = cvtpk(y0[2], y0[3]); w4.z = cvtpk(y1[0], y1[1]); w4.w = cvtpk(y1[2], y1[3]);
            *(u32x4*)(O + (rowbase + q0 + q) * DM + h * 128 + 8 * c16) = w4;
        }
    }
    ATT_WAIT_BAR(0);
#undef ATT_DMA
}
}

#define LAS __attribute__((address_space(3)))
typedef unsigned short bf16;
typedef unsigned v4u __attribute__((ext_vector_type(4)));
typedef unsigned v2u __attribute__((ext_vector_type(2)));
typedef float f32x4 __attribute__((ext_vector_type(4)));
typedef float f32x2 __attribute__((ext_vector_type(2)));
typedef short bf16x8 __attribute__((ext_vector_type(8)));
constexpr int NWAVES = 8, NTHREADS = 512;
constexpr int M = 32768, D = 1024, F = 2816, SEQ = 8192, NB = 4, NMOD = 9 * 1024;
constexpr int LDS_BYTES = 147456;
constexpr size_t MiB = 1u << 20;
constexpr size_t WS_MOD = 0;
constexpr size_t WS_BV = 512 * 1024;
constexpr size_t WS_BAR = 960 * 1024;
constexpr size_t WS_SSQ = 1 * MiB;
constexpr size_t WS_W = 2 * MiB;
constexpr size_t W_FFN_STRIDE = 33 * MiB / 2;
constexpr size_t W_GU_BYTES = 11 * MiB;
constexpr size_t WS_WQKV = WS_W + 66 * MiB, WS_WO = WS_W + 72 * MiB, WS_WIN = WS_W + 74 * MiB, WS_WOUT = WS_W + 78 * MiB;
constexpr size_t WS_A = 83 * MiB;
constexpr size_t WS_O = 147 * MiB;
constexpr size_t WS_H = 211 * MiB;
constexpr size_t WS_Q = WS_H, WS_K = WS_H + 64 * MiB, WS_V = WS_H + 128 * MiB;
constexpr size_t WS_Z = WS_H, WS_G = WS_H + 128 * MiB;
constexpr size_t WS_END = 403 * MiB;

__device__ __forceinline__ unsigned pk2(float lo, float hi) { unsigned r; asm volatile("v_cvt_pk_bf16_f32 %0, %1, %2" : "=v"(r) : "v"(lo), "v"(hi)); return r; }
__device__ __forceinline__ float bf_lo(unsigned w) { return __uint_as_float(w << 16); }
__device__ __forceinline__ float bf_hi(unsigned w) { return __uint_as_float(w & 0xffff0000u); }
__device__ __forceinline__ void transpose_item(const float* W, int K, int N, bf16* WT, int kb, int n0, int row_base, LAS float* scr, int lane) {
    const int k0 = 64 * kb;
    f32x4 wv[8];
#pragma unroll
    for (int i = 0; i < 8; ++i) wv[i] = *(const f32x4*)(W + (size_t)(k0 + 8 * i + (lane >> 3)) * N + n0 + 4 * (lane & 7));
#pragma unroll
    for (int i = 0; i < 8; ++i) { LAS float* d = scr + (8 * i + (lane >> 3)) * 33 + 4 * (lane & 7); d[0] = wv[i].x; d[1] = wv[i].y; d[2] = wv[i].z; d[3] = wv[i].w; }
    asm volatile("s_waitcnt lgkmcnt(0)" ::: "memory");
    const int c = lane & 7;
#pragma unroll
    for (int j = 0; j < 4; ++j) { const int n = (lane >> 3) + 8 * j; const LAS float* s = scr + (8 * c) * 33 + n;
        v4u o; o.x = pk2(s[0 * 33], s[1 * 33]); o.y = pk2(s[2 * 33], s[3 * 33]); o.z = pk2(s[4 * 33], s[5 * 33]); o.w = pk2(s[6 * 33], s[7 * 33]);
        *(v4u*)(WT + (size_t)(row_base + n) * K + k0 + 8 * c) = o; }
    asm volatile("s_waitcnt lgkmcnt(0)" ::: "memory");
}

struct Params { const float* in[30]; float* out; unsigned char* ws; int ph_lo, ph_hi; };
struct PL {
    const LAS unsigned* d;
    __device__ __forceinline__ unsigned u(int i) const { return (unsigned)__builtin_amdgcn_readfirstlane((int)d[i]); }
    __device__ __forceinline__ const float* in(int i) const { const unsigned long long lo = u(2 * i), hi = u(2 * i + 1); return (const float*)(const __attribute__((address_space(1))) float*)((hi << 32) | lo); }
    __device__ __forceinline__ float* out() const { const unsigned long long lo = u(60), hi = u(61); return (float*)(__attribute__((address_space(1))) float*)((hi << 32) | lo); }
    __device__ __forceinline__ unsigned char* ws() const { const unsigned long long lo = u(62), hi = u(63); return (unsigned char*)(__attribute__((address_space(1))) unsigned char*)((hi << 32) | lo); }
};
enum { I_X = 0, I_C, I_RELB, I_ADAW, I_ADAB, I_LNF1, I_F1G, I_F1U, I_F1D, I_LNMIX, I_LNF2, I_F2G, I_F2U, I_F2D, I_LNOUT, I_WQKV, I_QN, I_KN, I_LQ1, I_LK1, I_LQ2, I_LK2, I_SUBLN, I_WO,
       I_WIN, I_SLNG, I_SLNB, I_SWS, I_SBS, I_WOUT };
constexpr int NPHASE = 17;
#ifndef PHMASK
#define PHMASK 0xff
#endif

__device__ __forceinline__ void convert_weights(const PL& P, LAS unsigned char* lds, int gw, int NGW, int wave, int lane) {
    LAS float* scr = (LAS float*)(lds + wave * 8448);
    constexpr int IT_F = 1408, IT_FFN = 12 * IT_F, IT_QKV = 1536, IT_WO = 512, IT_WIN = 1024, IT_WOUT = 512;
    constexpr int NITEMS = IT_FFN + IT_QKV + IT_WO + IT_WIN + IT_WOUT;
    for (int it = gw; it < NITEMS; it += NGW) {
        int r = it;
        if (r < IT_FFN) {
            const int mi = r / IT_F, ri = r % IT_F; const int l = mi / 6, w = mi % 6; const int f = w / 3, kind = w % 3;
            bf16* gu = (bf16*)(P.ws() + WS_W + (size_t)(l * 2 + f) * W_FFN_STRIDE); bf16* dn = (bf16*)((unsigned char*)gu + W_GU_BYTES);
            if (kind < 2) { const float* W = (f == 0 ? (kind == 0 ? P.in(I_F1G) : P.in(I_F1U)) : (kind == 0 ? P.in(I_F2G) : P.in(I_F2U))) + (size_t)l * D * F; const int nblk = F / 32, kb = ri / nblk, n0 = 32 * (ri % nblk);
                transpose_item(W, D, F, gu, kb, n0, 256 * (n0 >> 7) + (n0 & 127) + 128 * kind, scr, lane); }
            else { const float* W = (f == 0 ? P.in(I_F1D) : P.in(I_F2D)) + (size_t)l * F * D; const int nblk = D / 32, kb = ri / nblk, n0 = 32 * (ri % nblk);
                transpose_item(W, F, D, dn, kb, n0, n0, scr, lane); }
            continue;
        }
        r -= IT_FFN;
        if (r < IT_QKV) { const int nblk = 3072 / 32, kb = r / nblk, n0 = 32 * (r % nblk); const int pn = n0 >> 8, rr = n0 & 255, wc = rr >> 6, bj = (rr >> 5) & 1;
            transpose_item(P.in(I_WQKV), D, 3072, (bf16*)(P.ws() + WS_WQKV), kb, n0, 256 * pn + 128 * bj + 32 * wc, scr, lane); continue; }
        r -= IT_QKV;
        if (r < IT_WO) { const int nblk = D / 32, kb = r / nblk, n0 = 32 * (r % nblk); transpose_item(P.in(I_WO), D, D, (bf16*)(P.ws() + WS_WO), kb, n0, n0, scr, lane); continue; }
        r -= IT_WO;
        if (r < IT_WIN) { const int nblk = 2048 / 32, kb = r / nblk, n0 = 32 * (r % nblk); transpose_item(P.in(I_WIN), D, 2048, (bf16*)(P.ws() + WS_WIN), kb, n0, n0, scr, lane); continue; }
        r -= IT_WIN;
        { const int nblk = D / 32, kb = r / nblk, n0 = 32 * (r % nblk); transpose_item(P.in(I_WOUT), D, D, (bf16*)(P.ws() + WS_WOUT), kb, n0, n0, scr, lane); }
    }
}

__device__ __forceinline__ void ada_phase(const PL& P, LAS unsigned char* lds, int vcu, int G, int tid, int wave, int lane) {
    if (vcu >= 144) return;
    LAS float* cact = (LAS float*)(lds + 69632);
    LAS float* red = (LAS float*)(lds + 86016);
    const float* c = P.in(I_C);
    for (int i = tid; i < 4096; i += NTHREADS) { const float x = c[i]; cact[i] = x / (1.0f + expf(-x)); }
    __syncthreads();
    float* mod = (float*)(P.ws() + WS_MOD);
    for (int item = vcu; item < 144; item += G) {
        const int l = item / 72, jb = item % 72;
        const float* W = P.in(I_ADAW) + (size_t)l * D * NMOD + jb * 128 + 2 * lane;
        float acc[4][2];
#pragma unroll
        for (int b = 0; b < 4; ++b) { acc[b][0] = 0.f; acc[b][1] = 0.f; }
#pragma unroll 8
        for (int kk = 0; kk < 128; ++kk) { const int k = wave * 128 + kk; const f32x2 w = *(const f32x2*)(W + (size_t)k * NMOD);
#pragma unroll
            for (int b = 0; b < 4; ++b) { const float cv = cact[b * 1024 + k]; acc[b][0] += cv * w.x; acc[b][1] += cv * w.y; } }
#pragma unroll
        for (int b = 0; b < 4; ++b) { red[(wave * 4 + b) * 128 + 2 * lane] = acc[b][0]; red[(wave * 4 + b) * 128 + 2 * lane + 1] = acc[b][1]; }
        __syncthreads();
        { const int b = tid >> 7, col = tid & 127; float s = 0.f;
#pragma unroll
            for (int w = 0; w < 8; ++w) s += red[(w * 4 + b) * 128 + col];
            mod[(size_t)(l * 4 + b) * NMOD + jb * 128 + col] = s + P.in(I_ADAB)[(size_t)l * NMOD + jb * 128 + col]; }
        __syncthreads();
    }
}

__device__ __forceinline__ void norm_phase(const float* xsrc, float* xdst, const float* gout, bf16* a, const float* g, const float* sh, const float* sc, int mode, int gw, int NGW, int lane) {
    for (int row = gw; row < M; row += NGW) {
        const int b = row >> 13;
        const f32x4* xr = (const f32x4*)(xsrc + (size_t)row * D) + lane;
        f32x4 v[4];
#pragma unroll
        for (int j = 0; j < 4; ++j) v[j] = xr[64 * j];
        if (mode >= 1) {
            float ss = 0.f;
#pragma unroll
            for (int j = 0; j < 4; ++j) ss += (v[j].x * v[j].x + v[j].y * v[j].y) + (v[j].z * v[j].z + v[j].w * v[j].w);
            const float rs = 1.0f / sqrtf(wave_sum(ss) * (1.0f / D) + 1e-6f);
            f32x4* xo = (f32x4*)(xdst + (size_t)row * D) + lane;
#pragma unroll
            for (int j = 0; j < 4; ++j) { const f32x4 gg = *((const f32x4*)gout + lane + 64 * j); v[j] = v[j] * rs * gg; xo[64 * j] = v[j]; }
        }
        if (mode != 2) {
            float ss = 0.f;
#pragma unroll
            for (int j = 0; j < 4; ++j) ss += (v[j].x * v[j].x + v[j].y * v[j].y) + (v[j].z * v[j].z + v[j].w * v[j].w);
            const float rs = 1.0f / sqrtf(wave_sum(ss) * (1.0f / D) + 1e-6f);
            v2u* ao = (v2u*)(a + (size_t)row * D) + lane;
#pragma unroll
            for (int j = 0; j < 4; ++j) { const f32x4 gg = *((const f32x4*)g + lane + 64 * j), s4 = *((const f32x4*)(sh + (size_t)b * NMOD) + lane + 64 * j), c4 = *((const f32x4*)(sc + (size_t)b * NMOD) + lane + 64 * j);
                const f32x4 y = (v[j] * rs * gg) * (c4 + 1.0f) + s4; v2u w; w.x = pk2(y.x, y.y); w.y = pk2(y.z, y.w); ao[64 * j] = w; }
        }
    }
}

__device__ __forceinline__ void prep_phase(const PL& P, int gw, int NGW, int lane) {
    unsigned char* ws = P.ws(); const float* mod = (const float*)(ws + WS_MOD);
    { const float* x = P.in(I_X); bf16* a = (bf16*)(ws + WS_A); float* ssq0 = (float*)(ws + WS_SSQ); const float* g = P.in(I_LNF1); const float* sc = mod + 1024;
      for (int row0 = gw; row0 < M; row0 += 2 * NGW) {
          f32x4 v[2][4]; float ss[2];
#pragma unroll
          for (int k = 0; k < 2; ++k) { const int row = row0 + k * NGW; const f32x4* xr = (const f32x4*)(x + (size_t)row * D) + lane;
#pragma unroll
              for (int j = 0; j < 4; ++j) v[k][j] = xr[64 * j]; }
#pragma unroll
          for (int k = 0; k < 2; ++k) { ss[k] = 0.f;
#pragma unroll
              for (int j = 0; j < 4; ++j) ss[k] += (v[k][j].x * v[k][j].x + v[k][j].y * v[k][j].y) + (v[k][j].z * v[k][j].z + v[k][j].w * v[k][j].w); }
          ss[0] = xadd<1>(ss[0]); ss[1] = xadd<1>(ss[1]); ss[0] = xadd<2>(ss[0]); ss[1] = xadd<2>(ss[1]); ss[0] = xadd<4>(ss[0]); ss[1] = xadd<4>(ss[1]);
          ss[0] = xadd<8>(ss[0]); ss[1] = xadd<8>(ss[1]); ss[0] = xadd<16>(ss[0]); ss[1] = xadd<16>(ss[1]); ss[0] = xadd<32>(ss[0]); ss[1] = xadd<32>(ss[1]);
#pragma unroll
          for (int k = 0; k < 2; ++k) { const int row = row0 + k * NGW; const int b = row >> 13; if (lane == 0) ssq0[row] = ss[k];
              v2u* ao = (v2u*)(a + (size_t)row * D) + lane;
#pragma unroll
              for (int j = 0; j < 4; ++j) { const f32x4 gg = *((const f32x4*)g + lane + 64 * j), c4 = *((const f32x4*)(sc + (size_t)b * NMOD) + lane + 64 * j);
                  const f32x4 y = v[k][j] * gg * (c4 + 1.0f); v2u w; w.x = pk2(y.x, y.y); w.y = pk2(y.z, y.w); ao[64 * j] = w; } } } }
    float* bvec = (float*)(ws + WS_BV);
    for (int it = gw; it < 27648; it += NGW) {
        int n = it, N = 5632, boff = 0, shoff = 0; const bf16* W = (const bf16*)(ws + WS_W);
        if (n >= 22016) { n -= 22016; W = (const bf16*)(ws + WS_W + 3 * W_FFN_STRIDE); boff = 88064; shoff = 4 * NMOD + 6144; }
        else if (n >= 19968) { n -= 19968; W = (const bf16*)(ws + WS_WIN); N = 2048; boff = 79872; shoff = 4 * NMOD + 3072; }
        else if (n >= 14336) { n -= 14336; W = (const bf16*)(ws + WS_W + 2 * W_FFN_STRIDE); boff = 57344; shoff = 4 * NMOD; }
        else if (n >= 8704) { n -= 8704; W = (const bf16*)(ws + WS_W + 1 * W_FFN_STRIDE); boff = 34816; shoff = 6144; }
        else if (n >= 5632) { n -= 5632; W = (const bf16*)(ws + WS_WQKV); N = 3072; boff = 22528; shoff = 3072; }
        const v4u* wp = (const v4u*)(W + (size_t)n * D + lane * 16); const v4u wa = wp[0], wb = wp[1];
        const float w[16] = {bf_lo(wa.x), bf_hi(wa.x), bf_lo(wa.y), bf_hi(wa.y), bf_lo(wa.z), bf_hi(wa.z), bf_lo(wa.w), bf_hi(wa.w), bf_lo(wb.x), bf_hi(wb.x), bf_lo(wb.y), bf_hi(wb.y), bf_lo(wb.z), bf_hi(wb.z), bf_lo(wb.w), bf_hi(wb.w)};
#pragma unroll
        for (int b = 0; b < 4; ++b) { const f32x4* sp = (const f32x4*)(mod + shoff + (size_t)b * NMOD + lane * 16); float d = 0.f;
#pragma unroll
            for (int q = 0; q < 4; ++q) { const f32x4 s4 = sp[q]; d += (s4.x * w[4 * q] + s4.y * w[4 * q + 1]) + (s4.z * w[4 * q + 2] + s4.w * w[4 * q + 3]); }
            d = wave_sum(d); if (lane == 0) bvec[boff + b * N + n] = d; }
    }
}

__device__ __forceinline__ void sgu_phase(const PL& P, LAS unsigned char* lds, int vcu, int G, int tid, int wave, int lane) {
    constexpr int ST = 136;
    LAS bf16* Wt = (LAS bf16*)lds; LAS bf16* Vt = (LAS bf16*)(lds + 34816); LAS float* st = (LAS float*)(lds + 69632);
    const bf16* Z = (const bf16*)(P.ws() + WS_Z); bf16* Gt = (bf16*)(P.ws() + WS_G);
    const float* wsp = P.in(I_SWS); const float* bs = P.in(I_SBS); const float* lng = P.in(I_SLNG); const float* lnb = P.in(I_SLNB);
    const int fr = lane & 15, fq = lane >> 4;
    for (int unit = vcu; unit < 256; unit += G) {
        const size_t r0 = (size_t)unit * 128;
        {
            const int rsub = lane >> 4, c16 = lane & 15;
#pragma unroll
            for (int it = 0; it < 4; ++it) { const int row = 16 * wave + 4 * it + rsub; const v4u* p = (const v4u*)(Z + (r0 + row) * 2048 + 1024 + c16 * 64);
                float s1 = 0.f, s2 = 0.f;
#pragma unroll
                for (int j = 0; j < 8; ++j) { const v4u a = p[j];
                    const float x[8] = {bf_lo(a.x), bf_hi(a.x), bf_lo(a.y), bf_hi(a.y), bf_lo(a.z), bf_hi(a.z), bf_lo(a.w), bf_hi(a.w)};
#pragma unroll
                    for (int k = 0; k < 8; ++k) { s1 += x[k]; s2 += x[k] * x[k]; } }
                s1 = xadd<1>(s1); s2 = xadd<1>(s2); s1 = xadd<2>(s1); s2 = xadd<2>(s2); s1 = xadd<4>(s1); s2 = xadd<4>(s2); s1 = xadd<8>(s1); s2 = xadd<8>(s2);
                const float mean = s1 * (1.0f / 1024.0f); const float var = fmaxf(s2 * (1.0f / 1024.0f) - mean * mean, 0.f);
                if (c16 == 0) { st[row * 2] = mean; st[row * 2 + 1] = 1.0f / sqrtf(var + 1e-6f); } }
        }
        __syncthreads();
        for (int g = 0; g < 8; ++g) {
#pragma unroll
            for (int it = 0; it < 4; ++it) { const int idx = it * NTHREADS + tid, t = idx >> 4, s0 = (idx & 15) * 8; const float* wp = wsp + ((size_t)g * 128 + t) * 128 + s0;
                const f32x4 a = *(const f32x4*)wp, b = *(const f32x4*)(wp + 4); float w[8] = {a.x, a.y, a.z, a.w, b.x, b.y, b.z, b.w};
#pragma unroll
                for (int k = 0; k < 8; ++k) w[k] = (s0 + k <= t) ? w[k] : 0.f;
                v4u o; o.x = pk2(w[0], w[1]); o.y = pk2(w[2], w[3]); o.z = pk2(w[4], w[5]); o.w = pk2(w[6], w[7]);
                *(LAS v4u*)(Wt + t * ST + s0) = o; }
#pragma unroll
            for (int it = 0; it < 4; ++it) { const int idx = it * NTHREADS + tid, s = idx & 127, cc = idx >> 7;
                const v4u a = *(const v4u*)(Z + (r0 + s) * 2048 + 1024 + g * 128 + cc * 8);
                const float mean = st[s * 2], rstd = st[s * 2 + 1];
                float x[8] = {bf_lo(a.x), bf_hi(a.x), bf_lo(a.y), bf_hi(a.y), bf_lo(a.z), bf_hi(a.z), bf_lo(a.w), bf_hi(a.w)};
                const f32x4 g0 = *(const f32x4*)(lng + g * 128 + cc * 8), g1 = *(const f32x4*)(lng + g * 128 + cc * 8 + 4), b0 = *(const f32x4*)(lnb + g * 128 + cc * 8), b1 = *(const f32x4*)(lnb + g * 128 + cc * 8 + 4);
                const float gg[8] = {g0.x, g0.y, g0.z, g0.w, g1.x, g1.y, g1.z, g1.w}, bb[8] = {b0.x, b0.y, b0.z, b0.w, b1.x, b1.y, b1.z, b1.w};
#pragma unroll
                for (int k = 0; k < 8; k += 2) { const unsigned w = pk2((x[k] - mean) * rstd * gg[k] + bb[k], (x[k + 1] - mean) * rstd * gg[k + 1] + bb[k + 1]);
                    Vt[(cc * 8 + k) * ST + s] = (bf16)(w & 0xffffu); Vt[(cc * 8 + k + 1) * ST + s] = (bf16)(w >> 16); } }
            __syncthreads();
            f32x4 acc[8];
#pragma unroll
            for (int n = 0; n < 8; ++n) acc[n] = (f32x4){0.f, 0.f, 0.f, 0.f};
            const int nks = (16 * wave + 15) / 32 + 1;
            for (int ks = 0; ks < nks; ++ks) {
                const bf16x8 af = *(const LAS bf16x8*)(Wt + (16 * wave + fr) * ST + 32 * ks + 8 * fq);
#pragma unroll
                for (int n = 0; n < 8; ++n) { const bf16x8 bfv = *(const LAS bf16x8*)(Vt + (16 * n + fr) * ST + 32 * ks + 8 * fq);
                    acc[n] = __builtin_amdgcn_mfma_f32_16x16x32_bf16(bfv, af, acc[n], 0, 0, 0); }
            }
            const int t = 16 * wave + fr; const float bias = bs[g * 128 + t]; const size_t row = r0 + t;
#pragma unroll
            for (int n = 0; n < 8; ++n) { const int col = g * 128 + 16 * n + 4 * fq; const v2u uu = *(const v2u*)(Z + row * 2048 + col);
                v2u w; w.x = pk2(bf_lo(uu.x) * (acc[n][0] + bias), bf_hi(uu.x) * (acc[n][1] + bias)); w.y = pk2(bf_lo(uu.y) * (acc[n][2] + bias), bf_hi(uu.y) * (acc[n][3] + bias));
                *(v2u*)(Gt + row * 1024 + col) = w; }
            __syncthreads();
        }
    }
}

#define XB_TMO      128
#define XB_XCNT(j)  (256  + 64 * (j))
#define XB_XSUB(j)  (1280 + 64 * (j))
#define XB_XGEN(j)  (2304 + 64 * (j))
#define XB_TOP      3328
#define XB_TOPGEN   3392
#define XCD_BAR_WORDS 3456
#define XB_SPIN_CAP (1u << 18)

__device__ __forceinline__ unsigned xb_ld(unsigned* p)              { return __hip_atomic_load(p, __ATOMIC_RELAXED, __HIP_MEMORY_SCOPE_AGENT); }
__device__ __forceinline__ unsigned xb_add(unsigned* p, unsigned v) { return __hip_atomic_fetch_add(p, v, __ATOMIC_RELAXED, __HIP_MEMORY_SCOPE_AGENT); }
__device__ __forceinline__ unsigned xb_xcc_id() { return (unsigned)__builtin_amdgcn_s_getreg((3 << 11) | 20) & 0xFu; }
#define XB_SPIN(cond, bar) do { unsigned _sp = 0; while (cond) { __builtin_amdgcn_s_sleep(1); \
    if ((++_sp & 255u) == 0u) { if (xb_ld(&(bar)[XB_TMO])) break; if (_sp > XB_SPIN_CAP) { atomicAdd(&(bar)[XB_TMO], 1u); break; } } } } while (0)

struct XcdBarrier {
    unsigned* bar; unsigned x;
    volatile LAS unsigned* st;
};

__device__ __forceinline__ XcdBarrier xcd_barrier_post(unsigned* bar, volatile LAS unsigned* st) {
    XcdBarrier b; b.bar = bar; b.x = xb_xcc_id(); b.st = st;
    if (threadIdx.x == 0) (void)xb_add(&bar[XB_XCNT(b.x)], 1u);
    return b;
}
__device__ __forceinline__ void xcd_barrier_complete(unsigned* bar, unsigned x, unsigned& nloc, unsigned& nx) {
    const unsigned G = gridDim.x * gridDim.y * gridDim.z;
    unsigned sum, cnt, mine, sp = 0u;
    for (;;) {
        sum = 0u; cnt = 0u; mine = 0u;
#pragma unroll
        for (unsigned j = 0; j < 16; ++j) { const unsigned c = xb_ld(&bar[XB_XCNT(j)]); sum += c; cnt += (c > 0u) ? 1u : 0u; mine = (j == x) ? c : mine; }
        if (sum == G) break;
        __builtin_amdgcn_s_sleep(1);
        if ((++sp & 255u) == 0u) { if (xb_ld(&bar[XB_TMO])) break; if (sp > XB_SPIN_CAP) { atomicAdd(&bar[XB_TMO], 1u); break; } }
    }
    nloc = mine > 0u ? mine : 1u; nx = cnt > 0u ? cnt : 1u;
}

__device__ __forceinline__ void xcd_barrier(const XcdBarrier& b) {
    asm volatile("s_waitcnt vmcnt(0)" ::: "memory");
    __syncthreads();
    if (threadIdx.x == 0) {
        unsigned* bar = b.bar;
        __builtin_amdgcn_s_waitcnt(0);
        unsigned nloc = b.st[0], nx = b.st[1];
        if (nloc == 0u) { xcd_barrier_complete(bar, b.x, nloc, nx); b.st[0] = nloc; b.st[1] = nx; }
        const unsigned old = xb_add(&bar[XB_XSUB(b.x)], 1u);
        const unsigned gen = old / nloc;
        if (old + 1u == (gen + 1u) * nloc) {
            __builtin_amdgcn_fence(__ATOMIC_RELEASE, "agent");
            asm volatile("s_waitcnt vmcnt(0)" ::: "memory");
            const unsigned og = xb_add(&bar[XB_TOP], 1u);
            const unsigned tg = og / nx;
            if (og + 1u == (tg + 1u) * nx) xb_add(&bar[XB_TOPGEN], 1u);
            else XB_SPIN(xb_ld(&bar[XB_TOPGEN]) == tg, bar);
            __builtin_amdgcn_fence(__ATOMIC_ACQUIRE, "agent");
            xb_add(&bar[XB_XGEN(b.x)], 1u);
            asm volatile("s_waitcnt vmcnt(0)" ::: "memory");
        } else {
            XB_SPIN(xb_ld(&bar[XB_XGEN(b.x)]) == gen, bar);
            __builtin_amdgcn_fence(__ATOMIC_ACQUIRE, "agent");
            asm volatile("s_waitcnt vmcnt(0)" ::: "memory");
        }
    }
    __syncthreads();
}

template <class Epi> __device__ __forceinline__ void run_gemm(LAS unsigned char* lds, const bf16* A, const bf16* Bt, int N, int K, int G, const Epi& E) {
    pg8::Gemm g{A, Bt, M, N, K}; pg8::StaticOrder S; S.init(M, N, G, (int)blockIdx.x);
    pg8::gemm_phase<Epi, pg8::StaticOrder, true, true>(lds, g, S, E);
}

__global__ void __launch_bounds__(NTHREADS, 2) mega_fwd(Params KP) {
    extern __shared__ __attribute__((aligned(16))) unsigned char lds_raw[];
    LAS unsigned char* lds = (LAS unsigned char*)lds_raw;
    cg::grid_group grid = cg::this_grid();
    { LAS unsigned* pd = (LAS unsigned*)(lds + 133376);
      if (threadIdx.x == 0) { ((LAS unsigned*)(lds + 133888))[0] = 0u; ((LAS unsigned*)(lds + 133888))[1] = 0u;
#pragma unroll
          for (int i = 0; i < 30; ++i) { const unsigned long long a = (unsigned long long)(uintptr_t)KP.in[i]; pd[2 * i] = (unsigned)a; pd[2 * i + 1] = (unsigned)(a >> 32); }
          { const unsigned long long a = (unsigned long long)(uintptr_t)KP.out; pd[60] = (unsigned)a; pd[61] = (unsigned)(a >> 32); }
          { const unsigned long long a = (unsigned long long)(uintptr_t)KP.ws; pd[62] = (unsigned)a; pd[63] = (unsigned)(a >> 32); } }
      __syncthreads(); }
    const PL P{(const LAS unsigned*)(lds + 133376)};
    (void)xcd_barrier_post((unsigned*)(KP.ws + WS_BAR), (volatile LAS unsigned*)(lds + 133888));
    const int ph_lo = KP.ph_lo, ph_hi = KP.ph_hi;
    const int G0 = gridDim.x, bx = blockIdx.x;
    const int vcu0 = (G0 % 8 == 0) ? (bx % 8) * (G0 / 8) + bx / 8 : bx;
#ifndef REPEAT_PH
#define REPEAT_PH -1
#endif
    for (int pp = ph_lo; pp < ph_hi + (REPEAT_PH >= 0 ? 1 : 0); ++pp) {
        const int ph = (REPEAT_PH >= 0 && pp > REPEAT_PH) ? pp - 1 : pp;
        int vcu = vcu0, G = G0; asm volatile("" : "+s"(vcu), "+s"(G));
        const int NGW = G * NWAVES;
        const int tid = opaque_tid(), lane = tid & 63, wave = __builtin_amdgcn_readfirstlane(tid >> 6); const int gw = vcu * NWAVES + wave;
        unsigned char* ws = P.ws(); asm volatile("" : "+s"(ws));
        float* mod = (float*)(ws + WS_MOD); float* ssq = (float*)(ws + WS_SSQ); const float* bvec = (const float*)(ws + WS_BV);
        bf16* Abuf = (bf16*)(ws + WS_A); bf16* Hbuf = (bf16*)(ws + WS_H);
        float* out = P.out();
        int type = 0, l = 0, f = 0, sA = 0, sB = -1, bvo = 0, modoff = 0;
        const float* xsrc = out; const bf16* rA = Hbuf; const bf16* rB = nullptr; int rK = F; float rgs = 0.5f;
        int so = -1, sob = -1, wsc_off = 0, lazy = -1; const float* wg = nullptr; const float* wg2 = nullptr;
        switch (ph) {
            case 0: type = 0; break;
            case 1: type = 1; break;
            case 2: type = 2; l = 0; f = 0; sA = 0; bvo = 0; break;
            case 3: type = 3; l = 0; rB = (const bf16*)(ws + WS_W + 0 * W_FFN_STRIDE + W_GU_BYTES); modoff = 2048; xsrc = P.in(I_X); so = 1; wg = P.in(I_LNMIX); wsc_off = 4096; break;
            case 4: type = 4; sA = 1; bvo = 22528; break;
            case 5: type = 5; break;
            case 6: type = 3; l = 0; rA = (const bf16*)(ws + WS_O); rB = (const bf16*)(ws + WS_WO); rK = D; rgs = 1.0f; modoff = 5120; so = 2; wg = P.in(I_LNF2); wsc_off = 7168; break;
            case 7: type = 2; l = 0; f = 1; sA = 2; bvo = 34816; break;
            case 8: type = 3; l = 0; rB = (const bf16*)(ws + WS_W + 1 * W_FFN_STRIDE + W_GU_BYTES); modoff = 8192; so = 3; sob = 4; wg = P.in(I_LNF1) + D; wsc_off = 4 * NMOD + 1024; wg2 = P.in(I_LNOUT); break;
            case 9: type = 2; l = 1; f = 0; sA = 3; sB = 4; bvo = 57344; break;
            case 10: type = 3; l = 1; rB = (const bf16*)(ws + WS_W + 2 * W_FFN_STRIDE + W_GU_BYTES); modoff = 2048; lazy = 3; so = 5; wg = P.in(I_LNMIX) + D; wsc_off = 4 * NMOD + 4096; break;
            case 11: type = 6; sA = 5; bvo = 79872; break;
            case 12: type = 7; break;
            case 13: type = 3; l = 1; rA = (const bf16*)(ws + WS_G); rB = (const bf16*)(ws + WS_WOUT); rK = D; rgs = 1.0f; modoff = 5120; so = 6; wg = P.in(I_LNF2) + D; wsc_off = 4 * NMOD + 7168; break;
            case 14: type = 2; l = 1; f = 1; sA = 6; bvo = 88064; break;
            case 15: type = 3; l = 1; rB = (const bf16*)(ws + WS_W + 3 * W_FFN_STRIDE + W_GU_BYTES); modoff = 8192; break;
            default: type = 8; break;
        }
        const float* modl = mod + (size_t)l * 4 * NMOD;
        if ((PHMASK & 1) && type == 0) {
            for (int i = gw * 64 + lane; i < 7 * M; i += NGW * 64) ssq[i] = 0.f;
            convert_weights(P, lds, gw, NGW, wave, lane);
            ada_phase(P, lds, vcu, G, tid, wave, lane);
        } else if ((PHMASK & 2) && type == 1) {
            prep_phase(P, gw, NGW, lane);
        } else if ((PHMASK & 2) && type == 8) {
            norm_phase(out, out, P.in(I_LNOUT) + D, Abuf, nullptr, nullptr, nullptr, 2, gw, NGW, lane);
        } else if ((PHMASK & 32) && type == 5) {
            const float p1 = wave_sum(P.in(I_LQ1)[lane] * P.in(I_LK1)[lane]), p2 = wave_sum(P.in(I_LQ2)[lane] * P.in(I_LK2)[lane]);
            const float lam = expf(p1) - expf(p2) + 0.2f;
            const float kmaxn = wave_max(fabsf(P.in(I_KN)[lane])) * 8.0f * 1.02f;
            for (int v = vcu; v < 256; v += G) {
                const int bh = v >> 3, j = v & 7;
                const float* relb = P.in(I_RELB); const float bmax = att::attn_head_setup(lds, relb, bh & 7); const float lut31 = relb[31 * 8 + (bh & 7)] * att::LOG2E;
                for (int i = 0; i < 8; ++i) { const int s = j + 8 * (i >> 1); const int qb = (i & 1) ? 63 - s : s;
                    att::attn_unit(bh >> 3, bh & 7, qb, (const bf16*)(ws + WS_Q), (const bf16*)(ws + WS_K), (const bf16*)(ws + WS_V), (bf16*)(ws + WS_O), lds, bmax, lut31, lam, kmaxn, P.in(I_SUBLN), 0.8f); }
            }
        } else if ((PHMASK & 4) && (type == 2 || type == 3 || type == 4 || type == 6)) {
            pg8::EpiMulti E{}; const bf16* gA = Abuf; const bf16* gB = nullptr; int gN = D, gK = D;
            E.ssqA = ssq + (size_t)sA * M; E.ssqB = sB >= 0 ? ssq + (size_t)sB * M : nullptr; E.bvec = bvec + bvo;
            if (type == 2) { E.kind = 0; E.p0 = Hbuf; E.i0 = F; gB = (const bf16*)(ws + WS_W + (size_t)(l * 2 + f) * W_FFN_STRIDE); gN = 2 * F; }
            else if (type == 3) { E.kind = lazy >= 0 ? 5 : (wg2 ? 4 : 1); E.g0 = xsrc; E.p0 = out; E.g1 = modl + modoff; E.f0 = rgs; gA = rA; gB = rB; gK = rK;
                E.lazy_ssq = lazy >= 0 ? ssq + (size_t)lazy * M : nullptr; E.lazy_g = P.in(I_LNOUT);
                E.aout = so >= 0 ? (void*)Abuf : nullptr; E.wg = wg; E.wsc = mod + wsc_off; E.wg2 = wg2; E.ssq_out = ssq + (size_t)(so >= 0 ? so : 0) * M; E.ssqB_out = ssq + (size_t)(sob >= 0 ? sob : 0) * M; }
            else if (type == 4) { E.kind = 2; E.p0 = ws + WS_Q; E.p1 = ws + WS_K; E.p2 = ws + WS_V; E.g0 = P.in(I_QN); E.g1 = P.in(I_KN); E.f0 = att::C2; gB = (const bf16*)(ws + WS_WQKV); gN = 3 * D; }
            else { E.kind = 3; E.p0 = ws + WS_Z; E.i0 = 2048; gB = (const bf16*)(ws + WS_WIN); gN = 2048; }
            { LAS unsigned* dd = (LAS unsigned*)(lds + 133120);
              if (tid == 0) {
#define DW(i, v) dd[i] = (unsigned)(v)
#define DP(i, ptr) do { const unsigned long long a_ = (unsigned long long)(uintptr_t)(ptr); dd[i] = (unsigned)a_; dd[(i) + 1] = (unsigned)(a_ >> 32); } while (0)
                  DW(0, E.kind); DW(1, E.i0); DW(2, __float_as_uint(E.f0)); DP(4, E.p0); DP(6, E.p1); DP(8, E.p2); DP(10, E.g0); DP(12, E.g1); DP(14, E.ssqA); DP(16, E.ssqB); DP(18, E.bvec);
                  DP(20, E.lazy_ssq); DP(22, E.lazy_g); DP(24, E.aout); DP(26, E.wg); DP(28, E.wsc); DP(30, E.wg2); DP(32, E.ssq_out); DP(34, E.ssqB_out);
#undef DW
#undef DP
              }
              __syncthreads();
              pg8::EpiLds EL{(const LAS unsigned*)dd};
              run_gemm(lds, gA, gB, gN, gK, G, EL); }
        } else if ((PHMASK & 128) && type == 7) {
            sgu_phase(P, lds, vcu, G, tid, wave, lane);
        }
        if (pp + 1 < ph_hi + (REPEAT_PH >= 0 ? 1 : 0)) { if (ph_lo < 0) grid.sync(); else { XcdBarrier xb_; xb_.bar = (unsigned*)(ws + WS_BAR); xb_.x = xb_xcc_id(); xb_.st = (volatile LAS unsigned*)(lds + 133888); xcd_barrier(xb_); } }
    }
}

#ifndef N_LAUNCH_MODE
#define N_LAUNCH_MODE 0
#endif
extern "C" void kernel_launch(void* const* d_in, const int* in_sizes, int n_in, void* d_out, int out_size, void* d_ws, size_t ws_size, hipStream_t stream) {
    static int grid = 0;
    if (grid == 0) {
        if (n_in != 30 || out_size != M * D || ws_size < WS_END) { fprintf(stderr, "kernel_launch: unexpected problem (n_in %d out %d ws %zu)\n", n_in, out_size, ws_size); grid = -1; return; }
        int dev = 0, cus = 0, per_cu = 0;
        hipGetDevice(&dev); hipDeviceGetAttribute(&cus, hipDeviceAttributeMultiprocessorCount, dev);
        if (hipFuncSetAttribute((const void*)mega_fwd, hipFuncAttributeMaxDynamicSharedMemorySize, LDS_BYTES) != hipSuccess) { fprintf(stderr, "kernel_launch: hipFuncSetAttribute failed\n"); grid = -1; return; }
        if (hipOccupancyMaxActiveBlocksPerMultiprocessor(&per_cu, (const void*)mega_fwd, NTHREADS, LDS_BYTES) != hipSuccess || per_cu < 1) { fprintf(stderr, "kernel_launch: occupancy query gives %d\n", per_cu); per_cu = 1; }
        (void)hipGetLastError();
        grid = cus * 1;
        if (grid <= 0) grid = 256;
    }
    if (grid < 0) return;
    if (hipMemsetAsync((char*)d_ws + WS_BAR, 0, 16384, stream) != hipSuccess) { fprintf(stderr, "kernel_launch: memset of the barrier words failed\n"); return; }
    Params p{};
    for (int i = 0; i < 30; ++i) p.in[i] = (const float*)d_in[i];
    p.out = (float*)d_out; p.ws = (unsigned char*)d_ws;
#if N_LAUNCH_MODE == 1
    for (int ph = 0; ph < NPHASE; ++ph) { p.ph_lo = ph; p.ph_hi = ph + 1; hipLaunchKernelGGL(mega_fwd, dim3(grid), dim3(NTHREADS), LDS_BYTES, stream, p); }
#else
    p.ph_lo = 0; p.ph_hi = NPHASE;
    void* args[] = {&p};
    hipError_t e = hipLaunchCooperativeKernel((const void*)mega_fwd, dim3(grid), dim3(NTHREADS), args, LDS_BYTES, stream);
    if (e != hipSuccess) fprintf(stderr, "cooperative launch failed: %s (grid %d)\n", hipGetErrorString(e), grid);
#endif
}
```
